# Optimizing an MI355X kernel written in HIP

```python
import math
import jax, jax.numpy as jnp
from jax import lax
import numpy as np

D_MODEL = 1024
BATCH = 16
SEQ = 2048
DEPTH = 4

MLA_HEADS = 8
MLA_NOPE = 64
MLA_ROPE = 32
MLA_V = 64
MLA_Q_LORA = 384
MLA_KV_LORA = 256
ROPE_BASE = 10000.0
DIFF_HEADS = 8
DIFF_HD = 64
DIFF_VD = 2 * DIFF_HD
D_FF = 2816
N_EXPERTS = 8
TOP_K = 2
N_DENSE = (DEPTH + 1) // 2
N_MOE = DEPTH // 2
Q_BLOCK = 128
EXPERT_BLOCK = 128
DEEPNORM_ALPHA = (2.0 * DEPTH) ** 0.25
DEEPNORM_BETA = (8.0 * DEPTH) ** -0.25
LN_EPS = 1e-5
RMS_EPS = 1e-6
SPLIT_SIZES = (MLA_Q_LORA, MLA_KV_LORA, MLA_ROPE,
               DIFF_HEADS * 2 * DIFF_HD, DIFF_HEADS * 2 * DIFF_HD, DIFF_HEADS * DIFF_VD,
               D_MODEL, D_MODEL)
N_IN = sum(SPLIT_SIZES)

kernel_name = 'hybrid_mla_diffattn_moe_encoder'


def _layernorm(x, g, b):
    xf = x.astype(jnp.float32)
    mu = jnp.mean(xf, axis=-1, keepdims=True)
    var = jnp.mean(jnp.square(xf - mu), axis=-1, keepdims=True)
    return ((xf - mu) * lax.rsqrt(var + LN_EPS) * g.astype(jnp.float32) + b.astype(jnp.float32)).astype(x.dtype)


def _rmsnorm(x, g):
    xf = x.astype(jnp.float32)
    ms = jnp.mean(jnp.square(xf), axis=-1, keepdims=True)
    return (xf * lax.rsqrt(ms + RMS_EPS) * g.astype(jnp.float32)).astype(x.dtype)


def _split_cols(z):
    out, off = [], 0
    for n in SPLIT_SIZES:
        out.append(z[..., off:off + n])
        off += n
    return out


def _rope_tables(positions):
    inv_freq = ROPE_BASE ** (-jnp.arange(0, MLA_ROPE, 2, dtype=jnp.float32) / MLA_ROPE)
    ang = positions.astype(jnp.float32)[..., None] * inv_freq
    return jnp.cos(ang), jnp.sin(ang)


def _rope(x, cos, sin):
    half = x.shape[-1] // 2
    x1 = x[..., :half].astype(jnp.float32)
    x2 = x[..., half:].astype(jnp.float32)
    return jnp.concatenate([x1 * cos - x2 * sin, x1 * sin + x2 * cos], axis=-1).astype(x.dtype)


def _alibi_slopes():
    return 2.0 ** (-8.0 * jnp.arange(1, DIFF_HEADS + 1, dtype=jnp.float32) / DIFF_HEADS)


def _query_blocks(a):
    b, s = a.shape[0], a.shape[1]
    a = a.reshape(b, s // Q_BLOCK, Q_BLOCK, *a.shape[2:])
    return jnp.moveaxis(a, 1, 0)


def _merge_blocks(a):
    a = jnp.moveaxis(a, 0, 1)
    return a.reshape(a.shape[0], a.shape[1] * a.shape[2], *a.shape[3:])


def _mla(q_lat, kv_lat, k_rope_raw, q_norm_g, w_q_up, kv_norm_g, w_kv_up, cos, sin):
    b, s = q_lat.shape[0], q_lat.shape[1]
    q = (_rmsnorm(q_lat, q_norm_g) @ w_q_up).reshape(b, s, MLA_HEADS, MLA_NOPE + MLA_ROPE)
    q_nope = q[..., :MLA_NOPE]
    q_rope = _rope(q[..., MLA_NOPE:], cos[:, :, None, :], sin[:, :, None, :])
    kv = (_rmsnorm(kv_lat, kv_norm_g) @ w_kv_up).reshape(b, s, MLA_HEADS, MLA_NOPE + MLA_V)
    k_nope = kv[..., :MLA_NOPE]
    v = kv[..., MLA_NOPE:]
    k_rope = _rope(k_rope_raw, cos, sin)
    scale = (MLA_NOPE + MLA_ROPE) ** -0.5

    def block(args):
        qn, qr = args
        sc = jnp.einsum('bqhd,bkhd->bhqk', qn, k_nope) + jnp.einsum('bqhr,bkr->bhqk', qr, k_rope)
        p = jax.nn.softmax(sc.astype(jnp.float32) * scale, axis=-1)
        return jnp.einsum('bhqk,bkhd->bqhd', p.astype(v.dtype), v)

    o = _merge_blocks(lax.map(block, (_query_blocks(q_nope), _query_blocks(q_rope))))
    return o.reshape(b, s, MLA_HEADS * MLA_V)


def _diff_attention(q, k, v, posf, lam, lam_init, norm_g, slopes):
    b, s = q.shape[0], q.shape[1]
    scale = DIFF_HD ** -0.5

    def block(args):
        qb, pq = args
        sc = jnp.einsum('bqhmd,bkhmd->mbhqk', qb, k).astype(jnp.float32) * scale
        dist = jnp.abs(pq[:, :, None] - posf[:, None, :])
        sc = sc - slopes[None, None, :, None, None] * dist[None, :, None, :, :]
        p = jax.nn.softmax(sc, axis=-1)
        a = p[0] - lam * p[1]
        return jnp.einsum('bhqk,bkhd->bqhd', a.astype(v.dtype), v)

    o = _merge_blocks(lax.map(block, (_query_blocks(q), _query_blocks(posf))))
    o = _rmsnorm(o, norm_g.reshape(DIFF_HEADS, DIFF_VD)) * (1.0 - lam_init)
    return o.reshape(b, s, DIFF_HEADS * DIFF_VD)


def _swiglu(h, w1, w3, w2):
    return (jax.nn.silu(h @ w1) * (h @ w3)) @ w2


def _moe(h, router_w, router_b, w1, w3, w2):
    b, s, d = h.shape
    t = b * s
    hf = h.reshape(t, d)
    logits = (hf @ router_w).astype(jnp.float32) + router_b.astype(jnp.float32)
    top_logits, top_idx = lax.top_k(logits, TOP_K)
    top_w = jax.nn.softmax(top_logits, axis=-1)
    expert_ids = top_idx.reshape(-1)
    token_ids = jnp.arange(t * TOP_K, dtype=jnp.int32) // TOP_K
    gates = top_w.reshape(-1)
    order = jnp.argsort(expert_ids)
    sorted_e = expert_ids[order]
    sorted_tok = token_ids[order]
    sorted_g = gates[order]
    counts = jnp.zeros((N_EXPERTS,), jnp.int32).at[expert_ids].add(1)
    starts = jnp.cumsum(counts) - counts
    padded = (counts + EXPERT_BLOCK - 1) // EXPERT_BLOCK * EXPERT_BLOCK
    pstarts = jnp.cumsum(padded) - padded
    pends = pstarts + padded
    dest = pstarts[sorted_e] + (jnp.arange(t * TOP_K, dtype=jnp.int32) - starts[sorted_e])
    n_rows = t * TOP_K + N_EXPERTS * EXPERT_BLOCK
    n_blk = n_rows // EXPERT_BLOCK
    buf_tok = jnp.full((n_rows,), t, jnp.int32).at[dest].set(sorted_tok)
    buf_g = jnp.zeros((n_rows,), jnp.float32).at[dest].set(sorted_g)
    blk_e = jnp.minimum(jnp.searchsorted(pends, jnp.arange(n_blk, dtype=jnp.int32) * EXPERT_BLOCK, side='right'),
                        N_EXPERTS - 1).astype(jnp.int32)
    xpad = jnp.concatenate([hf, jnp.zeros((1, d), hf.dtype)], axis=0)
    xb = xpad[buf_tok].reshape(n_blk, EXPERT_BLOCK, d)

    def expert_block(args):
        xe, e = args
        return (jax.nn.silu(xe @ w1[e]) * (xe @ w3[e])) @ w2[e]

    y = lax.map(expert_block, (xb, blk_e)).reshape(n_rows, d)
    y = y * buf_g[:, None].astype(y.dtype)
    out = jnp.zeros((t + 1, d), y.dtype).at[buf_tok].add(y)[:t]
    return out.reshape(b, s, d)


def setup_inputs(seed: int = 0) -> dict:
    key = jax.random.key(seed)
    keys = list(jax.random.split(key, 40))
    L, D, F, E = DEPTH, D_MODEL, D_FF, N_EXPERTS

    def nrm(shape, scale):
        return jax.random.normal(keys.pop(), shape, jnp.float32) * scale

    def gain(shape):
        return 1.0 + nrm(shape, 0.02)

    x = nrm((BATCH, SEQ, D), 1.0)
    c = nrm((BATCH, D), 1.0)
    offsets = jax.random.randint(keys.pop(), (BATCH, 1), 0, 4096, dtype=jnp.int32)
    positions = offsets + jnp.arange(SEQ, dtype=jnp.int32)[None, :]
    mla_out = MLA_HEADS * MLA_V
    diff_out = DIFF_HEADS * DIFF_VD
    return {
        'x': x,
        'c': c,
        'positions': positions,
        'w_ada': nrm((L, D, 6 * D), D ** -0.5),
        'b_ada': nrm((L, 6 * D), 0.02),
        'w_in': nrm((L, D, N_IN), D ** -0.5),
        'q_norm_g': gain((L, MLA_Q_LORA)),
        'w_q_up': nrm((L, MLA_Q_LORA, MLA_HEADS * (MLA_NOPE + MLA_ROPE)), MLA_Q_LORA ** -0.5),
        'kv_norm_g': gain((L, MLA_KV_LORA)),
        'w_kv_up': nrm((L, MLA_KV_LORA, MLA_HEADS * (MLA_NOPE + MLA_V)), MLA_KV_LORA ** -0.5),
        'lambda_q1': nrm((L, DIFF_HD), 0.1),
        'lambda_k1': nrm((L, DIFF_HD), 0.1),
        'lambda_q2': nrm((L, DIFF_HD), 0.1),
        'lambda_k2': nrm((L, DIFF_HD), 0.1),
        'diff_norm_g': gain((L, diff_out)),
        'w_br_mla': nrm((L, mla_out, D), mla_out ** -0.5 * DEEPNORM_BETA),
        'w_br_diff': nrm((L, diff_out, D), diff_out ** -0.5 * DEEPNORM_BETA),
        'w_out': nrm((L, D, D), D ** -0.5 * DEEPNORM_BETA),
        'ln1_g': gain((L, D)),
        'ln1_b': nrm((L, D), 0.02),
        'ln2_g': gain((L, D)),
        'ln2_b': nrm((L, D), 0.02),
        'ffn_w1': nrm((N_DENSE, D, F), D ** -0.5),
        'ffn_w3': nrm((N_DENSE, D, F), D ** -0.5),
        'ffn_w2': nrm((N_DENSE, F, D), F ** -0.5 * DEEPNORM_BETA),
        'router_w': nrm((N_MOE, D, E), D ** -0.5),
        'router_b': nrm((N_MOE, E), 0.01),
        'moe_w1': nrm((N_MOE, E, D, F), D ** -0.5),
        'moe_w3': nrm((N_MOE, E, D, F), D ** -0.5),
        'moe_w2': nrm((N_MOE, E, F, D), F ** -0.5 * DEEPNORM_BETA),
    }


def reference(x, c, positions, w_ada, b_ada, w_in, q_norm_g, w_q_up, kv_norm_g, w_kv_up,
              lambda_q1, lambda_k1, lambda_q2, lambda_k2, diff_norm_g, w_br_mla, w_br_diff, w_out,
              ln1_g, ln1_b, ln2_g, ln2_b, ffn_w1, ffn_w3, ffn_w2, router_w, router_b,
              moe_w1, moe_w3, moe_w2):
    b, s, _ = x.shape
    cos, sin = _rope_tables(positions)
    posf = positions.astype(jnp.float32)
    slopes = _alibi_slopes()
    cond = jax.nn.silu(c)
    for l in range(DEPTH):
        mod = cond @ w_ada[l] + b_ada[l]
        sh1, sc1, g1, sh2, sc2, g2 = jnp.split(mod[:, None, :], 6, axis=-1)
        h = x * (1.0 + sc1) + sh1
        z = h @ w_in[l]
        q_lat, kv_lat, k_rope, dq, dk, dv, gta, gtb = _split_cols(z)
        ya = _mla(q_lat, kv_lat, k_rope, q_norm_g[l], w_q_up[l], kv_norm_g[l], w_kv_up[l], cos, sin) @ w_br_mla[l]
        lam_init = 0.8 - 0.6 * math.exp(-0.3 * l)
        lam = (jnp.exp(jnp.sum(lambda_q1[l].astype(jnp.float32) * lambda_k1[l].astype(jnp.float32)))
               - jnp.exp(jnp.sum(lambda_q2[l].astype(jnp.float32) * lambda_k2[l].astype(jnp.float32)))
               + lam_init)
        yb = _diff_attention(dq.reshape(b, s, DIFF_HEADS, 2, DIFF_HD), dk.reshape(b, s, DIFF_HEADS, 2, DIFF_HD),
                             dv.reshape(b, s, DIFF_HEADS, DIFF_VD), posf, lam, lam_init, diff_norm_g[l], slopes) @ w_br_diff[l]
        mix = (jax.nn.sigmoid(gta) * ya + jax.nn.sigmoid(gtb) * yb) @ w_out[l]
        x = _layernorm(DEEPNORM_ALPHA * x + g1 * mix, ln1_g[l], ln1_b[l])
        h = x * (1.0 + sc2) + sh2
        if l % 2 == 0:
            f = _swiglu(h, ffn_w1[l // 2], ffn_w3[l // 2], ffn_w2[l // 2])
        else:
            f = _moe(h, router_w[l // 2], router_b[l // 2], moe_w1[l // 2], moe_w3[l // 2], moe_w2[l // 2])
        x = _layernorm(DEEPNORM_ALPHA * x + g2 * f, ln2_g[l], ln2_b[l])
    return x
```

```cpp
#include <hip/hip_runtime.h>
#include <hip/hip_bf16.h>
#include <cstdio>
#include <cstdint>
#include <cmath>

#ifndef MK_PER_PHASE
#define MK_PER_PHASE 0
#endif
#ifndef PH_MASK
#define PH_MASK 0xFFFF
#endif
#define PHM(k) (((PH_MASK) >> (k)) & 1)

constexpr int D = 1024, BATCH = 16, SEQ = 2048, DEPTH = 4, T = BATCH * SEQ;
constexpr int NZ = 5888;
constexpr int FF = 2816, NEXP = 8;
constexpr float ALPHA = 1.681792830507429f;
constexpr float LN_EPS = 1e-5f, RMS_EPS = 1e-6f;
constexpr float LOG2E = 1.4426950408889634f;
constexpr float CQ_MLA = 0.10206207261596575f * LOG2E;
constexpr float CQ_DIFF = 0.125f * LOG2E;

#define LAS __attribute__((address_space(3)))
#define GAS __attribute__((address_space(1)))
typedef unsigned short bf16_t;
typedef short bf16x8 __attribute__((ext_vector_type(8)));
typedef short s16x4 __attribute__((ext_vector_type(4)));
typedef float f32x4 __attribute__((ext_vector_type(4)));
typedef float f32x2 __attribute__((ext_vector_type(2)));
typedef float f32x16 __attribute__((ext_vector_type(16)));
typedef unsigned u32x4 __attribute__((ext_vector_type(4)));
typedef unsigned u32x2 __attribute__((ext_vector_type(2)));

__device__ __forceinline__ unsigned cvt_pk_bf16(float lo, float hi) { unsigned r; asm volatile("v_cvt_pk_bf16_f32 %0, %1, %2" : "=v"(r) : "v"(lo), "v"(hi)); return r; }
__device__ __forceinline__ u32x4 pack8(f32x4 a, f32x4 b) { u32x4 w; w.x = cvt_pk_bf16(a[0], a[1]); w.y = cvt_pk_bf16(a[2], a[3]); w.z = cvt_pk_bf16(b[0], b[1]); w.w = cvt_pk_bf16(b[2], b[3]); return w; }
__device__ __forceinline__ void unpack8(u32x4 w, f32x4& a, f32x4& b) {
    a[0] = __uint_as_float(w.x << 16); a[1] = __uint_as_float(w.x & 0xffff0000u); a[2] = __uint_as_float(w.y << 16); a[3] = __uint_as_float(w.y & 0xffff0000u);
    b[0] = __uint_as_float(w.z << 16); b[1] = __uint_as_float(w.z & 0xffff0000u); b[2] = __uint_as_float(w.w << 16); b[3] = __uint_as_float(w.w & 0xffff0000u); }
__device__ __forceinline__ float bf2f(bf16_t v) { return __uint_as_float(((unsigned)v) << 16); }
template <int X> __device__ __forceinline__ float swz_xor(float v) { return __int_as_float(__builtin_amdgcn_ds_swizzle(__float_as_int(v), (X << 10) | 0x1f)); }
__device__ __forceinline__ float sum_x32(float v) { auto rr = __builtin_amdgcn_permlane32_swap(__float_as_uint(v), __float_as_uint(v), false, false); return __uint_as_float(rr[0]) + __uint_as_float(rr[1]); }
__device__ __forceinline__ float sigmoidf_(float x) { return __builtin_amdgcn_rcpf(1.0f + __builtin_amdgcn_exp2f(-x * LOG2E)); }

namespace pg8 {
constexpr int BM = 256, BK = 64, HALF = 128, HTB = HALF * BK * 2, STAGE_BYTES = 8 * HTB, NXCD = 8, WGM = 8;
__host__ __device__ __forceinline__ int lds_byte(int r, int c) { const int st = (r >> 4) * 2 + (c >> 5), rr = r & 15, cc = c & 31, ob = rr * 64 + cc * 2; return st * 1024 + (ob ^ (((ob >> 9) & 1) << 5)); }
__host__ __device__ __forceinline__ void stage_rc(int b, int& R, int& C) { const int st = b / 1024, sb = b % 1024, swz = sb ^ (((sb >> 9) & 1) << 5); R = (st >> 1) * 16 + swz / 64; C = (st & 1) * 32 + (swz % 64) / 2; }
__host__ __device__ __forceinline__ int perm32(int rho) { const int n = rho >> 4, i = rho & 15; return 8 * (i >> 2) + 4 * n + (i & 3); }

struct Unit { int pm, pn; };
struct Gemm { const bf16_t* A; const bf16_t* Bt; int M, N, K, lda; };

struct StaticOrder {
    int nM, nN, nwg, G, c;
    __host__ __device__ void init(int M, int N, int G_, int c_) { nM = M / BM; nN = N / BM; nwg = nM * nN; G = G_; c = c_; }
    __host__ __device__ bool next(int i, Unit& u) const {
        const long L = (long)i * G + c; if (L >= nwg) return false;
        int wgid = (int)L; { const int q = nwg / NXCD, r = nwg % NXCD, xcd = wgid % NXCD, off = wgid / NXCD; wgid = (xcd < r ? xcd * (q + 1) : r * (q + 1) + (xcd - r) * q) + off; }
        const int nig = WGM * nN, gid = wgid / nig, fm = gid * WGM, gsz = (nM - fm) < WGM ? (nM - fm) : WGM;
        u.pm = fm + ((wgid % nig) % gsz); u.pn = (wgid % nig) / gsz; return true;
    }
    __device__ __forceinline__ size_t bofs(const Unit&) const { return 0; }
};
struct MoeOrder {
    StaticOrder so; int ts1, ts2, ts3, ts4, ts5, ts6, ts7; size_t estride;
    __device__ __forceinline__ bool next(int i, Unit& u) const { return so.next(i, u); }
    __device__ __forceinline__ size_t bofs(const Unit& u) const {
        const int e = (u.pm >= ts1) + (u.pm >= ts2) + (u.pm >= ts3) + (u.pm >= ts4) + (u.pm >= ts5) + (u.pm >= ts6) + (u.pm >= ts7);
        return (size_t)e * estride; }
};

template <class F, bool PERM_> struct EpiRow {
    static constexpr bool PERM = PERM_; F f;
    __device__ __forceinline__ void operator()(const f32x4 (&acc)[2][2][4][2], const Unit& u, int wr, int wc, int fr, int fq) const {
#pragma unroll
        for (int ai = 0; ai < 2; ++ai)
#pragma unroll
            for (int m = 0; m < 4; ++m) { const int row = u.pm * BM + ai * HALF + wr * 64 + m * 16 + fr;
                const float rs = f.rowscale(row);
#pragma unroll
                for (int bj = 0; bj < 2; ++bj) f(row, rs, u.pn * BM + bj * HALF + wc * 32, fq, acc[ai][bj][m][0], acc[ai][bj][m][1]);
                asm volatile("" ::: "memory"); __builtin_amdgcn_sched_barrier(0); }
    }
};
struct EpiSwiglu {
    static constexpr bool PERM = true; bf16_t* U; int ldu;
    __device__ __forceinline__ void operator()(const f32x4 (&acc)[2][2][4][2], const Unit& u, int wr, int wc, int fr, int fq) const {
#pragma unroll
        for (int ai = 0; ai < 2; ++ai)
#pragma unroll
            for (int m = 0; m < 4; ++m) { const int row = u.pm * BM + ai * HALF + wr * 64 + m * 16 + fr;
                f32x4 o[2];
#pragma unroll
                for (int n = 0; n < 2; ++n) { const f32x4 a = acc[ai][0][m][n], b = acc[ai][1][m][n];
#pragma unroll
                    for (int i = 0; i < 4; ++i) o[n][i] = a[i] * sigmoidf_(a[i]) * b[i]; }
                *(u32x4*)(U + (size_t)row * ldu + u.pn * HALF + wc * 32 + 8 * fq) = pack8(o[0], o[1]); __builtin_amdgcn_sched_barrier(0); }
    }
};

template <class Epi, class Sched, bool ALIGN_EPI = true>
__device__ __forceinline__ void gemm_phase(LAS unsigned char* lds, int tid_in, const Gemm g, const Sched& S, const Epi& E) {
    int tid_ = tid_in; asm volatile("" : "+v"(tid_));
    const int tid = tid_, wid = __builtin_amdgcn_readfirstlane(tid >> 6), lane = tid & 63, wr = wid >> 2, wc = wid & 3, fr = lane & 15, fq = lane >> 4;
    const int K = g.K, nt = K / BK, lda = g.lda;
    unsigned voffA[2], voffB[2];
#pragma unroll
    for (int i = 0; i < 2; ++i) { int R, C; stage_rc(tid * 16 + i * 8192, R, C); const int Rb = Epi::PERM ? ((R & ~31) + perm32(R & 31)) : R;
        voffA[i] = (unsigned)(R * lda + C) * 2u; voffB[i] = (unsigned)(Rb * K + C) * 2u; }
    const size_t kstep = (size_t)(BK * 2);
    const size_t hstepA = (size_t)HALF * lda * 2, hstepB = (size_t)HALF * K * 2;
    const size_t tstepA = 2 * hstepA, tstepB = 2 * hstepB;
    const unsigned ldsw = (unsigned)wid * 1024u;
    const int aoff = lds_byte(wr * 64 + fr, fq * 8), boff = lds_byte(wc * 32 + fr, fq * 8);
#define PG8_SA(b, h) (((b) * 2 + (h)) * HTB)
#define PG8_SB(b, h) ((4 + (b) * 2 + (h)) * HTB)
#define PG8_STAGE(bufoff, gbase, voff) do { _Pragma("unroll") for (int _i = 0; _i < 2; ++_i) \
        __builtin_amdgcn_global_load_lds((const unsigned*)((const char*)(gbase) + (voff)[_i]), (LAS unsigned*)(lds + (bufoff) + ldsw + _i * 8192), 16, 0, 0); } while (0)
#define PG8_LDA(dst, b, h) do { _Pragma("unroll") for (int m = 0; m < 4; ++m) _Pragma("unroll") for (int k = 0; k < 2; ++k) dst[m][k] = *(const LAS bf16x8*)(lds + PG8_SA(b, h) + aoff + m * 2048 + k * 1024); } while (0)
#define PG8_LDB(dst, b, h) do { _Pragma("unroll") for (int n = 0; n < 2; ++n) _Pragma("unroll") for (int k = 0; k < 2; ++k) dst[n][k] = *(const LAS bf16x8*)(lds + PG8_SB(b, h) + boff + n * 2048 + k * 1024); } while (0)
#define PG8_MMA(ai, bj, At, Bt) do { __builtin_amdgcn_s_setprio(1); _Pragma("unroll") for (int m = 0; m < 4; ++m) _Pragma("unroll") for (int n = 0; n < 2; ++n) _Pragma("unroll") for (int k = 0; k < 2; ++k) \
        acc[ai][bj][m][n] = __builtin_amdgcn_mfma_f32_16x16x32_bf16(Bt[n][k], At[m][k], acc[ai][bj][m][n], 0, 0, 0); __builtin_amdgcn_s_setprio(0); } while (0)
#define PG8_WAIT_V(n) asm volatile("s_waitcnt vmcnt(" #n ")" ::: "memory")
#define PG8_WAIT_L(n) asm volatile("s_waitcnt lgkmcnt(" #n ")" ::: "memory")
#define PG8_BAR __builtin_amdgcn_s_barrier()
#define PG8_SCHED __builtin_amdgcn_sched_barrier(0)
    Unit cur, nxt; int ui = 0;
    if (!S.next(0, cur)) return;
    f32x4 acc[2][2][4][2];
#pragma unroll
    for (int a = 0; a < 2; ++a)
#pragma unroll
        for (int b = 0; b < 2; ++b)
#pragma unroll
            for (int m = 0; m < 4; ++m)
#pragma unroll
                for (int n = 0; n < 2; ++n) acc[a][b][m][n] = (f32x4){0.f, 0.f, 0.f, 0.f};
    bf16x8 At[4][2], B0[2][2], B1[2][2];
    const char* cA = (const char*)g.A + (size_t)cur.pm * tstepA; const char* cB = (const char*)g.Bt + S.bofs(cur) + (size_t)cur.pn * tstepB;
    PG8_STAGE(PG8_SB(0, 0), cB, voffB); PG8_STAGE(PG8_SB(0, 1), cB + hstepB, voffB); PG8_STAGE(PG8_SA(0, 0), cA, voffA); PG8_STAGE(PG8_SA(0, 1), cA + hstepA, voffA);
    if (wr == 1) PG8_BAR;
    PG8_WAIT_V(2); PG8_BAR;
    PG8_STAGE(PG8_SB(1, 0), cB + kstep, voffB); PG8_STAGE(PG8_SA(1, 0), cA + kstep, voffA); PG8_STAGE(PG8_SB(1, 1), cB + hstepB + kstep, voffB);
    PG8_WAIT_V(6); PG8_BAR;
    for (;;) {
        const bool has_next = S.next(ui + 1, nxt);
        const char* nA = has_next ? (const char*)g.A + (size_t)nxt.pm * tstepA : cA; const char* nB = has_next ? (const char*)g.Bt + S.bofs(nxt) + (size_t)nxt.pn * tstepB : cB;
#pragma unroll 1
        for (int t = 0; t < nt; t += 2) {
            const bool last = (t == nt - 2);
            const char* a1 = cA + (size_t)(t + 1) * kstep;
            const char* a2 = last ? nA : cA + (size_t)(t + 2) * kstep; const char* b2 = last ? nB : cB + (size_t)(t + 2) * kstep;
            const char* a3 = a2 + kstep; const char* b3 = b2 + kstep;
            PG8_LDB(B0, 0, 0); PG8_LDB(B1, 0, 1); PG8_SCHED; PG8_LDA(At, 0, 0); PG8_STAGE(PG8_SA(1, 1), a1 + hstepA, voffA);
            PG8_WAIT_V(8); PG8_WAIT_L(0); PG8_BAR; PG8_MMA(0, 0, At, B0); PG8_MMA(0, 1, At, B1); PG8_BAR; PG8_SCHED;
            PG8_LDA(At, 0, 1); PG8_STAGE(PG8_SB(0, 0), b2, voffB); PG8_STAGE(PG8_SB(0, 1), b2 + hstepB, voffB); PG8_STAGE(PG8_SA(0, 0), a2, voffA);
            PG8_WAIT_V(8); PG8_WAIT_L(0); PG8_BAR; PG8_MMA(1, 0, At, B0); PG8_MMA(1, 1, At, B1); PG8_BAR; PG8_SCHED;
            PG8_LDB(B0, 1, 0); PG8_LDB(B1, 1, 1); PG8_SCHED; PG8_LDA(At, 1, 0); PG8_STAGE(PG8_SA(0, 1), a2 + hstepA, voffA);
            PG8_WAIT_V(8); PG8_WAIT_L(0); PG8_BAR; PG8_MMA(0, 0, At, B0); PG8_MMA(0, 1, At, B1); PG8_BAR; PG8_SCHED;
            PG8_LDA(At, 1, 1); PG8_STAGE(PG8_SB(1, 0), b3, voffB); PG8_STAGE(PG8_SB(1, 1), b3 + hstepB, voffB); PG8_STAGE(PG8_SA(1, 0), a3, voffA);
            PG8_WAIT_V(8); PG8_WAIT_L(0); PG8_BAR; PG8_MMA(1, 0, At, B0); PG8_MMA(1, 1, At, B1); PG8_BAR; PG8_SCHED;
        }
        if constexpr (ALIGN_EPI) { if (wr == 0) PG8_BAR; }
        E(acc, cur, wr, wc, fr, fq);
        if (!has_next) break;
#pragma unroll
        for (int a = 0; a < 2; ++a)
#pragma unroll
            for (int b = 0; b < 2; ++b)
#pragma unroll
                for (int m = 0; m < 4; ++m)
#pragma unroll
                    for (int n = 0; n < 2; ++n) acc[a][b][m][n] = (f32x4){0.f, 0.f, 0.f, 0.f};
        cur = nxt; cA = nA; cB = nB; ++ui;
        if constexpr (ALIGN_EPI) { if (wr == 1) PG8_BAR; }
    }
    PG8_WAIT_V(0);
    if constexpr (!ALIGN_EPI) { if (wr == 0) PG8_BAR; }
    PG8_BAR;
#undef PG8_SA
#undef PG8_SB
#undef PG8_STAGE
#undef PG8_LDA
#undef PG8_LDB
#undef PG8_MMA
#undef PG8_WAIT_V
#undef PG8_WAIT_L
#undef PG8_BAR
#undef PG8_SCHED
}
}

namespace att {
constexpr int NW = 8, QBLK = 32, KVBLK = 64;
constexpr float THR = 11.5f;
constexpr size_t SHM_V = 16384, SHM_K = 16384;
constexpr size_t OFF_V = 0, OFF_K = 2 * SHM_V, OFF_WS = OFF_K + 2 * SHM_K, OFF_POS = OFF_WS + NW * 64 * 4, ATT_LDS = OFF_POS + SEQ * 4;
#define KSWZ(row, colB) ((row) * 256 + ((colB) ^ (((row) & 7) << 4)))
#define SBAR() __builtin_amdgcn_sched_barrier(0)
__device__ __forceinline__ int crow(int r, int hi) { return (r & 3) + 8 * (r >> 2) + 4 * hi; }
__device__ __forceinline__ unsigned cvtpk(float lo, float hi) { unsigned r; asm volatile("v_cvt_pk_bf16_f32 %0, %1, %2" : "=v"(r) : "v"(lo), "v"(hi)); return r; }

__device__ __forceinline__ void partialSM(f32x16& p0, f32x16& p1, float& m_reg, float& mn, float& alpha) {
  float pmax = p0[0];
#pragma unroll
  for (int r = 1; r < 16; ++r) pmax = fmaxf(pmax, p0[r]);
#pragma unroll
  for (int r = 0; r < 16; ++r) pmax = fmaxf(pmax, p1[r]);
  { auto rr = __builtin_amdgcn_permlane32_swap(__float_as_uint(pmax), __float_as_uint(pmax), false, false);
    pmax = fmaxf(__uint_as_float(rr[0]), __uint_as_float(rr[1])); }
  if (__builtin_expect(__all(pmax - m_reg <= THR), 1)) { mn = m_reg; alpha = 1.f; }
  else { mn = fmaxf(m_reg, pmax); alpha = __builtin_amdgcn_exp2f(m_reg - mn); m_reg = mn; }
#pragma unroll
  for (int r = 0; r < 16; ++r) p0[r] = p0[r] - mn;
#pragma unroll
  for (int r = 0; r < 16; ++r) p1[r] = p1[r] - mn;
#pragma unroll
  for (int r = 0; r < 16; ++r) p0[r] = __builtin_amdgcn_exp2f(p0[r]);
}
__device__ __forceinline__ void finishSM(f32x16& p0, f32x16& p1, float alpha, float& l_reg, bf16x8& pa0, bf16x8& pa1, bf16x8& pa2, bf16x8& pa3) {
#pragma unroll
  for (int r = 0; r < 16; ++r) p1[r] = __builtin_amdgcn_exp2f(p1[r]);
  float ps = 0;
#pragma unroll
  for (int r = 0; r < 16; ++r) ps += p0[r];
#pragma unroll
  for (int r = 0; r < 16; ++r) ps += p1[r];
  { auto rr = __builtin_amdgcn_permlane32_swap(__float_as_uint(ps), __float_as_uint(ps), false, false);
    ps = __uint_as_float(rr[0]) + __uint_as_float(rr[1]); }
  l_reg = l_reg * alpha + ps;
#define PK4(P, BASE, OUT) do { unsigned a0 = cvtpk(P[BASE + 0], P[BASE + 1]), a1 = cvtpk(P[BASE + 2], P[BASE + 3]);   \
    unsigned b0 = cvtpk(P[BASE + 4], P[BASE + 5]), b1 = cvtpk(P[BASE + 6], P[BASE + 7]);                              \
    auto r0 = __builtin_amdgcn_permlane32_swap(a0, b0, false, false); auto r1 = __builtin_amdgcn_permlane32_swap(a1, b1, false, false); \
    u32x4 w = {r0[0], r1[0], r0[1], r1[1]}; OUT = *reinterpret_cast<bf16x8*>(&w); } while (0)
  PK4(p0, 0, pa0); PK4(p0, 8, pa1); PK4(p1, 0, pa2); PK4(p1, 8, pa3);
#undef PK4
}
template <int NQK> __device__ __forceinline__ void qkt(f32x16& p0, f32x16& p1, const char* Ks, const bf16x8* qr, int r32, int hi, int colb0) {
  p0 = f32x16{}; p1 = f32x16{};
#pragma unroll
  for (int d0 = 0; d0 < NQK; ++d0) { const int cb = colb0 + (d0 * 16 + hi * 8) * 2;
    bf16x8 b0 = *reinterpret_cast<const bf16x8*>(Ks + KSWZ(r32, cb));
    bf16x8 b1 = *reinterpret_cast<const bf16x8*>(Ks + KSWZ(32 + r32, cb));
    p0 = __builtin_amdgcn_mfma_f32_32x32x16_bf16(b0, qr[d0], p0, 0, 0, 0);
    p1 = __builtin_amdgcn_mfma_f32_32x32x16_bf16(b1, qr[d0], p1, 0, 0, 0); }
}
template <int NCB> __device__ __forceinline__ int v_st(int k, int c) { const int kk = (k & ~0xC) | ((k & 4) << 1) | ((k & 8) >> 1); return ((kk >> 3) * NCB + (c >> 5)) * 512 + ((kk & 7) * 32 + (c & 31)) * 2; }
__device__ __forceinline__ int v_rd_base(int lane) { return ((lane & 3) << 3) | (((lane >> 2) & 3) << 6) | (((lane >> 4) & 1) << 5) | (((lane >> 5) & 1) << 8); }
template <int NCB> constexpr int v_rd_off(int d0, int ks, int half) { return d0 * 512 + (2 * ks + half) * NCB * 512; }
template <int OFF> __device__ __forceinline__ s16x4 tr_read(int vb) { s16x4 r; asm volatile("ds_read_b64_tr_b16 %0, %1 offset:%2" : "=&v"(r) : "v"(vb), "i"(OFF) : "memory"); return r; }
template <int NCB, int D0> __device__ __forceinline__ void pv_one(f32x16& od, int vb, bf16x8 pa0, bf16x8 pa1, bf16x8 pa2, bf16x8 pa3) {
  const s16x4 l0 = tr_read<v_rd_off<NCB>(D0, 0, 0)>(vb), h0 = tr_read<v_rd_off<NCB>(D0, 0, 1)>(vb), l1 = tr_read<v_rd_off<NCB>(D0, 1, 0)>(vb), h1 = tr_read<v_rd_off<NCB>(D0, 1, 1)>(vb);
  const s16x4 l2 = tr_read<v_rd_off<NCB>(D0, 2, 0)>(vb), h2 = tr_read<v_rd_off<NCB>(D0, 2, 1)>(vb), l3 = tr_read<v_rd_off<NCB>(D0, 3, 0)>(vb), h3 = tr_read<v_rd_off<NCB>(D0, 3, 1)>(vb);
  asm volatile("s_waitcnt lgkmcnt(0)" ::: "memory"); SBAR();
#define PK(L, H) (bf16x8){L[0], L[1], L[2], L[3], H[0], H[1], H[2], H[3]}
  od = __builtin_amdgcn_mfma_f32_32x32x16_bf16(pa0, PK(l0, h0), od, 0, 0, 0);
  od = __builtin_amdgcn_mfma_f32_32x32x16_bf16(pa1, PK(l1, h1), od, 0, 0, 0);
  od = __builtin_amdgcn_mfma_f32_32x32x16_bf16(pa2, PK(l2, h2), od, 0, 0, 0);
  od = __builtin_amdgcn_mfma_f32_32x32x16_bf16(pa3, PK(l3, h3), od, 0, 0, 0);
#undef PK
}
template <int NCB> __device__ __forceinline__ void pv_all(f32x16* o, int vb, bf16x8 pa0, bf16x8 pa1, bf16x8 pa2, bf16x8 pa3) {
  pv_one<NCB, 0>(o[0], vb, pa0, pa1, pa2, pa3); pv_one<NCB, 1>(o[1], vb, pa0, pa1, pa2, pa3);
  if constexpr (NCB == 4) { pv_one<NCB, 2>(o[2], vb, pa0, pa1, pa2, pa3); pv_one<NCB, 3>(o[3], vb, pa0, pa1, pa2, pa3); }
}
__device__ __forceinline__ void alibi(f32x16& p0, f32x16& p1, const float* posl, int k0, int hi, float pq, float sl) {
  const float* pk = posl + k0 + 4 * hi;
#pragma unroll
  for (int g = 0; g < 4; ++g) { const f32x4 a = *(const f32x4*)(pk + 8 * g), b = *(const f32x4*)(pk + 32 + 8 * g);
#pragma unroll
    for (int i = 0; i < 4; ++i) { p0[4 * g + i] -= sl * fabsf(pq - a[i]); p1[4 * g + i] -= sl * fabsf(pq - b[i]); } }
}

struct DiffArgs { const int* pos; float sl; float lam; float oscale; const float* ng; };

template <bool DIFF>
__device__ __forceinline__ void attn_unit(const bf16_t* __restrict__ Qb, const bf16_t* __restrict__ Kh, const bf16_t* __restrict__ Vh, bf16_t* __restrict__ Ob, int q0, const DiffArgs da, char* lds, int tid_in) {
  constexpr int LDQ = DIFF ? 1024 : 768, LDK = DIFF ? 1024 : 768, LDV = DIFF ? 1024 : 512, LDO = DIFF ? 1024 : 512;
  constexpr int NQK = DIFF ? 4 : 6, NDV = DIFF ? 4 : 2, KCH = DIFF ? 16 : 12, VCH = DIFF ? 16 : 8;
  int tid_ = tid_in; asm volatile("" : "+v"(tid_));
  const int tid = tid_, wid = tid >> 6, lane = tid & 63, r32 = lane & 31, hi = lane >> 5;
  const int mp = DIFF ? (wid >> 2) : 0, wrow = DIFF ? (wid & 3) * QBLK : wid * QBLK;
  char* V_lds = lds + OFF_V; char* K_lds = lds + OFF_K;
  float* ws = (float*)(lds + OFF_WS) + wid * 64; float* li_l = ws; float* al_l = ws + 32;
  float* posl = (float*)(lds + OFF_POS);
  float m_reg = -1e30f, l_reg = 0; f32x16 o[NDV]; bf16x8 qr[NQK];
#pragma unroll
  for (int d = 0; d < NDV; ++d) o[d] = f32x16{};
  const bf16_t* Qw = Qb + (long)(wrow + r32) * LDQ + mp * 64 + hi * 8;
#pragma unroll
  for (int d0 = 0; d0 < NQK; ++d0) qr[d0] = *reinterpret_cast<const bf16x8*>(Qw + d0 * 16);
  float pq = 0.f;
  if constexpr (DIFF) {
    for (int i = tid; i < SEQ; i += NW * 64) posl[i] = (float)da.pos[i];
    pq = (float)da.pos[q0 + wrow + r32];
  }
  const int sr = tid >> 4, ch = tid & 15, sc = ch * 8;
  const bool kact = ch < KCH, vact = ch < VCH;
  const int vst0 = v_st<NDV>(sr, sc), vst1 = v_st<NDV>(32 + sr, sc);
  const int vb0 = (int)(uintptr_t)V_lds + v_rd_base(lane);
  const int kcol0 = mp * 128;
  struct { bf16x8 vs0, vs1, ks0, ks1; } sr_[2];
#define SLOAD(i, k0) do { if (vact) { sr_[i].vs0 = *(const bf16x8*)(&Vh[(long)((k0) + sr) * LDV + sc]); sr_[i].vs1 = *(const bf16x8*)(&Vh[(long)((k0) + 32 + sr) * LDV + sc]); } \
    if (kact) { sr_[i].ks0 = *(const bf16x8*)(&Kh[(long)((k0) + sr) * LDK + sc]); sr_[i].ks1 = *(const bf16x8*)(&Kh[(long)((k0) + 32 + sr) * LDK + sc]); } } while (0)
#define SWRITE(b, i) do { if (vact) { *(bf16x8*)(V_lds + (b) * SHM_V + vst0) = sr_[i].vs0; *(bf16x8*)(V_lds + (b) * SHM_V + vst1) = sr_[i].vs1; } \
    if (kact) { const int kc = sc * 2; *(bf16x8*)(K_lds + (b) * SHM_K + KSWZ(sr, kc)) = sr_[i].ks0; *(bf16x8*)(K_lds + (b) * SHM_K + KSWZ(32 + sr, kc)) = sr_[i].ks1; } } while (0)
#define SWAIT() asm volatile("s_waitcnt vmcnt(4)" ::: "memory")
#define RESC(a) do { if (__any((a) < 1.f)) { if (hi == 0) al_l[r32] = (a); asm volatile("s_waitcnt lgkmcnt(0)" ::: "memory"); \
    _Pragma("unroll") for (int d = 0; d < NDV; ++d) _Pragma("unroll") for (int r = 0; r < 16; ++r) o[d][r] *= al_l[crow(r, hi)]; } } while (0)
#define BIAS(P0, P1, k0) do { if constexpr (DIFF) alibi(P0, P1, posl, (k0), hi, pq, da.sl); } while (0)
  f32x16 pA0, pA1, pB0, pB1; float mnA, mnB, alA, alB; bf16x8 pa0, pa1, pa2, pa3; constexpr int NT = SEQ / KVBLK;
  constexpr int SE = 0, SO = 1;
  SLOAD(SE, 0); asm volatile("s_waitcnt vmcnt(0)" ::: "memory"); SWRITE(0, SE); __syncthreads();
  qkt<NQK>(pA0, pA1, K_lds, qr, r32, hi, kcol0); BIAS(pA0, pA1, 0); partialSM(pA0, pA1, m_reg, mnA, alA);
  SLOAD(SO, KVBLK); SLOAD(SE, 2 * KVBLK);
  SWAIT(); SWRITE(1, SO); __syncthreads();
  for (int j = 1; j + 1 < NT; j += 2) {
    SBAR(); qkt<NQK>(pB0, pB1, K_lds + SHM_K, qr, r32, hi, kcol0); BIAS(pB0, pB1, j * KVBLK);
    finishSM(pA0, pA1, alA, l_reg, pa0, pa1, pa2, pa3); SBAR();
    SLOAD(SO, (j + 2) * KVBLK); SBAR();
    pv_all<NDV>(o, vb0, pa0, pa1, pa2, pa3); partialSM(pB0, pB1, m_reg, mnB, alB);
    __syncthreads(); SWAIT(); SWRITE(0, SE);
    RESC(alB); __syncthreads();
    SBAR(); qkt<NQK>(pA0, pA1, K_lds, qr, r32, hi, kcol0); BIAS(pA0, pA1, (j + 1) * KVBLK);
    finishSM(pB0, pB1, alB, l_reg, pa0, pa1, pa2, pa3); SBAR();
    if (j + 3 < NT) SLOAD(SE, (j + 3) * KVBLK); SBAR();
    pv_all<NDV>(o, vb0 + (int)SHM_V, pa0, pa1, pa2, pa3); partialSM(pA0, pA1, m_reg, mnA, alA);
    __syncthreads(); SWAIT(); SWRITE(1, SO);
    RESC(alA); __syncthreads();
  }
  SBAR(); qkt<NQK>(pB0, pB1, K_lds + SHM_K, qr, r32, hi, kcol0); BIAS(pB0, pB1, (NT - 1) * KVBLK);
  finishSM(pA0, pA1, alA, l_reg, pa0, pa1, pa2, pa3); SBAR();
  pv_all<NDV>(o, vb0, pa0, pa1, pa2, pa3); partialSM(pB0, pB1, m_reg, mnB, alB);
  __syncthreads(); RESC(alB);
  finishSM(pB0, pB1, alB, l_reg, pa0, pa1, pa2, pa3); SBAR();
  pv_all<NDV>(o, vb0 + (int)SHM_V, pa0, pa1, pa2, pa3);
  if (hi == 0) li_l[r32] = l_reg; asm volatile("s_waitcnt lgkmcnt(0)" ::: "memory");
  float rli[16];
#pragma unroll
  for (int r = 0; r < 16; ++r) rli[r] = __builtin_amdgcn_rcpf(li_l[crow(r, hi)]);
  if constexpr (!DIFF) {
    bf16_t* Ow = Ob + (long)wrow * LDO;
#pragma unroll
    for (int r = 0; r < 16; ++r) { const int orow = crow(r, hi);
#pragma unroll
      for (int d0 = 0; d0 < NDV; ++d0) { const float v = o[d0][r] * rli[r]; Ow[(long)orow * LDO + d0 * 32 + r32] = (bf16_t)(cvtpk(v, v) & 0xffffu); } }
    __syncthreads();
  } else {
    __syncthreads();
    float* cmb = (float*)lds + (wid & 3) * 4096;
    if (mp == 1) {
#pragma unroll
      for (int r = 0; r < 16; ++r) { const int orow = crow(r, hi);
#pragma unroll
        for (int d0 = 0; d0 < 4; ++d0) cmb[orow * 128 + d0 * 32 + r32] = o[d0][r] * rli[r]; }
    }
    __syncthreads();
    if (mp == 0) {
      float ss[16];
#pragma unroll
      for (int r = 0; r < 16; ++r) { const int orow = crow(r, hi); float s = 0.f;
#pragma unroll
        for (int d0 = 0; d0 < 4; ++d0) { const float v = o[d0][r] * rli[r] - da.lam * cmb[orow * 128 + d0 * 32 + r32]; o[d0][r] = v; s += v * v; }
        ss[r] = s; }
#pragma unroll
      for (int r = 0; r < 16; ++r) { float s = ss[r];
        s += swz_xor<1>(s); s += swz_xor<2>(s); s += swz_xor<4>(s); s += swz_xor<8>(s); s += swz_xor<16>(s);
        ss[r] = da.oscale * __builtin_amdgcn_rsqf(s * (1.0f / 128.0f) + RMS_EPS); }
      bf16_t* Ow = Ob + (long)wrow * LDO;
      float gn[4];
#pragma unroll
      for (int d0 = 0; d0 < 4; ++d0) gn[d0] = da.ng[d0 * 32 + r32];
#pragma unroll
      for (int r = 0; r < 16; ++r) { const int orow = crow(r, hi);
#pragma unroll
        for (int d0 = 0; d0 < 4; ++d0) { const float v = o[d0][r] * ss[r] * gn[d0]; Ow[(long)orow * LDO + d0 * 32 + r32] = (bf16_t)(cvtpk(v, v) & 0xffffu); } }
    }
    __syncthreads();
  }
#undef SLOAD
#undef SWRITE
#undef SWAIT
#undef RESC
#undef BIAS
}
#undef KSWZ
#undef SBAR
}

constexpr size_t MiB = 1u << 20;
constexpr size_t WS_CTL = 0, CTL_ZERO_BYTES = 1 * MiB;
constexpr size_t WS_MOD = 1 * MiB;
constexpr size_t WS_RSQ = 3 * MiB;
constexpr size_t WS_COS = 6 * MiB;
constexpr size_t WS_SIN = 8 * MiB;
constexpr size_t WS_SEL = 10 * MiB;
constexpr size_t WS_GATE = 10 * MiB + 256 * 1024;
constexpr size_t WS_RMAP = 11 * MiB;
constexpr size_t WS_WMIX = 12 * MiB;
constexpr size_t W_IN = WS_WMIX, W_QUP = W_IN + (size_t)NZ * 1024 * 2, W_KVUP = W_QUP + 768 * 384 * 2, W_BRM = W_KVUP + 1024 * 256 * 2, W_BRD = W_BRM + 1024 * 512 * 2, W_OUT = W_BRD + 1024 * 1024 * 2;
constexpr size_t WS_WFF = 30 * MiB;
constexpr size_t W13_ESTRIDE = (size_t)5632 * 1024 * 2, W2_ESTRIDE = (size_t)1024 * 2816 * 2, W2_BASE = WS_WFF + 8 * W13_ESTRIDE;
constexpr size_t WS_ACT = 162 * MiB;
constexpr size_t WS_H = WS_ACT;
constexpr size_t WS_LAT = WS_H + 64 * MiB;
constexpr size_t WS_ZB = WS_LAT + 48 * MiB;
constexpr size_t WS_QM = WS_ZB + 320 * MiB;
constexpr size_t WS_KM = WS_QM + 48 * MiB;
constexpr size_t WS_VM = WS_KM + 48 * MiB;
constexpr size_t WS_OM = WS_VM + 32 * MiB;
constexpr size_t WS_END = WS_OM + 32 * MiB;
constexpr size_t WS_PRE = WS_QM;
constexpr size_t WS_PART = WS_QM;
constexpr size_t WS_T1 = WS_ZB + 64 * MiB;
constexpr size_t WS_MB = WS_ZB + 128 * MiB;
constexpr size_t WS_U = WS_LAT;
constexpr size_t WS_XB = WS_LAT;
constexpr size_t WS_Y = WS_LAT;
constexpr size_t WS_UM = WS_LAT + 132 * MiB;
static_assert(WS_UM + (size_t)67584 * 2816 * 2 <= WS_END + 64 * MiB, "ws map");
constexpr size_t WS_NEED = WS_END + 8 * MiB;
constexpr int CW_BAR = 4096;
constexpr int CW_CNT = 8192;
constexpr int CW_CUR = 8192 + 256;

constexpr int RING_BYTES = 131072, LDSCTL_OFF = RING_BYTES, MISC_OFF = LDSCTL_OFF + 320, LDS_BYTES = 147456;
constexpr int NWAVES = 8;

#define XB_TMO      128
#define XB_XCNT(j)  (256  + 64 * (j))
#define XB_XSUB(j)  (1280 + 64 * (j))
#define XB_XGEN(j)  (2304 + 64 * (j))
#define XB_TOP      3328
#define XB_TOPGEN   3392
#define XCD_BAR_WORDS 3456
#define XB_SPIN_CAP (1u << 18)
__device__ __forceinline__ unsigned xb_ld(unsigned* p)              { return __hip_atomic_load(p, __ATOMIC_RELAXED, __HIP_MEMORY_SCOPE_AGENT); }
__device__ __forceinline__ unsigned xb_add(unsigned* p, unsigned v) { return __hip_atomic_fetch_add(p, v, __ATOMIC_RELAXED, __HIP_MEMORY_SCOPE_AGENT); }
__device__ __forceinline__ unsigned xb_xcc_id() { return (unsigned)__builtin_amdgcn_s_getreg((3 << 11) | 20) & 0xFu; }
#define XB_SPIN(cond, bar) do { unsigned _sp = 0; while (cond) { __builtin_amdgcn_s_sleep(1); \
    if ((++_sp & 255u) == 0u) { if (xb_ld(&(bar)[XB_TMO])) break; if (_sp > XB_SPIN_CAP) { atomicAdd(&(bar)[XB_TMO], 1u); break; } } } } while (0)
struct XcdBarrier { unsigned* bar; unsigned x; volatile LAS unsigned* st; };
__device__ __forceinline__ XcdBarrier xcd_barrier_post(unsigned* bar, volatile LAS unsigned* st, bool leader) {
    XcdBarrier b; b.bar = bar; b.x = xb_xcc_id(); b.st = st;
    if (leader) (void)xb_add(&bar[XB_XCNT(b.x)], 1u);
    return b;
}
__device__ __forceinline__ void xcd_barrier_complete(unsigned* bar, unsigned x, unsigned& nloc, unsigned& nx) {
    const unsigned G = gridDim.x * gridDim.y * gridDim.z;
    unsigned sum, cnt, mine, sp = 0u;
    for (;;) {
        sum = 0u; cnt = 0u; mine = 0u;
#pragma unroll
        for (unsigned j = 0; j < 16; ++j) { const unsigned c = xb_ld(&bar[XB_XCNT(j)]); sum += c; cnt += (c > 0u) ? 1u : 0u; mine = (j == x) ? c : mine; }
        if (sum == G) break;
        __builtin_amdgcn_s_sleep(1);
        if ((++sp & 255u) == 0u) { if (xb_ld(&bar[XB_TMO])) break; if (sp > XB_SPIN_CAP) { atomicAdd(&bar[XB_TMO], 1u); break; } }
    }
    nloc = mine > 0u ? mine : 1u; nx = cnt > 0u ? cnt : 1u;
}
__device__ __forceinline__ void xcd_barrier(const XcdBarrier& b, bool leader) {
    asm volatile("s_waitcnt vmcnt(0)" ::: "memory");
    __syncthreads();
    if (leader) {
        unsigned* bar = b.bar;
        __builtin_amdgcn_s_waitcnt(0);
        unsigned nloc = b.st[0], nx = b.st[1];
        if (nloc == 0u) { xcd_barrier_complete(bar, b.x, nloc, nx); b.st[0] = nloc; b.st[1] = nx; }
        const unsigned old = xb_add(&bar[XB_XSUB(b.x)], 1u);
        const unsigned gen = old / nloc;
        if (old + 1u == (gen + 1u) * nloc) {
            __builtin_amdgcn_fence(__ATOMIC_RELEASE, "agent");
            asm volatile("s_waitcnt vmcnt(0)" ::: "memory");
            const unsigned og = xb_add(&bar[XB_TOP], 1u);
            const unsigned tg = og / nx;
            if (og + 1u == (tg + 1u) * nx) xb_add(&bar[XB_TOPGEN], 1u);
            else XB_SPIN(xb_ld(&bar[XB_TOPGEN]) == tg, bar);
            __builtin_amdgcn_fence(__ATOMIC_ACQUIRE, "agent");
            xb_add(&bar[XB_XGEN(b.x)], 1u);
            asm volatile("s_waitcnt vmcnt(0)" ::: "memory");
        } else {
            XB_SPIN(xb_ld(&bar[XB_XGEN(b.x)]) == gen, bar);
            __builtin_amdgcn_fence(__ATOMIC_ACQUIRE, "agent");
            asm volatile("s_waitcnt vmcnt(0)" ::: "memory");
        }
    }
    __syncthreads();
}

__device__ __forceinline__ float wave_sum(float v) {
    v += swz_xor<1>(v); v += swz_xor<2>(v); v += swz_xor<4>(v); v += swz_xor<8>(v); v += swz_xor<16>(v);
    return sum_x32(v);
}
__device__ __forceinline__ unsigned f2bf(float f) { unsigned u = __builtin_bit_cast(unsigned, f); return (u + 0x7fffu + ((u >> 16) & 1u)) >> 16; }
__device__ __forceinline__ unsigned pk2(float lo, float hi) { return f2bf(lo) | (f2bf(hi) << 16); }

template <class MapF>
__device__ __forceinline__ void transpose_item(const float* W, int N, bf16_t* WT, int ldk, const float* gain, LAS float* scr, int kb, int nb, int lane, MapF map) {
    const int k0 = 64 * kb, n0 = 32 * nb;
#pragma unroll 8
    for (int i = 0; i < 32; ++i) { const int kk = 2 * i + (lane >> 5); float v = W[(size_t)(k0 + kk) * N + n0 + (lane & 31)]; if (gain) v *= gain[k0 + kk]; scr[kk * 33 + (lane & 31)] = v; }
    asm volatile("s_waitcnt lgkmcnt(0)" ::: "memory");
    const int c = lane & 7;
#pragma unroll
    for (int j = 0; j < 4; ++j) { const int n = (lane >> 3) + 8 * j; const LAS float* s = scr + (8 * c) * 33 + n;
        u32x4 o; o.x = pk2(s[0 * 33], s[1 * 33]); o.y = pk2(s[2 * 33], s[3 * 33]); o.z = pk2(s[4 * 33], s[5 * 33]); o.w = pk2(s[6 * 33], s[7 * 33]);
        const int dr = map(n0 + n);
        *(GAS u32x4*)(WT + (size_t)dr * ldk + k0 + 8 * c) = o; }
    asm volatile("s_waitcnt lgkmcnt(0)" ::: "memory");
}
__host__ __device__ __forceinline__ int rope_virt(int rho) { const int n = rho >> 4, fq = (rho & 15) >> 2, i = rho & 3; return 8 * fq + 4 * n + i; }
struct MapIn  { __device__ __forceinline__ int operator()(int n) const { if (n < 384) return n; if (n < 640) return n + 128; if (n < 672) return 384 + rope_virt(n - 640); return n + 96; } };
struct MapQup { __device__ __forceinline__ int operator()(int n) const { const int h = n / 96, w = n - h * 96; return w < 64 ? n : h * 96 + 64 + rope_virt(w - 64); } };
struct MapId  { __device__ __forceinline__ int operator()(int n) const { return n; } };
struct MapW13 { int half; __device__ __forceinline__ int operator()(int n) const { return 256 * (n >> 7) + 128 * half + (n & 127); } };

struct Args {
    const float* x; const float* c; const int* pos; const float* w_ada; const float* b_ada; const float* w_in; const float* q_norm_g; const float* w_q_up; const float* kv_norm_g; const float* w_kv_up;
    const float* lq1; const float* lk1; const float* lq2; const float* lk2; const float* diff_norm_g; const float* w_br_mla; const float* w_br_diff; const float* w_out;
    const float* ln1_g; const float* ln1_b; const float* ln2_g; const float* ln2_b; const float* ffn_w1; const float* ffn_w3; const float* ffn_w2; const float* router_w; const float* router_b;
    const float* moe_w1; const float* moe_w3; const float* moe_w2;
    float* out; unsigned char* ws; int ph_lo, ph_hi; float lam_init[4];
};

typedef const __attribute__((address_space(4))) Args* KArgP;
__device__ __forceinline__ KArgP kargs() { KArgP p = (KArgP)__builtin_amdgcn_kernarg_segment_ptr(); asm volatile("" : "+s"(p)); return p; }
struct Ctx { LAS unsigned char* lds; int tid, lane, wave, vcu, G; unsigned char* ws; };

__device__ __forceinline__ void cvt_mixer_weights(const Ctx& C, int l) {
    KArgP a = kargs();
    LAS float* scr = (LAS float*)(C.lds + C.wave * 8448);
    const int gw = C.vcu * NWAVES + C.wave, NGW = C.G * NWAVES;
    constexpr int I_IN = 16 * 181, I_QUP = 6 * 24, I_KVUP = 4 * 32, I_BRM = 8 * 32, I_BRD = 16 * 32, I_OUT = 16 * 32;
    constexpr int NIT = I_IN + I_QUP + I_KVUP + I_BRM + I_BRD + I_OUT;
    unsigned char* ws = C.ws;
    for (int it = gw; it < NIT; it += NGW) {
        int r = it;
        if (r < I_IN) { transpose_item(a->w_in + (size_t)l * 1024 * 5792, 5792, (bf16_t*)(ws + W_IN), 1024, nullptr, scr, r / 181, r % 181, C.lane, MapIn{}); continue; } r -= I_IN;
        if (r < I_QUP) { transpose_item(a->w_q_up + (size_t)l * 384 * 768, 768, (bf16_t*)(ws + W_QUP), 384, a->q_norm_g + l * 384, scr, r / 24, r % 24, C.lane, MapQup{}); continue; } r -= I_QUP;
        if (r < I_KVUP) { transpose_item(a->w_kv_up + (size_t)l * 256 * 1024, 1024, (bf16_t*)(ws + W_KVUP), 256, a->kv_norm_g + l * 256, scr, r / 32, r % 32, C.lane, MapId{}); continue; } r -= I_KVUP;
        if (r < I_BRM) { transpose_item(a->w_br_mla + (size_t)l * 512 * 1024, 1024, (bf16_t*)(ws + W_BRM), 512, nullptr, scr, r / 32, r % 32, C.lane, MapId{}); continue; } r -= I_BRM;
        if (r < I_BRD) { transpose_item(a->w_br_diff + (size_t)l * 1024 * 1024, 1024, (bf16_t*)(ws + W_BRD), 1024, nullptr, scr, r / 32, r % 32, C.lane, MapId{}); continue; } r -= I_BRD;
        transpose_item(a->w_out + (size_t)l * 1024 * 1024, 1024, (bf16_t*)(ws + W_OUT), 1024, nullptr, scr, r / 32, r % 32, C.lane, MapId{});
    }
}
__device__ __forceinline__ void cvt_ffn_weights(const Ctx& C, int l) {
    KArgP a = kargs();
    LAS float* scr = (LAS float*)(C.lds + C.wave * 8448);
    const int gw = C.vcu * NWAVES + C.wave, NGW = C.G * NWAVES;
    constexpr int I_W1 = 16 * 88, I_W2 = 44 * 32, I_E = 2 * I_W1 + I_W2;
    unsigned char* ws = C.ws;
    const bool moe = (l & 1) != 0; const int li = l >> 1;
    const int nE = moe ? NEXP : 1;
    const float* w1 = moe ? a->moe_w1 + (size_t)li * NEXP * 1024 * FF : a->ffn_w1 + (size_t)li * 1024 * FF;
    const float* w3 = moe ? a->moe_w3 + (size_t)li * NEXP * 1024 * FF : a->ffn_w3 + (size_t)li * 1024 * FF;
    const float* w2 = moe ? a->moe_w2 + (size_t)li * NEXP * 1024 * FF : a->ffn_w2 + (size_t)li * 1024 * FF;
    for (int it = gw; it < nE * I_E; it += NGW) {
        const int e = it / I_E; int r = it - e * I_E;
        bf16_t* d13 = (bf16_t*)(ws + WS_WFF + (size_t)e * W13_ESTRIDE); bf16_t* d2 = (bf16_t*)(ws + W2_BASE + (size_t)e * W2_ESTRIDE);
        const size_t eo = (size_t)e * 1024 * FF;
        if (r < I_W1) { transpose_item(w1 + eo, FF, d13, 1024, nullptr, scr, r / 88, r % 88, C.lane, MapW13{0}); continue; } r -= I_W1;
        if (r < I_W1) { transpose_item(w3 + eo, FF, d13, 1024, nullptr, scr, r / 88, r % 88, C.lane, MapW13{1}); continue; } r -= I_W1;
        transpose_item(w2 + eo, 1024, d2, FF, nullptr, scr, r / 32, r % 32, C.lane, MapId{});
    }
}

struct FIn {
    bf16_t* LAT; bf16_t* ZB; bf16_t* KM; float* RSQ; const float* COS; const float* SIN;
    __device__ __forceinline__ float rowscale(int) const { return 1.f; }
    __device__ __forceinline__ void operator()(int row, float rs, int cb, int fq, f32x4 v0, f32x4 v1) const {
        if (cb < 384 || (cb >= 512 && cb < 768)) {
            *(u32x4*)(LAT + (size_t)row * 768 + cb + 8 * fq) = pack8(v0, v1);
            float ss = (v0[0] * v0[0] + v0[1] * v0[1]) + (v0[2] * v0[2] + v0[3] * v0[3]) + (v1[0] * v1[0] + v1[1] * v1[1]) + (v1[2] * v1[2] + v1[3] * v1[3]);
            ss += swz_xor<16>(ss); ss = sum_x32(ss);
            const int slot = cb < 384 ? (cb >> 5) : 12 + ((cb - 512) >> 5);
            if (fq == 0) RSQ[(size_t)row * 24 + slot] = ss;
        } else if (cb < 416) {
            const f32x4 cs = *(const f32x4*)(COS + (size_t)row * 16 + 4 * fq), sn = *(const f32x4*)(SIN + (size_t)row * 16 + 4 * fq);
            const f32x4 o1 = v0 * cs - v1 * sn, o2 = v0 * sn + v1 * cs;
            const u32x4 w = pack8(o1, o2);
#pragma unroll
            for (int h = 0; h < 8; ++h) *(u32x4*)(KM + (size_t)row * 768 + h * 96 + 64 + 8 * fq) = w;
        } else if (cb >= 768) {
            const int g = (cb - 768) >> 10, c = (cb - 768) & 1023;
            if (g == 0) { v0 = v0 * CQ_DIFF; v1 = v1 * CQ_DIFF; }
            if (g >= 3) {
#pragma unroll
                for (int i = 0; i < 4; ++i) { v0[i] = sigmoidf_(v0[i]); v1[i] = sigmoidf_(v1[i]); } }
            *(u32x4*)(ZB + (size_t)g * T * 1024 + (size_t)row * 1024 + c + 8 * fq) = pack8(v0, v1);
        }
    }
};
struct FQup {
    bf16_t* QM; const float* RSQ; const float* COS; const float* SIN;
    __device__ __forceinline__ float rowscale(int row) const {
        const f32x4 a = *(const f32x4*)(RSQ + (size_t)row * 24), b = *(const f32x4*)(RSQ + (size_t)row * 24 + 4), c = *(const f32x4*)(RSQ + (size_t)row * 24 + 8);
        const float ss = ((a[0] + a[1]) + (a[2] + a[3])) + ((b[0] + b[1]) + (b[2] + b[3])) + ((c[0] + c[1]) + (c[2] + c[3]));
        return CQ_MLA * __builtin_amdgcn_rsqf(ss * (1.0f / 384.0f) + RMS_EPS); }
    __device__ __forceinline__ void operator()(int row, float r, int cb, int fq, f32x4 v0, f32x4 v1) const {
        v0 = v0 * r; v1 = v1 * r;
        if ((cb % 96) == 64) {
            const f32x4 cs = *(const f32x4*)(COS + (size_t)row * 16 + 4 * fq), sn = *(const f32x4*)(SIN + (size_t)row * 16 + 4 * fq);
            const f32x4 o1 = v0 * cs - v1 * sn, o2 = v0 * sn + v1 * cs; v0 = o1; v1 = o2;
        }
        *(u32x4*)(QM + (size_t)row * 768 + cb + 8 * fq) = pack8(v0, v1);
    }
};
struct FKVup {
    bf16_t* KM; bf16_t* VM; const float* RSQ;
    __device__ __forceinline__ float rowscale(int row) const {
        const f32x4 a = *(const f32x4*)(RSQ + (size_t)row * 24 + 12), b = *(const f32x4*)(RSQ + (size_t)row * 24 + 16);
        const float ss = ((a[0] + a[1]) + (a[2] + a[3])) + ((b[0] + b[1]) + (b[2] + b[3]));
        return __builtin_amdgcn_rsqf(ss * (1.0f / 256.0f) + RMS_EPS); }
    __device__ __forceinline__ void operator()(int row, float r, int cb, int fq, f32x4 v0, f32x4 v1) const {
        v0 = v0 * r; v1 = v1 * r;
        const int h = cb >> 7, w = cb & 127;
        if (w < 64) *(u32x4*)(KM + (size_t)row * 768 + h * 96 + w + 8 * fq) = pack8(v0, v1);
        else *(u32x4*)(VM + (size_t)row * 512 + h * 64 + (w - 64) + 8 * fq) = pack8(v0, v1);
    }
};
struct FBr1 {
    bf16_t* T1; const bf16_t* SA;
    __device__ __forceinline__ float rowscale(int) const { return 1.f; }
    __device__ __forceinline__ void operator()(int row, float rs, int cb, int fq, f32x4 v0, f32x4 v1) const {
        const size_t o = (size_t)row * 1024 + cb + 8 * fq; f32x4 s0, s1; unpack8(*(const u32x4*)(SA + o), s0, s1);
        *(u32x4*)(T1 + o) = pack8(v0 * s0, v1 * s1);
    }
};
struct FBr2 {
    bf16_t* MB; const bf16_t* T1; const bf16_t* SB;
    __device__ __forceinline__ float rowscale(int) const { return 1.f; }
    __device__ __forceinline__ void operator()(int row, float rs, int cb, int fq, f32x4 v0, f32x4 v1) const {
        const size_t o = (size_t)row * 1024 + cb + 8 * fq; f32x4 s0, s1, t0, t1; unpack8(*(const u32x4*)(SB + o), s0, s1); unpack8(*(const u32x4*)(T1 + o), t0, t1);
        *(u32x4*)(MB + o) = pack8(t0 + v0 * s0, t1 + v1 * s1);
    }
};
struct FRes {
    float* PRE; const float* X; const float* gate;
    __device__ __forceinline__ float rowscale(int) const { return 1.f; }
    __device__ __forceinline__ void operator()(int row, float rs, int cb, int fq, f32x4 v0, f32x4 v1) const {
        const int b = row >> 11; const float* gp = gate + (size_t)b * 6144 + cb + 4 * fq;
        const size_t o = (size_t)row * 1024 + cb + 4 * fq;
        const f32x4 g0 = *(const f32x4*)gp, g1 = *(const f32x4*)(gp + 16), x0 = *(const f32x4*)(X + o), x1 = *(const f32x4*)(X + o + 16);
        *(f32x4*)(PRE + o) = x0 * ALPHA + g0 * v0; *(f32x4*)(PRE + o + 16) = x1 * ALPHA + g1 * v1;
    }
};
struct FMoeOut {
    bf16_t* Y; const int* RMAP;
    __device__ __forceinline__ float rowscale(int) const { return 1.f; }
    __device__ __forceinline__ void operator()(int row, float rs, int cb, int fq, f32x4 v0, f32x4 v1) const {
        const int s = RMAP[row];
        if (s >= 0) *(u32x4*)(Y + (size_t)s * 1024 + cb + 8 * fq) = pack8(v0, v1);
    }
};

template <int MODE, bool ROUTE>
__device__ __forceinline__ void ln_phase(const Ctx& C, const float* PRE, float* XF, bf16_t* H, const float* lng, const float* lnb, const float* sc, const float* sh,
                                         const bf16_t* Y, const float* GATE, const float* g2, const float* rw, const float* rb, int* SEL, float* GOUT, unsigned* CNT) {
    int lane_ = C.lane; asm volatile("" : "+v"(lane_)); const int lane = lane_; const int wg = blockIdx.x; const int b = (wg * 128) >> 11;
    f32x4 vg[4], vb[4], vsc[4], vsh[4], vg2[4];
#pragma unroll
    for (int j = 0; j < 4; ++j) { const int c = 4 * lane + 256 * j; vg[j] = *(const f32x4*)(lng + c); vb[j] = *(const f32x4*)(lnb + c);
        if (sc) { vsc[j] = *(const f32x4*)(sc + (size_t)b * 6144 + c) + 1.0f; vsh[j] = *(const f32x4*)(sh + (size_t)b * 6144 + c); }
        if (MODE == 1) vg2[j] = *(const f32x4*)(g2 + (size_t)b * 6144 + c); }
    LAS float* rwl = (LAS float*)C.lds;
    LAS unsigned* hist = (LAS unsigned*)(C.lds + 32768);
    if (ROUTE) { for (int i = C.tid; i < 8192; i += NWAVES * 64) rwl[i] = rw[i]; if (C.tid < 8) hist[C.tid] = 0u; __syncthreads(); }
    for (int rr = 0; rr < 16; ++rr) {
        const int row = wg * 128 + C.wave * 16 + rr;
        f32x4 v[4];
        if (MODE == 0) {
#pragma unroll
            for (int j = 0; j < 4; ++j) v[j] = *(const f32x4*)(PRE + (size_t)row * 1024 + 4 * lane + 256 * j);
        } else {
            const float ga = GATE[2 * row], gb = GATE[2 * row + 1];
#pragma unroll
            for (int j = 0; j < 4; ++j) { const int c = 4 * lane + 256 * j; const f32x4 xv = *(const f32x4*)(XF + (size_t)row * 1024 + c);
                const u32x2 ya = *(const u32x2*)(Y + (size_t)(2 * row) * 1024 + c), yb = *(const u32x2*)(Y + (size_t)(2 * row + 1) * 1024 + c);
                f32x4 fa, fb; fa[0] = __uint_as_float(ya.x << 16); fa[1] = __uint_as_float(ya.x & 0xffff0000u); fa[2] = __uint_as_float(ya.y << 16); fa[3] = __uint_as_float(ya.y & 0xffff0000u);
                fb[0] = __uint_as_float(yb.x << 16); fb[1] = __uint_as_float(yb.x & 0xffff0000u); fb[2] = __uint_as_float(yb.y << 16); fb[3] = __uint_as_float(yb.y & 0xffff0000u);
                v[j] = xv * ALPHA + vg2[j] * (fa * ga + fb * gb); }
        }
        float s = 0.f;
#pragma unroll
        for (int j = 0; j < 4; ++j) s += (v[j][0] + v[j][1]) + (v[j][2] + v[j][3]);
        const float mean = wave_sum(s) * (1.f / 1024.f); float s2 = 0.f;
#pragma unroll
        for (int j = 0; j < 4; ++j) { v[j] = v[j] - mean; s2 += (v[j][0] * v[j][0] + v[j][1] * v[j][1]) + (v[j][2] * v[j][2] + v[j][3] * v[j][3]); }
        const float rstd = 1.f / sqrtf(wave_sum(s2) * (1.f / 1024.f) + LN_EPS);
        float lg[8];
        if (ROUTE) {
#pragma unroll
            for (int e = 0; e < 8; ++e) lg[e] = 0.f; }
#pragma unroll
        for (int j = 0; j < 4; ++j) { const int c = 4 * lane + 256 * j; const f32x4 y = v[j] * rstd * vg[j] + vb[j];
            *(f32x4*)(XF + (size_t)row * 1024 + c) = y;
            if (sc) { const f32x4 hh = y * vsc[j] + vsh[j];
                u32x2 w; w.x = cvt_pk_bf16(hh[0], hh[1]); w.y = cvt_pk_bf16(hh[2], hh[3]); *(u32x2*)(H + (size_t)row * 1024 + c) = w;
                if (ROUTE) {
#pragma unroll
                    for (int i = 0; i < 4; ++i) { const f32x4 w0 = *(const LAS f32x4*)(rwl + (c + i) * 8), w1 = *(const LAS f32x4*)(rwl + (c + i) * 8 + 4);
#pragma unroll
                        for (int e = 0; e < 4; ++e) { lg[e] += hh[i] * w0[e]; lg[4 + e] += hh[i] * w1[e]; } } } } }
        if (ROUTE) {
#pragma unroll
            for (int e = 0; e < 8; ++e) lg[e] = wave_sum(lg[e]) + rb[e];
            int i0 = 0; float m0 = lg[0];
#pragma unroll
            for (int e = 1; e < 8; ++e) if (lg[e] > m0) { m0 = lg[e]; i0 = e; }
            int i1 = -1; float m1 = -INFINITY;
#pragma unroll
            for (int e = 0; e < 8; ++e) if (e != i0 && lg[e] > m1) { m1 = lg[e]; i1 = e; }
            const float g0 = 1.0f / (1.0f + expf(m1 - m0));
            if (lane == 0) { SEL[row] = i0 | (i1 << 8); GOUT[2 * row] = g0; GOUT[2 * row + 1] = 1.0f - g0; atomicAdd((unsigned*)&hist[i0], 1u); atomicAdd((unsigned*)&hist[i1], 1u); }
        }
    }
    if (ROUTE) { __syncthreads(); if (C.tid < 8) atomicAdd(CNT + C.tid, (unsigned)hist[C.tid]); }
}

constexpr int NPH_L = 10, NPHASE = 2 + DEPTH * NPH_L;
#ifndef LB2
#define LB2 2
#endif
__global__ void __launch_bounds__(NWAVES * 64, LB2) mk_fwd(Args args) {
    extern __shared__ __attribute__((aligned(16))) unsigned char lds[];
    const int wave0 = __builtin_amdgcn_readfirstlane((int)threadIdx.x >> 6);
    Ctx C; C.lds = (LAS unsigned char*)lds; C.wave = wave0; C.lane = (int)__builtin_amdgcn_mbcnt_hi(~0u, __builtin_amdgcn_mbcnt_lo(~0u, 0u)); C.tid = wave0 * 64 + C.lane;
    C.G = gridDim.x; { const int bx = blockIdx.x; C.vcu = (C.G % 8 == 0) ? (bx % 8) * (C.G / 8) + bx / 8 : bx; }
    KArgP ka0 = kargs();
    unsigned* const ctl0 = (unsigned*)(ka0->ws + WS_CTL);
    volatile LAS unsigned* MISC = (volatile LAS unsigned*)(C.lds + MISC_OFF);
    for (int u = C.tid; u < (LDS_BYTES - LDSCTL_OFF) / 4; u += NWAVES * 64) ((LAS unsigned*)(C.lds + LDSCTL_OFF))[u] = 0u;
    __syncthreads();
    XcdBarrier bar; bar.bar = ctl0 + CW_BAR; bar.x = 0; bar.st = nullptr;
    if (!MK_PER_PHASE) bar = xcd_barrier_post(ctl0 + CW_BAR, MISC + 8, C.tid == 0);
    const int lo = ka0->ph_lo, hi = ka0->ph_hi;
#define FRESH() do { int l_; asm volatile("v_mbcnt_lo_u32_b32 %0, -1, 0\n\tv_mbcnt_hi_u32_b32 %0, -1, %0" : "=v"(l_)); C.lane = l_; C.wave = wave0; C.tid = wave0 * 64 + l_; } while (0)
#define IN(k) (lo <= (k) && (k) < hi)
#define SEAM(k) do { if (IN((k) + 1)) { FRESH(); xcd_barrier(bar, C.tid == 0); } } while (0)
#define MOD ((float*)(ws + WS_MOD))
#define PART ((float*)(ws + WS_PART))
#define RSQ ((float*)(ws + WS_RSQ))
#define COS ((float*)(ws + WS_COS))
#define SIN ((float*)(ws + WS_SIN))
#define H ((bf16_t*)(ws + WS_H))
#define LAT ((bf16_t*)(ws + WS_LAT))
#define ZB ((bf16_t*)(ws + WS_ZB))
#define QM ((bf16_t*)(ws + WS_QM))
#define KM ((bf16_t*)(ws + WS_KM))
#define VM ((bf16_t*)(ws + WS_VM))
#define OM ((bf16_t*)(ws + WS_OM))
#define PRE ((float*)(ws + WS_PRE))
#define T1 ((bf16_t*)(ws + WS_T1))
#define MB ((bf16_t*)(ws + WS_MB))
#define DQ (ZB)
#define DK (ZB + (size_t)T * 1024)
#define DV (ZB + (size_t)2 * T * 1024)
#define SA (ZB + (size_t)3 * T * 1024)
#define SB (ZB + (size_t)4 * T * 1024)
#define XF (ka->out)
#define ctl ((unsigned*)(ws + WS_CTL))
#define gw (C.vcu * NWAVES + C.wave)
#define NGW (C.G * NWAVES)

    if (PHM(10) && IN(0)) { KArgP ka = kargs(); (void)ka; FRESH(); unsigned char* const ws = ka->ws; C.ws = ws;
        cvt_mixer_weights(C, 0); cvt_ffn_weights(C, 0);
        LAS float* cond = (LAS float*)(C.lds + C.wave * 8448);
        for (int it = gw; it < 4 * 24 * 8; it += NGW) {
            const int kc = it & 7, jb = (it >> 3) % 24, l = it / (8 * 24);
            for (int i = C.lane; i < 2048; i += 64) { const int k = i >> 4, b = i & 15; const float cv = ka->c[b * 1024 + kc * 128 + k]; cond[k * 16 + b] = cv / (1.0f + expf(-cv)); }
            asm volatile("s_waitcnt lgkmcnt(0)" ::: "memory");
            f32x4 acc[16];
#pragma unroll
            for (int b = 0; b < 16; ++b) acc[b] = (f32x4){0.f, 0.f, 0.f, 0.f};
            const float* wp = ka->w_ada + ((size_t)l * 1024 + kc * 128) * 6144 + jb * 256 + 4 * C.lane;
#pragma unroll 4
            for (int k = 0; k < 128; ++k) { const f32x4 w = *(const f32x4*)(wp + (size_t)k * 6144);
                const f32x4 c0 = *(const LAS f32x4*)(cond + k * 16), c1 = *(const LAS f32x4*)(cond + k * 16 + 4), c2 = *(const LAS f32x4*)(cond + k * 16 + 8), c3 = *(const LAS f32x4*)(cond + k * 16 + 12);
#pragma unroll
                for (int b = 0; b < 4; ++b) { acc[b] += w * c0[b]; acc[4 + b] += w * c1[b]; acc[8 + b] += w * c2[b]; acc[12 + b] += w * c3[b]; } }
#pragma unroll
            for (int b = 0; b < 16; ++b) *(f32x4*)(PART + (((size_t)kc * 4 + l) * 16 + b) * 6144 + jb * 256 + 4 * C.lane) = acc[b];
            asm volatile("s_waitcnt lgkmcnt(0)" ::: "memory");
        }
        for (int i = blockIdx.x * (NWAVES * 64) + C.tid; i < T * 16; i += C.G * NWAVES * 64) {
            const int t = i >> 4, j = i & 15; const float inv = powf(10000.0f, -(float)j * (1.0f / 16.0f)); const float ang = (float)ka->pos[t] * inv;
            COS[i] = cosf(ang); SIN[i] = sinf(ang); }
        SEAM(0);
    }
    if (PHM(11) && IN(1)) { KArgP ka = kargs(); (void)ka; FRESH(); unsigned char* const ws = ka->ws; C.ws = ws;
        for (int i = blockIdx.x * (NWAVES * 64) + C.tid; i < 4 * 16 * 6144; i += C.G * NWAVES * 64) {
            const int j = i % 6144, l = i / (16 * 6144); float s = ka->b_ada[l * 6144 + j];
#pragma unroll
            for (int kc = 0; kc < 8; ++kc) s += PART[(size_t)kc * 4 * 16 * 6144 + i];
            MOD[i] = s; }
        { const int wg = blockIdx.x, b = (wg * 128) >> 11; f32x4 vsc[4], vsh[4];
#pragma unroll
          for (int j = 0; j < 4; ++j) { const int c = 4 * C.lane + 256 * j; f32x4 a = *(const f32x4*)(ka->b_ada + c), s = *(const f32x4*)(ka->b_ada + 1024 + c);
#pragma unroll
              for (int kc = 0; kc < 8; ++kc) { const float* p = PART + (((size_t)kc * 4 + 0) * 16 + b) * 6144; a += *(const f32x4*)(p + c); s += *(const f32x4*)(p + 1024 + c); }
              vsh[j] = a; vsc[j] = s + 1.0f; }
          for (int rr = 0; rr < 16; ++rr) { const int row = wg * 128 + C.wave * 16 + rr;
#pragma unroll
              for (int j = 0; j < 4; ++j) { const int c = 4 * C.lane + 256 * j; const f32x4 xv = *(const f32x4*)(ka->x + (size_t)row * 1024 + c); const f32x4 hh = xv * vsc[j] + vsh[j];
                  u32x2 w; w.x = cvt_pk_bf16(hh[0], hh[1]); w.y = cvt_pk_bf16(hh[2], hh[3]); *(u32x2*)(H + (size_t)row * 1024 + c) = w; } } }
        SEAM(1);
    }

    for (int l = 0; l < DEPTH; ++l) {
        const int P = 2 + l * NPH_L;
        const bool moe = (l & 1) != 0; const int li = l >> 1;
        if (PHM(0) && IN(P + 0)) { KArgP ka = kargs(); (void)ka; FRESH(); unsigned char* const ws = ka->ws; C.ws = ws;
            pg8::Gemm g{H, (const bf16_t*)(ws + W_IN), T, NZ, 1024, 1024}; pg8::StaticOrder S; S.init(T, NZ, C.G, (int)blockIdx.x);
            pg8::EpiRow<FIn, true> E{FIn{LAT, ZB, KM, RSQ, COS, SIN}};
            pg8::gemm_phase(C.lds, C.tid, g, S, E);
            SEAM(P + 0);
        }
        if (PHM(1) && IN(P + 1)) { KArgP ka = kargs(); (void)ka; FRESH(); unsigned char* const ws = ka->ws; C.ws = ws;
            { pg8::Gemm g{LAT, (const bf16_t*)(ws + W_QUP), T, 768, 384, 768}; pg8::StaticOrder S; S.init(T, 768, C.G, (int)blockIdx.x);
              pg8::EpiRow<FQup, true> E{FQup{QM, RSQ, COS, SIN}}; pg8::gemm_phase(C.lds, C.tid, g, S, E); }
            { pg8::Gemm g{LAT + 512, (const bf16_t*)(ws + W_KVUP), T, 1024, 256, 768}; pg8::StaticOrder S; S.init(T, 1024, C.G, (int)blockIdx.x);
              pg8::EpiRow<FKVup, true> E{FKVup{KM, VM, RSQ}}; pg8::gemm_phase(C.lds, C.tid, g, S, E); }
            SEAM(P + 1);
        }
        if (PHM(2) && IN(P + 2)) { KArgP ka = kargs(); (void)ka; FRESH(); unsigned char* const ws = ka->ws; C.ws = ws;
            float lam;
            { float s1 = 0.f, s2 = 0.f;
              for (int i = 0; i < 64; ++i) { s1 += ka->lq1[l * 64 + i] * ka->lk1[l * 64 + i]; s2 += ka->lq2[l * 64 + i] * ka->lk2[l * 64 + i]; }
              lam = expf(s1) - expf(s2) + ka->lam_init[l]; }
            const int xcd = C.vcu >> 5, jj = C.vcu & 31; const bool g256 = (C.G == 256);
            for (int i = 0; ; ++i) {
                int u; if (g256) { if (i >= 4) break; u = xcd * 128 + i * 32 + jj; } else { u = i * C.G + C.vcu; if (u >= 1024) break; }
                const int bh = u >> 3, qb = u & 7, b = bh >> 3, h = bh & 7; const size_t r0 = (size_t)b * SEQ;
                att::DiffArgs da{nullptr, 0.f, 0.f, 0.f, nullptr};
                att::attn_unit<false>(QM + (r0 + qb * 256) * 768 + h * 96, KM + r0 * 768 + h * 96, VM + r0 * 512 + h * 64, OM + (r0 + qb * 256) * 512 + h * 64, qb * 256, da, (char*)lds, C.tid);
            }
            for (int i = 0; ; ++i) {
                int u; if (g256) { if (i >= 8) break; u = xcd * 256 + i * 32 + jj; } else { u = i * C.G + C.vcu; if (u >= 2048) break; }
                const int bh = u >> 4, qb = u & 15, b = bh >> 3, h = bh & 7; const size_t r0 = (size_t)b * SEQ;
                att::DiffArgs da{ka->pos + r0, exp2f(-(float)(h + 1)) * LOG2E, lam, 1.0f - ka->lam_init[l], ka->diff_norm_g + l * 1024 + h * 128};
                att::attn_unit<true>(DQ + (r0 + qb * 128) * 1024 + h * 128, DK + r0 * 1024 + h * 128, DV + r0 * 1024 + h * 128, DQ + (r0 + qb * 128) * 1024 + h * 128, qb * 128, da, (char*)lds, C.tid);
            }
            SEAM(P + 2);
        }
        if (PHM(3) && IN(P + 3)) { KArgP ka = kargs(); (void)ka; FRESH(); unsigned char* const ws = ka->ws; C.ws = ws;
            { pg8::Gemm g{OM, (const bf16_t*)(ws + W_BRM), T, 1024, 512, 512}; pg8::StaticOrder S; S.init(T, 1024, C.G, (int)blockIdx.x);
              pg8::EpiRow<FBr1, true> E{FBr1{T1, SA}}; pg8::gemm_phase(C.lds, C.tid, g, S, E); }
            asm volatile("s_waitcnt vmcnt(0)" ::: "memory"); __syncthreads();
            { pg8::Gemm g{DQ, (const bf16_t*)(ws + W_BRD), T, 1024, 1024, 1024}; pg8::StaticOrder S; S.init(T, 1024, C.G, (int)blockIdx.x);
              pg8::EpiRow<FBr2, true> E{FBr2{MB, T1, SB}}; pg8::gemm_phase(C.lds, C.tid, g, S, E); }
            SEAM(P + 3);
        }
        if (PHM(4) && IN(P + 4)) { KArgP ka = kargs(); (void)ka; FRESH(); unsigned char* const ws = ka->ws; C.ws = ws;
            pg8::Gemm g{MB, (const bf16_t*)(ws + W_OUT), T, 1024, 1024, 1024}; pg8::StaticOrder S; S.init(T, 1024, C.G, (int)blockIdx.x);
            const float* xres = (l == 0) ? ka->x : XF;
            pg8::EpiRow<FRes, false> E{FRes{PRE, xres, (MOD + (size_t)l * 16 * 6144) + 2048}}; pg8::gemm_phase(C.lds, C.tid, g, S, E);
            SEAM(P + 4);
        }
        if (PHM(5) && IN(P + 5)) { KArgP ka = kargs(); (void)ka; FRESH(); unsigned char* const ws = ka->ws; C.ws = ws;
            if (moe) ln_phase<0, true>(C, PRE, XF, H, ka->ln1_g + l * 1024, ka->ln1_b + l * 1024, (MOD + (size_t)l * 16 * 6144) + 4096, (MOD + (size_t)l * 16 * 6144) + 3072, nullptr, nullptr, nullptr,
                                       ka->router_w + (size_t)li * 8192, ka->router_b + li * 8, (int*)(ws + WS_SEL), (float*)(ws + WS_GATE), ctl + CW_CNT + 64 * li);
            else ln_phase<0, false>(C, PRE, XF, H, ka->ln1_g + l * 1024, ka->ln1_b + l * 1024, (MOD + (size_t)l * 16 * 6144) + 4096, (MOD + (size_t)l * 16 * 6144) + 3072, nullptr, nullptr, nullptr, nullptr, nullptr, nullptr, nullptr, nullptr);
            SEAM(P + 5);
        }
        int ts[9];
#pragma unroll
        for (int e = 0; e < 9; ++e) ts[e] = 0;
        if (moe && (IN(P + 6) || IN(P + 7) || IN(P + 8))) { KArgP ka = kargs(); unsigned char* const ws = ka->ws;
            int accp = 0;
#pragma unroll
            for (int e = 0; e < 8; ++e) { ts[e] = accp; const int cnt = (int)__hip_atomic_load(ctl + CW_CNT + 64 * li + e, __ATOMIC_RELAXED, __HIP_MEMORY_SCOPE_AGENT); accp += (cnt + 255) >> 8; }
            ts[8] = accp;
        }
        if (PHM(6) && IN(P + 6)) { KArgP ka = kargs(); (void)ka; FRESH(); unsigned char* const ws = ka->ws; C.ws = ws;
            if (moe) {
                const int* SEL = (const int*)(ws + WS_SEL); int* RMAP = (int*)(ws + WS_RMAP); bf16_t* XB = (bf16_t*)(ws + WS_XB);
                unsigned* CUR = ctl + CW_CUR + 64 * li; const unsigned* CNT = ctl + CW_CNT + 64 * li;
                if (blockIdx.x == 0) {
                    _Pragma("unroll") for (int e = 0; e < 8; ++e) { const int c = (int)CNT[e], beg = ts[e] * 256 + c, end = ts[e + 1] * 256; for (int p = beg + C.tid; p < end; p += NWAVES * 64) RMAP[p] = -1; } }
                for (int s0 = gw * 64; s0 < 2 * T; s0 += NGW * 64) {
                    const int s = s0 + C.lane, t = s >> 1, k = s & 1; const int sel = SEL[t]; const int e = k ? (sel >> 8) : (sel & 255);
                    int pos = 0;
#pragma unroll
                    for (int ee = 0; ee < 8; ++ee) { const unsigned long long m = __ballot(e == ee); const int n = __popcll(m);
                        if (n) { unsigned base = 0; if (C.lane == 0) base = atomicAdd(CUR + ee, (unsigned)n); base = __builtin_amdgcn_readfirstlane(base);
                            if (e == ee) pos = ts[ee] * 256 + (int)base + (int)__builtin_amdgcn_mbcnt_hi((unsigned)(m >> 32), __builtin_amdgcn_mbcnt_lo((unsigned)m, 0u)); } }
                    RMAP[pos] = s;
                    for (int q = 0; q < 64; ++q) { const int pq = __builtin_amdgcn_readlane(pos, q), tq = (s0 + q) >> 1;
                        const u32x4* src = (const u32x4*)(H + (size_t)tq * 1024); u32x4* dst = (u32x4*)(XB + (size_t)pq * 1024);
                        dst[C.lane] = src[C.lane]; dst[64 + C.lane] = src[64 + C.lane]; }
                }
            }
            if (moe) SEAM(P + 6);
        }
        if (PHM(7) && IN(P + 7)) { KArgP ka = kargs(); (void)ka; FRESH(); unsigned char* const ws = ka->ws; C.ws = ws;
            if (!moe) { pg8::Gemm g{H, (const bf16_t*)(ws + WS_WFF), T, 5632, 1024, 1024}; pg8::StaticOrder S; S.init(T, 5632, C.G, (int)blockIdx.x);
                pg8::EpiSwiglu E{(bf16_t*)(ws + WS_U), FF}; pg8::gemm_phase(C.lds, C.tid, g, S, E); }
            else { pg8::Gemm g{(const bf16_t*)(ws + WS_XB), (const bf16_t*)(ws + WS_WFF), ts[8] * 256, 5632, 1024, 1024};
                pg8::MoeOrder S; S.so.init(ts[8] * 256, 5632, C.G, (int)blockIdx.x); S.ts1 = ts[1]; S.ts2 = ts[2]; S.ts3 = ts[3]; S.ts4 = ts[4]; S.ts5 = ts[5]; S.ts6 = ts[6]; S.ts7 = ts[7]; S.estride = W13_ESTRIDE;
                pg8::EpiSwiglu E{(bf16_t*)(ws + WS_UM), FF}; pg8::gemm_phase(C.lds, C.tid, g, S, E); }
            SEAM(P + 7);
        }
        if (PHM(8) && IN(P + 8)) { KArgP ka = kargs(); (void)ka; FRESH(); unsigned char* const ws = ka->ws; C.ws = ws;
            if (!moe) { pg8::Gemm g{(const bf16_t*)(ws + WS_U), (const bf16_t*)(ws + W2_BASE), T, 1024, FF, FF}; pg8::StaticOrder S; S.init(T, 1024, C.G, (int)blockIdx.x);
                pg8::EpiRow<FRes, false> E{FRes{PRE, XF, (MOD + (size_t)l * 16 * 6144) + 5120}}; pg8::gemm_phase(C.lds, C.tid, g, S, E); }
            else { pg8::Gemm g{(const bf16_t*)(ws + WS_UM), (const bf16_t*)(ws + W2_BASE), ts[8] * 256, 1024, FF, FF};
                pg8::MoeOrder S; S.so.init(ts[8] * 256, 1024, C.G, (int)blockIdx.x); S.ts1 = ts[1]; S.ts2 = ts[2]; S.ts3 = ts[3]; S.ts4 = ts[4]; S.ts5 = ts[5]; S.ts6 = ts[6]; S.ts7 = ts[7]; S.estride = W2_ESTRIDE;
                pg8::EpiRow<FMoeOut, true> E{FMoeOut{(bf16_t*)(ws + WS_Y), (const int*)(ws + WS_RMAP)}}; pg8::gemm_phase(C.lds, C.tid, g, S, E); }
            SEAM(P + 8);
        }
        if (PHM(9) && IN(P + 9)) { KArgP ka = kargs(); (void)ka; FRESH(); unsigned char* const ws = ka->ws; C.ws = ws;
            const float* nsc = (l + 1 < DEPTH) ? MOD + (size_t)(l + 1) * 16 * 6144 + 1024 : nullptr; const float* nsh = (l + 1 < DEPTH) ? MOD + (size_t)(l + 1) * 16 * 6144 : nullptr;
            if (moe) ln_phase<1, false>(C, nullptr, XF, H, ka->ln2_g + l * 1024, ka->ln2_b + l * 1024, nsc, nsh, (const bf16_t*)(ws + WS_Y), (const float*)(ws + WS_GATE), (MOD + (size_t)l * 16 * 6144) + 5120, nullptr, nullptr, nullptr, nullptr, nullptr);
            else ln_phase<0, false>(C, PRE, XF, H, ka->ln2_g + l * 1024, ka->ln2_b + l * 1024, nsc, nsh, nullptr, nullptr, nullptr, nullptr, nullptr, nullptr, nullptr, nullptr);
            if (l + 1 < DEPTH) { __syncthreads(); cvt_mixer_weights(C, l + 1); cvt_ffn_weights(C, l + 1); }
            if (l + 1 < DEPTH) SEAM(P + 9);
        }
    }
#undef IN
#undef SEAM
#undef MOD
#undef PART
#undef RSQ
#undef COS
#undef SIN
#undef H
#undef LAT
#undef ZB
#undef QM
#undef KM
#undef VM
#undef OM
#undef PRE
#undef T1
#undef MB
#undef DQ
#undef DK
#undef DV
#undef SA
#undef SB
#undef XF
#undef ctl
#undef gw
#undef NGW
}

extern "C" void kernel_launch(void* const* d_in, const int* in_sizes, int n_in, void* d_out, int out_size, void* d_ws, size_t ws_size, hipStream_t stream) {
    static int grid = 0;
    if (grid == 0) {
        if (n_in != 30 || in_sizes[0] != T * D || out_size != T * D || ws_size < WS_NEED) { fprintf(stderr, "kernel_launch: unexpected shapes (n_in %d, in0 %d, out %d, ws %zu, need %zu)\n", n_in, n_in > 0 ? in_sizes[0] : -1, out_size, ws_size, (size_t)WS_NEED); grid = -1; return; }
        if (hipFuncSetAttribute((const void*)mk_fwd, hipFuncAttributeMaxDynamicSharedMemorySize, LDS_BYTES) != hipSuccess) { fprintf(stderr, "kernel_launch: hipFuncSetAttribute failed\n"); grid = -1; return; }
        int per_cu = 0;
        if (hipOccupancyMaxActiveBlocksPerMultiprocessor(&per_cu, (const void*)mk_fwd, NWAVES * 64, LDS_BYTES) != hipSuccess || per_cu < 1) fprintf(stderr, "kernel_launch: occupancy query reports %d\n", per_cu);
        (void)hipGetLastError();
        grid = 256;
    }
    if (grid < 0) return;
    if (hipMemsetAsync((char*)d_ws + WS_CTL, 0, CTL_ZERO_BYTES, stream) != hipSuccess) { fprintf(stderr, "kernel_launch: memset failed\n"); return; }
    Args a{};
    const float** fp = (const float**)&a.x;
    a.x = (const float*)d_in[0]; a.c = (const float*)d_in[1]; a.pos = (const int*)d_in[2]; a.w_ada = (const float*)d_in[3]; a.b_ada = (const float*)d_in[4]; a.w_in = (const float*)d_in[5];
    a.q_norm_g = (const float*)d_in[6]; a.w_q_up = (const float*)d_in[7]; a.kv_norm_g = (const float*)d_in[8]; a.w_kv_up = (const float*)d_in[9];
    a.lq1 = (const float*)d_in[10]; a.lk1 = (const float*)d_in[11]; a.lq2 = (const float*)d_in[12]; a.lk2 = (const float*)d_in[13]; a.diff_norm_g = (const float*)d_in[14];
    a.w_br_mla = (const float*)d_in[15]; a.w_br_diff = (const float*)d_in[16]; a.w_out = (const float*)d_in[17];
    a.ln1_g = (const float*)d_in[18]; a.ln1_b = (const float*)d_in[19]; a.ln2_g = (const float*)d_in[20]; a.ln2_b = (const float*)d_in[21];
    a.ffn_w1 = (const float*)d_in[22]; a.ffn_w3 = (const float*)d_in[23]; a.ffn_w2 = (const float*)d_in[24]; a.router_w = (const float*)d_in[25]; a.router_b = (const float*)d_in[26];
    a.moe_w1 = (const float*)d_in[27]; a.moe_w3 = (const float*)d_in[28]; a.moe_w2 = (const float*)d_in[29];
    (void)fp;
    a.out = (float*)d_out; a.ws = (unsigned char*)d_ws;
    for (int l = 0; l < 4; ++l) a.lam_init[l] = (float)(0.8 - 0.6 * exp(-0.3 * (double)l));
#if MK_PER_PHASE
    for (int p = 0; p < NPHASE; ++p) {
        const int k = (p - 2) % NPH_L, l = (p - 2) / NPH_L;
        if (p >= 2 && k == 6 && (l & 1) == 0) continue;
        a.ph_lo = p; a.ph_hi = p + 1;
        hipLaunchKernelGGL(mk_fwd, dim3(grid), dim3(NWAVES * 64), LDS_BYTES, stream, a);
    }
#else
    a.ph_lo = 0; a.ph_hi = NPHASE;
    hipLaunchKernelGGL(mk_fwd, dim3(grid), dim3(NWAVES * 64), LDS_BYTES, stream, a);
#endif
    const hipError_t le = hipPeekAtLastError();
    if (le != hipSuccess) fprintf(stderr, "kernel_launch: launch failed: %s\n", hipGetErrorName(le));
}
```

```cpp
#include <hip/hip_runtime.h>
#include <hip/hip_bf16.h>
#include <cstdio>
#include <cstdint>
#include <cmath>

#ifndef MK_PER_PHASE
#define MK_PER_PHASE 0
#endif
#ifndef PH_MASK
#define PH_MASK 0xFFFF
#endif
#define PHM(k) (((PH_MASK) >> (k)) & 1)
#ifndef PROBE
#define PROBE 0
#endif

constexpr int D = 1024, BATCH = 16, SEQ = 2048, DEPTH = 4, T = BATCH * SEQ;
constexpr int NZ = 5888;
constexpr int FF = 2816, NEXP = 8;
constexpr float ALPHA = 1.681792830507429f;
constexpr float LN_EPS = 1e-5f, RMS_EPS = 1e-6f;
constexpr float LOG2E = 1.4426950408889634f;
constexpr float CQ_MLA = 0.10206207261596575f * LOG2E;
constexpr float CQ_DIFF = 0.125f * LOG2E;

#define LAS __attribute__((address_space(3)))
#define GAS __attribute__((address_space(1)))
typedef unsigned short bf16_t;
typedef short bf16x8 __attribute__((ext_vector_type(8)));
typedef short s16x4 __attribute__((ext_vector_type(4)));
typedef float f32x4 __attribute__((ext_vector_type(4)));
typedef float f32x2 __attribute__((ext_vector_type(2)));
typedef float f32x16 __attribute__((ext_vector_type(16)));
typedef unsigned u32x4 __attribute__((ext_vector_type(4)));
typedef unsigned u32x2 __attribute__((ext_vector_type(2)));

__device__ __forceinline__ unsigned cvt_pk_bf16(float lo, float hi) { unsigned r; asm volatile("v_cvt_pk_bf16_f32 %0, %1, %2" : "=v"(r) : "v"(lo), "v"(hi)); return r; }
__device__ __forceinline__ u32x4 pack8(f32x4 a, f32x4 b) { u32x4 w; w.x = cvt_pk_bf16(a[0], a[1]); w.y = cvt_pk_bf16(a[2], a[3]); w.z = cvt_pk_bf16(b[0], b[1]); w.w = cvt_pk_bf16(b[2], b[3]); return w; }
__device__ __forceinline__ void unpack8(u32x4 w, f32x4& a, f32x4& b) {
    a[0] = __uint_as_float(w.x << 16); a[1] = __uint_as_float(w.x & 0xffff0000u); a[2] = __uint_as_float(w.y << 16); a[3] = __uint_as_float(w.y & 0xffff0000u);
    b[0] = __uint_as_float(w.z << 16); b[1] = __uint_as_float(w.z & 0xffff0000u); b[2] = __uint_as_float(w.w << 16); b[3] = __uint_as_float(w.w & 0xffff0000u); }
__device__ __forceinline__ float bf2f(bf16_t v) { return __uint_as_float(((unsigned)v) << 16); }
template <int X> __device__ __forceinline__ float swz_xor(float v) { return __int_as_float(__builtin_amdgcn_ds_swizzle(__float_as_int(v), (X << 10) | 0x1f)); }
__device__ __forceinline__ float sum_x32(float v) { auto rr = __builtin_amdgcn_permlane32_swap(__float_as_uint(v), __float_as_uint(v), false, false); return __uint_as_float(rr[0]) + __uint_as_float(rr[1]); }
__device__ __forceinline__ float sigmoidf_(float x) { return __builtin_amdgcn_rcpf(1.0f + __builtin_amdgcn_exp2f(-x * LOG2E)); }

namespace pg8 {
constexpr int BM = 256, BK = 64, HALF = 128, HTB = HALF * BK * 2, STAGE_BYTES = 8 * HTB, NXCD = 8, WGM = 8;
__host__ __device__ __forceinline__ int lds_byte(int r, int c) { const int st = (r >> 4) * 2 + (c >> 5), rr = r & 15, cc = c & 31, ob = rr * 64 + cc * 2; return st * 1024 + (ob ^ (((ob >> 9) & 1) << 5)); }
__host__ __device__ __forceinline__ void stage_rc(int b, int& R, int& C) { const int st = b / 1024, sb = b % 1024, swz = sb ^ (((sb >> 9) & 1) << 5); R = (st >> 1) * 16 + swz / 64; C = (st & 1) * 32 + (swz % 64) / 2; }
__host__ __device__ __forceinline__ int perm32(int rho) { const int n = rho >> 4, i = rho & 15; return 8 * (i >> 2) + 4 * n + (i & 3); }

struct Unit { int pm, pn; };
struct Gemm { const bf16_t* A; const bf16_t* Bt; int M, N, K, lda; };

struct StaticOrder {
    int nM, nN, nwg, G, c;
    __host__ __device__ void init(int M, int N, int G_, int c_) { nM = M / BM; nN = N / BM; nwg = nM * nN; G = G_; c = c_; }
    __host__ __device__ bool next(int i, Unit& u) const {
        const long L = (long)i * G + c; if (L >= nwg) return false;
        int wgid = (int)L; { const int q = nwg / NXCD, r = nwg % NXCD, xcd = wgid % NXCD, off = wgid / NXCD; wgid = (xcd < r ? xcd * (q + 1) : r * (q + 1) + (xcd - r) * q) + off; }
        const int nig = WGM * nN, gid = wgid / nig, fm = gid * WGM, gsz = (nM - fm) < WGM ? (nM - fm) : WGM;
        u.pm = fm + ((wgid % nig) % gsz); u.pn = (wgid % nig) / gsz; return true;
    }
    __device__ __forceinline__ size_t bofs(const Unit&) const { return 0; }
};
struct MoeOrder {
    StaticOrder so; int ts1, ts2, ts3, ts4, ts5, ts6, ts7; size_t estride;
    __device__ __forceinline__ bool next(int i, Unit& u) const { return so.next(i, u); }
    __device__ __forceinline__ size_t bofs(const Unit& u) const {
        const int e = (u.pm >= ts1) + (u.pm >= ts2) + (u.pm >= ts3) + (u.pm >= ts4) + (u.pm >= ts5) + (u.pm >= ts6) + (u.pm >= ts7);
        return (size_t)e * estride; }
};

template <class F, bool PERM_> struct EpiRow {
    static constexpr bool PERM = PERM_; F f;
    __device__ __forceinline__ void operator()(const f32x4 (&acc)[2][2][4][2], const Unit& u, int wr, int wc, int fr, int fq) const {
#pragma unroll
        for (int ai = 0; ai < 2; ++ai)
#pragma unroll
            for (int m = 0; m < 4; ++m) { const int row = u.pm * BM + ai * HALF + wr * 64 + m * 16 + fr;
                const float rs = f.rowscale(row);
#pragma unroll
                for (int bj = 0; bj < 2; ++bj) f(row, rs, u.pn * BM + bj * HALF + wc * 32, fq, acc[ai][bj][m][0], acc[ai][bj][m][1]);
                asm volatile("" ::: "memory"); __builtin_amdgcn_sched_barrier(0); }
    }
};
struct EpiSwiglu {
    static constexpr bool PERM = true; bf16_t* U; int ldu;
    __device__ __forceinline__ void operator()(const f32x4 (&acc)[2][2][4][2], const Unit& u, int wr, int wc, int fr, int fq) const {
#pragma unroll
        for (int ai = 0; ai < 2; ++ai)
#pragma unroll
            for (int m = 0; m < 4; ++m) { const int row = u.pm * BM + ai * HALF + wr * 64 + m * 16 + fr;
                f32x4 o[2];
#pragma unroll
                for (int n = 0; n < 2; ++n) { const f32x4 a = acc[ai][0][m][n], b = acc[ai][1][m][n];
#pragma unroll
                    for (int i = 0; i < 4; ++i) o[n][i] = a[i] * sigmoidf_(a[i]) * b[i]; }
                *(u32x4*)(U + (size_t)row * ldu + u.pn * HALF + wc * 32 + 8 * fq) = pack8(o[0], o[1]); __builtin_amdgcn_sched_barrier(0); }
    }
};

template <class Epi, class Sched, bool ALIGN_EPI = true>
__device__ __forceinline__ void gemm_phase(LAS unsigned char* lds, int tid_in, const Gemm g, const Sched& S, const Epi& E) {
    int tid_ = tid_in; asm volatile("" : "+v"(tid_));
    const int tid = tid_, wid = __builtin_amdgcn_readfirstlane(tid >> 6), lane = tid & 63, wr = wid >> 2, wc = wid & 3, fr = lane & 15, fq = lane >> 4;
    const int K = g.K, nt = K / BK, lda = g.lda;
    unsigned voffA[2], voffB[2];
#pragma unroll
    for (int i = 0; i < 2; ++i) { int R, C; stage_rc(tid * 16 + i * 8192, R, C); const int Rb = Epi::PERM ? ((R & ~31) + perm32(R & 31)) : R;
        voffA[i] = (unsigned)(R * lda + C) * 2u; voffB[i] = (unsigned)(Rb * K + C) * 2u; }
    const size_t kstep = (size_t)(BK * 2);
    const size_t hstepA = (size_t)HALF * lda * 2, hstepB = (size_t)HALF * K * 2;
    const size_t tstepA = 2 * hstepA, tstepB = 2 * hstepB;
    const unsigned ldsw = (unsigned)wid * 1024u;
    const int aoff = lds_byte(wr * 64 + fr, fq * 8), boff = lds_byte(wc * 32 + fr, fq * 8);
#define PG8_SA(b, h) (((b) * 2 + (h)) * HTB)
#define PG8_SB(b, h) ((4 + (b) * 2 + (h)) * HTB)
#define PG8_STAGE(bufoff, gbase, voff) do { _Pragma("unroll") for (int _i = 0; _i < 2; ++_i) \
        __builtin_amdgcn_global_load_lds((const unsigned*)((const char*)(gbase) + (voff)[_i]), (LAS unsigned*)(lds + (bufoff) + ldsw + _i * 8192), 16, 0, 0); } while (0)
#define PG8_LDA(dst, b, h) do { _Pragma("unroll") for (int m = 0; m < 4; ++m) _Pragma("unroll") for (int k = 0; k < 2; ++k) dst[m][k] = *(const LAS bf16x8*)(lds + PG8_SA(b, h) + aoff + m * 2048 + k * 1024); } while (0)
#define PG8_LDB(dst, b, h) do { _Pragma("unroll") for (int n = 0; n < 2; ++n) _Pragma("unroll") for (int k = 0; k < 2; ++k) dst[n][k] = *(const LAS bf16x8*)(lds + PG8_SB(b, h) + boff + n * 2048 + k * 1024); } while (0)
#define PG8_MMA(ai, bj, At, Bt) do { __builtin_amdgcn_s_setprio(1); _Pragma("unroll") for (int m = 0; m < 4; ++m) _Pragma("unroll") for (int n = 0; n < 2; ++n) _Pragma("unroll") for (int k = 0; k < 2; ++k) \
        acc[ai][bj][m][n] = __builtin_amdgcn_mfma_f32_16x16x32_bf16(Bt[n][k], At[m][k], acc[ai][bj][m][n], 0, 0, 0); __builtin_amdgcn_s_setprio(0); } while (0)
#define PG8_WAIT_V(n) asm volatile("s_waitcnt vmcnt(" #n ")" ::: "memory")
#define PG8_WAIT_L(n) asm volatile("s_waitcnt lgkmcnt(" #n ")" ::: "memory")
#define PG8_BAR __builtin_amdgcn_s_barrier()
#define PG8_SCHED __builtin_amdgcn_sched_barrier(0)
    Unit cur, nxt; int ui = 0;
    if (!S.next(0, cur)) return;
    f32x4 acc[2][2][4][2];
#pragma unroll
    for (int a = 0; a < 2; ++a)
#pragma unroll
        for (int b = 0; b < 2; ++b)
#pragma unroll
            for (int m = 0; m < 4; ++m)
#pragma unroll
                for (int n = 0; n < 2; ++n) acc[a][b][m][n] = (f32x4){0.f, 0.f, 0.f, 0.f};
    bf16x8 At[4][2], B0[2][2], B1[2][2];
    const char* cA = (const char*)g.A + (size_t)cur.pm * tstepA; const char* cB = (const char*)g.Bt + S.bofs(cur) + (size_t)cur.pn * tstepB;
    PG8_STAGE(PG8_SB(0, 0), cB, voffB); PG8_STAGE(PG8_SB(0, 1), cB + hstepB, voffB); PG8_STAGE(PG8_SA(0, 0), cA, voffA); PG8_STAGE(PG8_SA(0, 1), cA + hstepA, voffA);
    if (wr == 1) PG8_BAR;
    PG8_WAIT_V(2); PG8_BAR;
    PG8_STAGE(PG8_SB(1, 0), cB + kstep, voffB); PG8_STAGE(PG8_SA(1, 0), cA + kstep, voffA); PG8_STAGE(PG8_SB(1, 1), cB + hstepB + kstep, voffB);
    PG8_WAIT_V(6); PG8_BAR;
    for (;;) {
        const bool has_next = S.next(ui + 1, nxt);
        const char* nA = has_next ? (const char*)g.A + (size_t)nxt.pm * tstepA : cA; const char* nB = has_next ? (const char*)g.Bt + S.bofs(nxt) + (size_t)nxt.pn * tstepB : cB;
#pragma unroll 1
        for (int t = 0; t < nt; t += 2) {
            const bool last = (t == nt - 2);
            const char* a1 = cA + (size_t)(t + 1) * kstep;
            const char* a2 = last ? nA : cA + (size_t)(t + 2) * kstep; const char* b2 = last ? nB : cB + (size_t)(t + 2) * kstep;
            const char* a3 = a2 + kstep; const char* b3 = b2 + kstep;
            PG8_LDB(B0, 0, 0); PG8_LDB(B1, 0, 1); PG8_SCHED; PG8_LDA(At, 0, 0); PG8_STAGE(PG8_SA(1, 1), a1 + hstepA, voffA);
            PG8_WAIT_V(8); PG8_WAIT_L(0); PG8_BAR; PG8_MMA(0, 0, At, B0); PG8_MMA(0, 1, At, B1); PG8_BAR; PG8_SCHED;
            PG8_LDA(At, 0, 1); PG8_STAGE(PG8_SB(0, 0), b2, voffB); PG8_STAGE(PG8_SB(0, 1), b2 + hstepB, voffB); PG8_STAGE(PG8_SA(0, 0), a2, voffA);
            PG8_WAIT_V(8); PG8_WAIT_L(0); PG8_BAR; PG8_MMA(1, 0, At, B0); PG8_MMA(1, 1, At, B1); PG8_BAR; PG8_SCHED;
            PG8_LDB(B0, 1, 0); PG8_LDB(B1, 1, 1); PG8_SCHED; PG8_LDA(At, 1, 0); PG8_STAGE(PG8_SA(0, 1), a2 + hstepA, voffA);
            PG8_WAIT_V(8); PG8_WAIT_L(0); PG8_BAR; PG8_MMA(0, 0, At, B0); PG8_MMA(0, 1, At, B1); PG8_BAR; PG8_SCHED;
            PG8_LDA(At, 1, 1); PG8_STAGE(PG8_SB(1, 0), b3, voffB); PG8_STAGE(PG8_SB(1, 1), b3 + hstepB, voffB); PG8_STAGE(PG8_SA(1, 0), a3, voffA);
            PG8_WAIT_V(8); PG8_WAIT_L(0); PG8_BAR; PG8_MMA(1, 0, At, B0); PG8_MMA(1, 1, At, B1); PG8_BAR; PG8_SCHED;
        }
        if constexpr (ALIGN_EPI) { if (wr == 0) PG8_BAR; }
        E(acc, cur, wr, wc, fr, fq);
        if (!has_next) break;
#pragma unroll
        for (int a = 0; a < 2; ++a)
#pragma unroll
            for (int b = 0; b < 2; ++b)
#pragma unroll
                for (int m = 0; m < 4; ++m)
#pragma unroll
                    for (int n = 0; n < 2; ++n) acc[a][b][m][n] = (f32x4){0.f, 0.f, 0.f, 0.f};
        cur = nxt; cA = nA; cB = nB; ++ui;
        if constexpr (ALIGN_EPI) { if (wr == 1) PG8_BAR; }
    }
    PG8_WAIT_V(0);
    if constexpr (!ALIGN_EPI) { if (wr == 0) PG8_BAR; }
    PG8_BAR;
#undef PG8_SA
#undef PG8_SB
#undef PG8_STAGE
#undef PG8_LDA
#undef PG8_LDB
#undef PG8_MMA
#undef PG8_WAIT_V
#undef PG8_WAIT_L
#undef PG8_BAR
#undef PG8_SCHED
}
}

namespace att {
constexpr int NW = 8, QBLK = 32, KVBLK = 64;
constexpr float THR = 11.5f;
constexpr size_t SHM_V = 16384, SHM_K = 16384;
constexpr size_t OFF_V = 0, OFF_K = 2 * SHM_V, OFF_WS = OFF_K + 2 * SHM_K, OFF_POS = OFF_WS + NW * 64 * 4, ATT_LDS = OFF_POS + SEQ * 4;
#define KSWZ(row, colB) ((row) * 256 + ((colB) ^ (((row) & 7) << 4)))
#define SBAR() __builtin_amdgcn_sched_barrier(0)
__device__ __forceinline__ int crow(int r, int hi) { return (r & 3) + 8 * (r >> 2) + 4 * hi; }
__device__ __forceinline__ unsigned cvtpk(float lo, float hi) { unsigned r; asm volatile("v_cvt_pk_bf16_f32 %0, %1, %2" : "=v"(r) : "v"(lo), "v"(hi)); return r; }

__device__ __forceinline__ void partialSM(f32x16& p0, f32x16& p1, float& m_reg, float& mn, float& alpha) {
  float pmax = p0[0];
#pragma unroll
  for (int r = 1; r < 16; ++r) pmax = fmaxf(pmax, p0[r]);
#pragma unroll
  for (int r = 0; r < 16; ++r) pmax = fmaxf(pmax, p1[r]);
  { auto rr = __builtin_amdgcn_permlane32_swap(__float_as_uint(pmax), __float_as_uint(pmax), false, false);
    pmax = fmaxf(__uint_as_float(rr[0]), __uint_as_float(rr[1])); }
  if (__builtin_expect(__all(pmax - m_reg <= THR), 1)) { mn = m_reg; alpha = 1.f; }
  else { mn = fmaxf(m_reg, pmax); alpha = __builtin_amdgcn_exp2f(m_reg - mn); m_reg = mn; }
#pragma unroll
  for (int r = 0; r < 16; ++r) p0[r] = p0[r] - mn;
#pragma unroll
  for (int r = 0; r < 16; ++r) p1[r] = p1[r] - mn;
#pragma unroll
  for (int r = 0; r < 16; ++r) p0[r] = __builtin_amdgcn_exp2f(p0[r]);
}
__device__ __forceinline__ void finishSM(f32x16& p0, f32x16& p1, float alpha, float& l_reg, bf16x8& pa0, bf16x8& pa1, bf16x8& pa2, bf16x8& pa3) {
#pragma unroll
  for (int r = 0; r < 16; ++r) p1[r] = __builtin_amdgcn_exp2f(p1[r]);
  float ps = 0;
#pragma unroll
  for (int r = 0; r < 16; ++r) ps += p0[r];
#pragma unroll
  for (int r = 0; r < 16; ++r) ps += p1[r];
  { auto rr = __builtin_amdgcn_permlane32_swap(__float_as_uint(ps), __float_as_uint(ps), false, false);
    ps = __uint_as_float(rr[0]) + __uint_as_float(rr[1]); }
  l_reg = l_reg * alpha + ps;
#define PK4(P, BASE, OUT) do { unsigned a0 = cvtpk(P[BASE + 0], P[BASE + 1]), a1 = cvtpk(P[BASE + 2], P[BASE + 3]);   \
    unsigned b0 = cvtpk(P[BASE + 4], P[BASE + 5]), b1 = cvtpk(P[BASE + 6], P[BASE + 7]);                              \
    auto r0 = __builtin_amdgcn_permlane32_swap(a0, b0, false, false); auto r1 = __builtin_amdgcn_permlane32_swap(a1, b1, false, false); \
    u32x4 w = {r0[0], r1[0], r0[1], r1[1]}; OUT = *reinterpret_cast<bf16x8*>(&w); } while (0)
  PK4(p0, 0, pa0); PK4(p0, 8, pa1); PK4(p1, 0, pa2); PK4(p1, 8, pa3);
#undef PK4
}
template <int NQK> __device__ __forceinline__ void qkt(f32x16& p0, f32x16& p1, const char* Ks, const bf16x8* qr, int r32, int hi, int colb0) {
  p0 = f32x16{}; p1 = f32x16{};
#pragma unroll
  for (int d0 = 0; d0 < NQK; ++d0) { const int cb = colb0 + (d0 * 16 + hi * 8) * 2;
    bf16x8 b0 = *reinterpret_cast<const bf16x8*>(Ks + KSWZ(r32, cb));
    bf16x8 b1 = *reinterpret_cast<const bf16x8*>(Ks + KSWZ(32 + r32, cb));
    p0 = __builtin_amdgcn_mfma_f32_32x32x16_bf16(b0, qr[d0], p0, 0, 0, 0);
    p1 = __builtin_amdgcn_mfma_f32_32x32x16_bf16(b1, qr[d0], p1, 0, 0, 0); }
}
template <int NCB> __device__ __forceinline__ int v_st(int k, int c) { const int kk = (k & ~0xC) | ((k & 4) << 1) | ((k & 8) >> 1); return ((kk >> 3) * NCB + (c >> 5)) * 512 + ((kk & 7) * 32 + (c & 31)) * 2; }
__device__ __forceinline__ int v_rd_base(int lane) { return ((lane & 3) << 3) | (((lane >> 2) & 3) << 6) | (((lane >> 4) & 1) << 5) | (((lane >> 5) & 1) << 8); }
template <int NCB> constexpr int v_rd_off(int d0, int ks, int half) { return d0 * 512 + (2 * ks + half) * NCB * 512; }
template <int OFF> __device__ __forceinline__ s16x4 tr_read(int vb) { s16x4 r; asm volatile("ds_read_b64_tr_b16 %0, %1 offset:%2" : "=&v"(r) : "v"(vb), "i"(OFF) : "memory"); return r; }
template <int NCB, int D0> __device__ __forceinline__ void pv_one(f32x16& od, int vb, bf16x8 pa0, bf16x8 pa1, bf16x8 pa2, bf16x8 pa3) {
  const s16x4 l0 = tr_read<v_rd_off<NCB>(D0, 0, 0)>(vb), h0 = tr_read<v_rd_off<NCB>(D0, 0, 1)>(vb), l1 = tr_read<v_rd_off<NCB>(D0, 1, 0)>(vb), h1 = tr_read<v_rd_off<NCB>(D0, 1, 1)>(vb);
  const s16x4 l2 = tr_read<v_rd_off<NCB>(D0, 2, 0)>(vb), h2 = tr_read<v_rd_off<NCB>(D0, 2, 1)>(vb), l3 = tr_read<v_rd_off<NCB>(D0, 3, 0)>(vb), h3 = tr_read<v_rd_off<NCB>(D0, 3, 1)>(vb);
  asm volatile("s_waitcnt lgkmcnt(0)" ::: "memory"); SBAR();
#define PK(L, H) (bf16x8){L[0], L[1], L[2], L[3], H[0], H[1], H[2], H[3]}
  od = __builtin_amdgcn_mfma_f32_32x32x16_bf16(pa0, PK(l0, h0), od, 0, 0, 0);
  od = __builtin_amdgcn_mfma_f32_32x32x16_bf16(pa1, PK(l1, h1), od, 0, 0, 0);
  od = __builtin_amdgcn_mfma_f32_32x32x16_bf16(pa2, PK(l2, h2), od, 0, 0, 0);
  od = __builtin_amdgcn_mfma_f32_32x32x16_bf16(pa3, PK(l3, h3), od, 0, 0, 0);
#undef PK
}
template <int NCB> __device__ __forceinline__ void pv_all(f32x16* o, int vb, bf16x8 pa0, bf16x8 pa1, bf16x8 pa2, bf16x8 pa3) {
  pv_one<NCB, 0>(o[0], vb, pa0, pa1, pa2, pa3); pv_one<NCB, 1>(o[1], vb, pa0, pa1, pa2, pa3);
  if constexpr (NCB == 4) { pv_one<NCB, 2>(o[2], vb, pa0, pa1, pa2, pa3); pv_one<NCB, 3>(o[3], vb, pa0, pa1, pa2, pa3); }
}
__device__ __forceinline__ void alibi(f32x16& p0, f32x16& p1, const float* posl, int k0, int hi, float pq, float sl) {
  const float* pk = posl + k0 + 4 * hi;
#pragma unroll
  for (int g = 0; g < 4; ++g) { const f32x4 a = *(const f32x4*)(pk + 8 * g), b = *(const f32x4*)(pk + 32 + 8 * g);
#pragma unroll
    for (int i = 0; i < 4; ++i) { p0[4 * g + i] -= sl * fabsf(pq - a[i]); p1[4 * g + i] -= sl * fabsf(pq - b[i]); } }
}

struct DiffArgs { const int* pos; float sl; float lam; float oscale; const float* ng; };

template <bool DIFF>
__device__ __forceinline__ void attn_unit(const bf16_t* __restrict__ Qb, const bf16_t* __restrict__ Kh, const bf16_t* __restrict__ Vh, bf16_t* __restrict__ Ob, int q0, const DiffArgs da, char* lds, int tid_in) {
  constexpr int LDQ = DIFF ? 1024 : 768, LDK = DIFF ? 1024 : 768, LDV = DIFF ? 1024 : 512, LDO = DIFF ? 1024 : 512;
  constexpr int NQK = DIFF ? 4 : 6, NDV = DIFF ? 4 : 2, KCH = DIFF ? 16 : 12, VCH = DIFF ? 16 : 8;
  int tid_ = tid_in; asm volatile("" : "+v"(tid_));
  const int tid = tid_, wid = tid >> 6, lane = tid & 63, r32 = lane & 31, hi = lane >> 5;
  const int mp = DIFF ? (wid >> 2) : 0, wrow = DIFF ? (wid & 3) * QBLK : wid * QBLK;
  char* V_lds = lds + OFF_V; char* K_lds = lds + OFF_K;
  float* ws = (float*)(lds + OFF_WS) + wid * 64; float* li_l = ws; float* al_l = ws + 32;
  float* posl = (float*)(lds + OFF_POS);
  float m_reg = -1e30f, l_reg = 0; f32x16 o[NDV]; bf16x8 qr[NQK];
#pragma unroll
  for (int d = 0; d < NDV; ++d) o[d] = f32x16{};
  const bf16_t* Qw = Qb + (long)(wrow + r32) * LDQ + mp * 64 + hi * 8;
#pragma unroll
  for (int d0 = 0; d0 < NQK; ++d0) qr[d0] = *reinterpret_cast<const bf16x8*>(Qw + d0 * 16);
  float pq = 0.f;
  if constexpr (DIFF) {
    for (int i = tid; i < SEQ; i += NW * 64) posl[i] = (float)da.pos[i];
    pq = (float)da.pos[q0 + wrow + r32];
  }
  const int sr = tid >> 4, ch = tid & 15, sc = ch * 8;
  const bool kact = ch < KCH, vact = ch < VCH;
  const int vst0 = v_st<NDV>(sr, sc), vst1 = v_st<NDV>(32 + sr, sc);
  const int vb0 = (int)(uintptr_t)V_lds + v_rd_base(lane);
  const int kcol0 = mp * 128;
  constexpr int SDEPTH = DIFF ? 1 : 2;
  struct { bf16x8 vs0, vs1, ks0, ks1; } sr_[SDEPTH];
#define SLOAD(i, k0) do { if (vact) { sr_[i].vs0 = *(const bf16x8*)(&Vh[(long)((k0) + sr) * LDV + sc]); sr_[i].vs1 = *(const bf16x8*)(&Vh[(long)((k0) + 32 + sr) * LDV + sc]); } \
    if (kact) { sr_[i].ks0 = *(const bf16x8*)(&Kh[(long)((k0) + sr) * LDK + sc]); sr_[i].ks1 = *(const bf16x8*)(&Kh[(long)((k0) + 32 + sr) * LDK + sc]); } } while (0)
#define SWRITE(b, i) do { if (vact) { *(bf16x8*)(V_lds + (b) * SHM_V + vst0) = sr_[i].vs0; *(bf16x8*)(V_lds + (b) * SHM_V + vst1) = sr_[i].vs1; } \
    if (kact) { const int kc = sc * 2; *(bf16x8*)(K_lds + (b) * SHM_K + KSWZ(sr, kc)) = sr_[i].ks0; *(bf16x8*)(K_lds + (b) * SHM_K + KSWZ(32 + sr, kc)) = sr_[i].ks1; } } while (0)
#define SWAIT() do { if constexpr (SDEPTH == 2) asm volatile("s_waitcnt vmcnt(4)" ::: "memory"); else asm volatile("s_waitcnt vmcnt(0)" ::: "memory"); } while (0)
#define RESC(a) do { if (__any((a) < 1.f)) { if (hi == 0) al_l[r32] = (a); asm volatile("s_waitcnt lgkmcnt(0)" ::: "memory"); \
    _Pragma("unroll") for (int d = 0; d < NDV; ++d) _Pragma("unroll") for (int r = 0; r < 16; ++r) o[d][r] *= al_l[crow(r, hi)]; } } while (0)
#define BIAS(P0, P1, k0) do { if constexpr (DIFF) alibi(P0, P1, posl, (k0), hi, pq, da.sl); } while (0)
  f32x16 pA0, pA1, pB0, pB1; float mnA, mnB, alA, alB; bf16x8 pa0, pa1, pa2, pa3; constexpr int NT = SEQ / KVBLK;
  constexpr int SE = 0, SO = SDEPTH - 1;
  SLOAD(SE, 0); asm volatile("s_waitcnt vmcnt(0)" ::: "memory"); SWRITE(0, SE); __syncthreads();
  qkt<NQK>(pA0, pA1, K_lds, qr, r32, hi, kcol0); BIAS(pA0, pA1, 0); partialSM(pA0, pA1, m_reg, mnA, alA);
  SLOAD(SO, KVBLK); if constexpr (SDEPTH == 2) SLOAD(SE, 2 * KVBLK);
  SWAIT(); SWRITE(1, SO); __syncthreads();
  for (int j = 1; j + 1 < NT; j += 2) {
    SBAR(); qkt<NQK>(pB0, pB1, K_lds + SHM_K, qr, r32, hi, kcol0); BIAS(pB0, pB1, j * KVBLK);
    finishSM(pA0, pA1, alA, l_reg, pa0, pa1, pa2, pa3); SBAR();
    SLOAD(SO, (j + SDEPTH) * KVBLK); SBAR();
    pv_all<NDV>(o, vb0, pa0, pa1, pa2, pa3); partialSM(pB0, pB1, m_reg, mnB, alB);
    __syncthreads(); SWAIT(); SWRITE(0, SE);
    RESC(alB); __syncthreads();
    SBAR(); qkt<NQK>(pA0, pA1, K_lds, qr, r32, hi, kcol0); BIAS(pA0, pA1, (j + 1) * KVBLK);
    finishSM(pB0, pB1, alB, l_reg, pa0, pa1, pa2, pa3); SBAR();
    if (SDEPTH == 1 || j + 3 < NT) SLOAD(SE, (j + 1 + SDEPTH) * KVBLK); SBAR();
    pv_all<NDV>(o, vb0 + (int)SHM_V, pa0, pa1, pa2, pa3); partialSM(pA0, pA1, m_reg, mnA, alA);
    __syncthreads(); SWAIT(); SWRITE(1, SO);
    RESC(alA); __syncthreads();
  }
  SBAR(); qkt<NQK>(pB0, pB1, K_lds + SHM_K, qr, r32, hi, kcol0); BIAS(pB0, pB1, (NT - 1) * KVBLK);
  finishSM(pA0, pA1, alA, l_reg, pa0, pa1, pa2, pa3); SBAR();
  pv_all<NDV>(o, vb0, pa0, pa1, pa2, pa3); partialSM(pB0, pB1, m_reg, mnB, alB);
  __syncthreads(); RESC(alB);
  finishSM(pB0, pB1, alB, l_reg, pa0, pa1, pa2, pa3); SBAR();
  pv_all<NDV>(o, vb0 + (int)SHM_V, pa0, pa1, pa2, pa3);
  if (hi == 0) li_l[r32] = l_reg; asm volatile("s_waitcnt lgkmcnt(0)" ::: "memory");
  float rli[16];
#pragma unroll
  for (int r = 0; r < 16; ++r) rli[r] = __builtin_amdgcn_rcpf(li_l[crow(r, hi)]);
  if constexpr (!DIFF) {
    bf16_t* Ow = Ob + (long)wrow * LDO;
#pragma unroll
    for (int r = 0; r < 16; ++r) { const int orow = crow(r, hi);
#pragma unroll
      for (int d0 = 0; d0 < NDV; ++d0) { const float v = o[d0][r] * rli[r]; Ow[(long)orow * LDO + d0 * 32 + r32] = (bf16_t)(cvtpk(v, v) & 0xffffu); } }
    __syncthreads();
  } else {
    __syncthreads();
    float* cmb = (float*)lds + (wid & 3) * 4096;
    if (mp == 1) {
#pragma unroll
      for (int r = 0; r < 16; ++r) { const int orow = crow(r, hi);
#pragma unroll
        for (int d0 = 0; d0 < 4; ++d0) cmb[orow * 128 + d0 * 32 + r32] = o[d0][r] * rli[r]; }
    }
    __syncthreads();
    if (mp == 0) {
      float ss[16];
#pragma unroll
      for (int r = 0; r < 16; ++r) { const int orow = crow(r, hi); float s = 0.f;
#pragma unroll
        for (int d0 = 0; d0 < 4; ++d0) { const float v = o[d0][r] * rli[r] - da.lam * cmb[orow * 128 + d0 * 32 + r32]; o[d0][r] = v; s += v * v; }
        ss[r] = s; }
#pragma unroll
      for (int r = 0; r < 16; ++r) { float s = ss[r];
        s += swz_xor<1>(s); s += swz_xor<2>(s); s += swz_xor<4>(s); s += swz_xor<8>(s); s += swz_xor<16>(s);
        ss[r] = da.oscale * __builtin_amdgcn_rsqf(s * (1.0f / 128.0f) + RMS_EPS); }
      bf16_t* Ow = Ob + (long)wrow * LDO;
      float gn[4];
#pragma unroll
      for (int d0 = 0; d0 < 4; ++d0) gn[d0] = da.ng[d0 * 32 + r32];
#pragma unroll
      for (int r = 0; r < 16; ++r) { const int orow = crow(r, hi);
#pragma unroll
        for (int d0 = 0; d0 < 4; ++d0) { const float v = o[d0][r] * ss[r] * gn[d0]; Ow[(long)orow * LDO + d0 * 32 + r32] = (bf16_t)(cvtpk(v, v) & 0xffffu); } }
    }
    __syncthreads();
  }
#undef SLOAD
#undef SWRITE
#undef SWAIT
#undef RESC
#undef BIAS
}
#undef KSWZ
#undef SBAR
}

constexpr size_t MiB = 1u << 20;
constexpr size_t WS_CTL = 0, CTL_ZERO_BYTES = 1 * MiB;
constexpr size_t WS_MOD = 1 * MiB;
constexpr size_t WS_RSQ = 3 * MiB;
constexpr size_t WS_COS = 6 * MiB;
constexpr size_t WS_SIN = 8 * MiB;
constexpr size_t WS_SEL = 10 * MiB;
constexpr size_t WS_GATE = 10 * MiB + 256 * 1024;
constexpr size_t WS_RMAP = 11 * MiB;
constexpr size_t WS_WMIX = 12 * MiB;
constexpr size_t W_IN = WS_WMIX, W_QUP = W_IN + (size_t)NZ * 1024 * 2, W_KVUP = W_QUP + 768 * 384 * 2, W_BRM = W_KVUP + 1024 * 256 * 2, W_BRD = W_BRM + 1024 * 512 * 2, W_OUT = W_BRD + 1024 * 1024 * 2;
constexpr size_t WS_WFF = 30 * MiB;
constexpr size_t W13_ESTRIDE = (size_t)5632 * 1024 * 2, W2_ESTRIDE = (size_t)1024 * 2816 * 2, W2_BASE = WS_WFF + 8 * W13_ESTRIDE;
constexpr size_t WS_ACT = 162 * MiB;
constexpr size_t WS_H = WS_ACT;
constexpr size_t WS_LAT = WS_H + 64 * MiB;
constexpr size_t WS_ZB = WS_LAT + 48 * MiB;
constexpr size_t WS_QM = WS_ZB + 320 * MiB;
constexpr size_t WS_KM = WS_QM + 48 * MiB;
constexpr size_t WS_VM = WS_KM + 48 * MiB;
constexpr size_t WS_OM = WS_VM + 32 * MiB;
constexpr size_t WS_END = WS_OM + 32 * MiB;
constexpr size_t WS_PRE = WS_QM;
constexpr size_t WS_PART = WS_QM;
constexpr size_t WS_T1 = WS_ZB + 64 * MiB;
constexpr size_t WS_MB = WS_ZB + 128 * MiB;
constexpr size_t WS_U = WS_LAT;
constexpr size_t WS_XB = WS_LAT;
constexpr size_t WS_Y = WS_LAT;
constexpr size_t WS_UM = WS_LAT + 132 * MiB;
static_assert(WS_UM + (size_t)67584 * 2816 * 2 <= WS_END + 64 * MiB, "ws map");
constexpr size_t WS_NEED = WS_END + 8 * MiB;
constexpr int CW_BAR = 4096;
constexpr int CW_CNT = 8192;
constexpr int CW_CUR = 8192 + 256;

constexpr int RING_BYTES = 131072, LDSCTL_OFF = RING_BYTES, MISC_OFF = LDSCTL_OFF + 320, LDS_BYTES = 147456;
constexpr int NWAVES = 8;

#define XB_TMO      128
#define XB_XCNT(j)  (256  + 64 * (j))
#define XB_XSUB(j)  (1280 + 64 * (j))
#define XB_XGEN(j)  (2304 + 64 * (j))
#define XB_TOP      3328
#define XB_TOPGEN   3392
#define XCD_BAR_WORDS 3456
#define XB_SPIN_CAP (1u << 18)
__device__ __forceinline__ unsigned xb_ld(unsigned* p)              { return __hip_atomic_load(p, __ATOMIC_RELAXED, __HIP_MEMORY_SCOPE_AGENT); }
__device__ __forceinline__ unsigned xb_add(unsigned* p, unsigned v) { return __hip_atomic_fetch_add(p, v, __ATOMIC_RELAXED, __HIP_MEMORY_SCOPE_AGENT); }
__device__ __forceinline__ unsigned xb_xcc_id() { return (unsigned)__builtin_amdgcn_s_getreg((3 << 11) | 20) & 0xFu; }
#define XB_SPIN(cond, bar) do { unsigned _sp = 0; while (cond) { __builtin_amdgcn_s_sleep(1); \
    if ((++_sp & 255u) == 0u) { if (xb_ld(&(bar)[XB_TMO])) break; if (_sp > XB_SPIN_CAP) { atomicAdd(&(bar)[XB_TMO], 1u); break; } } } } while (0)
struct XcdBarrier { unsigned* bar; unsigned x; volatile LAS unsigned* st; };
__device__ __forceinline__ XcdBarrier xcd_barrier_post(unsigned* bar, volatile LAS unsigned* st, bool leader) {
    XcdBarrier b; b.bar = bar; b.x = xb_xcc_id(); b.st = st;
    if (leader) (void)xb_add(&bar[XB_XCNT(b.x)], 1u);
    return b;
}
__device__ __forceinline__ void xcd_barrier_complete(unsigned* bar, unsigned x, unsigned& nloc, unsigned& nx) {
    const unsigned G = gridDim.x * gridDim.y * gridDim.z;
    unsigned sum, cnt, mine, sp = 0u;
    for (;;) {
        sum = 0u; cnt = 0u; mine = 0u;
#pragma unroll
        for (unsigned j = 0; j < 16; ++j) { const unsigned c = xb_ld(&bar[XB_XCNT(j)]); sum += c; cnt += (c > 0u) ? 1u : 0u; mine = (j == x) ? c : mine; }
        if (sum == G) break;
        __builtin_amdgcn_s_sleep(1);
        if ((++sp & 255u) == 0u) { if (xb_ld(&bar[XB_TMO])) break; if (sp > XB_SPIN_CAP) { atomicAdd(&bar[XB_TMO], 1u); break; } }
    }
    nloc = mine > 0u ? mine : 1u; nx = cnt > 0u ? cnt : 1u;
}
__device__ __forceinline__ void xcd_barrier(const XcdBarrier& b, bool leader) {
    asm volatile("s_waitcnt vmcnt(0)" ::: "memory");
    __syncthreads();
    if (leader) {
        unsigned* bar = b.bar;
        __builtin_amdgcn_s_waitcnt(0);
        unsigned nloc = b.st[0], nx = b.st[1];
        if (nloc == 0u) { xcd_barrier_complete(bar, b.x, nloc, nx); b.st[0] = nloc; b.st[1] = nx; }
        const unsigned old = xb_add(&bar[XB_XSUB(b.x)], 1u);
        const unsigned gen = old / nloc;
        if (old + 1u == (gen + 1u) * nloc) {
            __builtin_amdgcn_fence(__ATOMIC_RELEASE, "agent");
            asm volatile("s_waitcnt vmcnt(0)" ::: "memory");
            const unsigned og = xb_add(&bar[XB_TOP], 1u);
            const unsigned tg = og / nx;
            if (og + 1u == (tg + 1u) * nx) xb_add(&bar[XB_TOPGEN], 1u);
            else XB_SPIN(xb_ld(&bar[XB_TOPGEN]) == tg, bar);
            __builtin_amdgcn_fence(__ATOMIC_ACQUIRE, "agent");
            xb_add(&bar[XB_XGEN(b.x)], 1u);
            asm volatile("s_waitcnt vmcnt(0)" ::: "memory");
        } else {
            XB_SPIN(xb_ld(&bar[XB_XGEN(b.x)]) == gen, bar);
            __builtin_amdgcn_fence(__ATOMIC_ACQUIRE, "agent");
            asm volatile("s_waitcnt vmcnt(0)" ::: "memory");
        }
    }
    __syncthreads();
}

__device__ __forceinline__ float wave_sum(float v) {
    v += swz_xor<1>(v); v += swz_xor<2>(v); v += swz_xor<4>(v); v += swz_xor<8>(v); v += swz_xor<16>(v);
    return sum_x32(v);
}
__device__ __forceinline__ unsigned f2bf(float f) { unsigned u = __builtin_bit_cast(unsigned, f); return (u + 0x7fffu + ((u >> 16) & 1u)) >> 16; }
__device__ __forceinline__ unsigned pk2(float lo, float hi) { return f2bf(lo) | (f2bf(hi) << 16); }

template <class MapF>
__device__ __forceinline__ void transpose_item(const float* W, int N, bf16_t* WT, int ldk, const float* gain, LAS float* scr, int kb, int nb, int lane, MapF map) {
    const int k0 = 64 * kb, n0 = 32 * nb;
    float tv[32];
#pragma unroll
    for (int i = 0; i < 32; ++i) { const int kk = 2 * i + (lane >> 5); tv[i] = W[(size_t)(k0 + kk) * N + n0 + (lane & 31)]; }
#pragma unroll
    for (int i = 0; i < 32; ++i) { const int kk = 2 * i + (lane >> 5); float v = tv[i]; if (gain) v *= gain[k0 + kk]; scr[kk * 33 + (lane & 31)] = v; }
    asm volatile("s_waitcnt lgkmcnt(0)" ::: "memory");
    const int c = lane & 7;
#pragma unroll
    for (int j = 0; j < 4; ++j) { const int n = (lane >> 3) + 8 * j; const LAS float* s = scr + (8 * c) * 33 + n;
        u32x4 o; o.x = pk2(s[0 * 33], s[1 * 33]); o.y = pk2(s[2 * 33], s[3 * 33]); o.z = pk2(s[4 * 33], s[5 * 33]); o.w = pk2(s[6 * 33], s[7 * 33]);
        const int dr = map(n0 + n);
        *(GAS u32x4*)(WT + (size_t)dr * ldk + k0 + 8 * c) = o; }
    asm volatile("s_waitcnt lgkmcnt(0)" ::: "memory");
}
__host__ __device__ __forceinline__ int rope_virt(int rho) { const int n = rho >> 4, fq = (rho & 15) >> 2, i = rho & 3; return 8 * fq + 4 * n + i; }
struct MapIn  { __device__ __forceinline__ int operator()(int n) const { if (n < 384) return n; if (n < 640) return n + 128; if (n < 672) return 384 + rope_virt(n - 640); return n + 96; } };
struct MapQup { __device__ __forceinline__ int operator()(int n) const { const int h = n / 96, w = n - h * 96; return w < 64 ? n : h * 96 + 64 + rope_virt(w - 64); } };
struct MapId  { __device__ __forceinline__ int operator()(int n) const { return n; } };
struct MapW13 { int half; __device__ __forceinline__ int operator()(int n) const { return 256 * (n >> 7) + 128 * half + (n & 127); } };

struct Args {
    const float* x; const float* c; const int* pos; const float* w_ada; const float* b_ada; const float* w_in; const float* q_norm_g; const float* w_q_up; const float* kv_norm_g; const float* w_kv_up;
    const float* lq1; const float* lk1; const float* lq2; const float* lk2; const float* diff_norm_g; const float* w_br_mla; const float* w_br_diff; const float* w_out;
    const float* ln1_g; const float* ln1_b; const float* ln2_g; const float* ln2_b; const float* ffn_w1; const float* ffn_w3; const float* ffn_w2; const float* router_w; const float* router_b;
    const float* moe_w1; const float* moe_w3; const float* moe_w2;
    float* out; unsigned char* ws; int ph_lo, ph_hi; float lam_init[4];
};

typedef const __attribute__((address_space(4))) Args* KArgP;
__device__ __forceinline__ KArgP kargs() { KArgP p = (KArgP)__builtin_amdgcn_kernarg_segment_ptr(); asm volatile("" : "+s"(p)); return p; }
struct Ctx { LAS unsigned char* lds; int tid, lane, wave, vcu, G; unsigned char* ws; };

__device__ __forceinline__ void cvt_mixer_weights(const Ctx& C, int l) {
    KArgP a = kargs();
    LAS float* scr = (LAS float*)(C.lds + C.wave * 8448);
    const int gw = C.vcu * NWAVES + C.wave, NGW = C.G * NWAVES;
    constexpr int I_IN = 16 * 181, I_QUP = 6 * 24, I_KVUP = 4 * 32, I_BRM = 8 * 32, I_BRD = 16 * 32, I_OUT = 16 * 32;
    constexpr int NIT = I_IN + I_QUP + I_KVUP + I_BRM + I_BRD + I_OUT;
    unsigned char* ws = C.ws;
    for (int it = gw; it < NIT; it += NGW) {
        int r = it;
        if (r < I_IN) { transpose_item(a->w_in + (size_t)l * 1024 * 5792, 5792, (bf16_t*)(ws + W_IN), 1024, nullptr, scr, r / 181, r % 181, C.lane, MapIn{}); continue; } r -= I_IN;
        if (r < I_QUP) { transpose_item(a->w_q_up + (size_t)l * 384 * 768, 768, (bf16_t*)(ws + W_QUP), 384, a->q_norm_g + l * 384, scr, r / 24, r % 24, C.lane, MapQup{}); continue; } r -= I_QUP;
        if (r < I_KVUP) { transpose_item(a->w_kv_up + (size_t)l * 256 * 1024, 1024, (bf16_t*)(ws + W_KVUP), 256, a->kv_norm_g + l * 256, scr, r / 32, r % 32, C.lane, MapId{}); continue; } r -= I_KVUP;
        if (r < I_BRM) { transpose_item(a->w_br_mla + (size_t)l * 512 * 1024, 1024, (bf16_t*)(ws + W_BRM), 512, nullptr, scr, r / 32, r % 32, C.lane, MapId{}); continue; } r -= I_BRM;
        if (r < I_BRD) { transpose_item(a->w_br_diff + (size_t)l * 1024 * 1024, 1024, (bf16_t*)(ws + W_BRD), 1024, nullptr, scr, r / 32, r % 32, C.lane, MapId{}); continue; } r -= I_BRD;
        transpose_item(a->w_out + (size_t)l * 1024 * 1024, 1024, (bf16_t*)(ws + W_OUT), 1024, nullptr, scr, r / 32, r % 32, C.lane, MapId{});
    }
}
__device__ __forceinline__ void cvt_ffn_weights(const Ctx& C, int l) {
    KArgP a = kargs();
    LAS float* scr = (LAS float*)(C.lds + C.wave * 8448);
    const int gw = C.vcu * NWAVES + C.wave, NGW = C.G * NWAVES;
    constexpr int I_W1 = 16 * 88, I_W2 = 44 * 32, I_E = 2 * I_W1 + I_W2;
    unsigned char* ws = C.ws;
    const bool moe = (l & 1) != 0; const int li = l >> 1;
    const int nE = moe ? NEXP : 1;
    const float* w1 = moe ? a->moe_w1 + (size_t)li * NEXP * 1024 * FF : a->ffn_w1 + (size_t)li * 1024 * FF;
    const float* w3 = moe ? a->moe_w3 + (size_t)li * NEXP * 1024 * FF : a->ffn_w3 + (size_t)li * 1024 * FF;
    const float* w2 = moe ? a->moe_w2 + (size_t)li * NEXP * 1024 * FF : a->ffn_w2 + (size_t)li * 1024 * FF;
    for (int it = gw; it < nE * I_E; it += NGW) {
        const int e = it / I_E; int r = it - e * I_E;
        bf16_t* d13 = (bf16_t*)(ws + WS_WFF + (size_t)e * W13_ESTRIDE); bf16_t* d2 = (bf16_t*)(ws + W2_BASE + (size_t)e * W2_ESTRIDE);
        const size_t eo = (size_t)e * 1024 * FF;
        if (r < I_W1) { transpose_item(w1 + eo, FF, d13, 1024, nullptr, scr, r / 88, r % 88, C.lane, MapW13{0}); continue; } r -= I_W1;
        if (r < I_W1) { transpose_item(w3 + eo, FF, d13, 1024, nullptr, scr, r / 88, r % 88, C.lane, MapW13{1}); continue; } r -= I_W1;
        transpose_item(w2 + eo, 1024, d2, FF, nullptr, scr, r / 32, r % 32, C.lane, MapId{});
    }
}

struct FIn {
    bf16_t* LAT; bf16_t* ZB; bf16_t* KM; float* RSQ; const float* COS; const float* SIN;
    __device__ __forceinline__ float rowscale(int) const { return 1.f; }
    __device__ __forceinline__ void operator()(int row, float rs, int cb, int fq, f32x4 v0, f32x4 v1) const {
        if (cb < 384 || (cb >= 512 && cb < 768)) {
            *(u32x4*)(LAT + (size_t)row * 768 + cb + 8 * fq) = pack8(v0, v1);
            float ss = (v0[0] * v0[0] + v0[1] * v0[1]) + (v0[2] * v0[2] + v0[3] * v0[3]) + (v1[0] * v1[0] + v1[1] * v1[1]) + (v1[2] * v1[2] + v1[3] * v1[3]);
            ss += swz_xor<16>(ss); ss = sum_x32(ss);
            const int slot = cb < 384 ? (cb >> 5) : 12 + ((cb - 512) >> 5);
            if (fq == 0) RSQ[(size_t)row * 24 + slot] = ss;
        } else if (cb < 416) {
            const f32x4 cs = *(const f32x4*)(COS + (size_t)row * 16 + 4 * fq), sn = *(const f32x4*)(SIN + (size_t)row * 16 + 4 * fq);
            const f32x4 o1 = v0 * cs - v1 * sn, o2 = v0 * sn + v1 * cs;
            const u32x4 w = pack8(o1, o2);
#pragma unroll
            for (int h = 0; h < 8; ++h) *(u32x4*)(KM + (size_t)row * 768 + h * 96 + 64 + 8 * fq) = w;
        } else if (cb >= 768) {
            const int g = (cb - 768) >> 10, c = (cb - 768) & 1023;
            if (g == 0) { v0 = v0 * CQ_DIFF; v1 = v1 * CQ_DIFF; }
            if (g >= 3) {
#pragma unroll
                for (int i = 0; i < 4; ++i) { v0[i] = sigmoidf_(v0[i]); v1[i] = sigmoidf_(v1[i]); } }
            *(u32x4*)(ZB + (size_t)g * T * 1024 + (size_t)row * 1024 + c + 8 * fq) = pack8(v0, v1);
        }
    }
};
struct FQup {
    bf16_t* QM; const float* RSQ; const float* COS; const float* SIN;
    __device__ __forceinline__ float rowscale(int row) const {
        const f32x4 a = *(const f32x4*)(RSQ + (size_t)row * 24), b = *(const f32x4*)(RSQ + (size_t)row * 24 + 4), c = *(const f32x4*)(RSQ + (size_t)row * 24 + 8);
        const float ss = ((a[0] + a[1]) + (a[2] + a[3])) + ((b[0] + b[1]) + (b[2] + b[3])) + ((c[0] + c[1]) + (c[2] + c[3]));
        return CQ_MLA * __builtin_amdgcn_rsqf(ss * (1.0f / 384.0f) + RMS_EPS); }
    __device__ __forceinline__ void operator()(int row, float r, int cb, int fq, f32x4 v0, f32x4 v1) const {
        v0 = v0 * r; v1 = v1 * r;
        if ((cb % 96) == 64) {
            const f32x4 cs = *(const f32x4*)(COS + (size_t)row * 16 + 4 * fq), sn = *(const f32x4*)(SIN + (size_t)row * 16 + 4 * fq);
            const f32x4 o1 = v0 * cs - v1 * sn, o2 = v0 * sn + v1 * cs; v0 = o1; v1 = o2;
        }
        *(u32x4*)(QM + (size_t)row * 768 + cb + 8 * fq) = pack8(v0, v1);
    }
};
struct FKVup {
    bf16_t* KM; bf16_t* VM; const float* RSQ;
    __device__ __forceinline__ float rowscale(int row) const {
        const f32x4 a = *(const f32x4*)(RSQ + (size_t)row * 24 + 12), b = *(const f32x4*)(RSQ + (size_t)row * 24 + 16);
        const float ss = ((a[0] + a[1]) + (a[2] + a[3])) + ((b[0] + b[1]) + (b[2] + b[3]));
        return __builtin_amdgcn_rsqf(ss * (1.0f / 256.0f) + RMS_EPS); }
    __device__ __forceinline__ void operator()(int row, float r, int cb, int fq, f32x4 v0, f32x4 v1) const {
        v0 = v0 * r; v1 = v1 * r;
        const int h = cb >> 7, w = cb & 127;
        if (w < 64) *(u32x4*)(KM + (size_t)row * 768 + h * 96 + w + 8 * fq) = pack8(v0, v1);
        else *(u32x4*)(VM + (size_t)row * 512 + h * 64 + (w - 64) + 8 * fq) = pack8(v0, v1);
    }
};
struct FBr1 {
    bf16_t* T1; const bf16_t* SA;
    __device__ __forceinline__ float rowscale(int) const { return 1.f; }
    __device__ __forceinline__ void operator()(int row, float rs, int cb, int fq, f32x4 v0, f32x4 v1) const {
        const size_t o = (size_t)row * 1024 + cb + 8 * fq; f32x4 s0, s1; unpack8(*(const u32x4*)(SA + o), s0, s1);
        *(u32x4*)(T1 + o) = pack8(v0 * s0, v1 * s1);
    }
};
struct FBr2 {
    bf16_t* MB; const bf16_t* T1; const bf16_t* SB;
    __device__ __forceinline__ float rowscale(int) const { return 1.f; }
    __device__ __forceinline__ void operator()(int row, float rs, int cb, int fq, f32x4 v0, f32x4 v1) const {
        const size_t o = (size_t)row * 1024 + cb + 8 * fq; f32x4 s0, s1, t0, t1; unpack8(*(const u32x4*)(SB + o), s0, s1); unpack8(*(const u32x4*)(T1 + o), t0, t1);
        *(u32x4*)(MB + o) = pack8(t0 + v0 * s0, t1 + v1 * s1);
    }
};
struct FRes {
    float* PRE; const float* X; const float* gate;
    __device__ __forceinline__ float rowscale(int) const { return 1.f; }
    __device__ __forceinline__ void operator()(int row, float rs, int cb, int fq, f32x4 v0, f32x4 v1) const {
        const int b = row >> 11; const float* gp = gate + (size_t)b * 6144 + cb + 4 * fq;
        const size_t o = (size_t)row * 1024 + cb + 4 * fq;
        const f32x4 g0 = *(const f32x4*)gp, g1 = *(const f32x4*)(gp + 16), x0 = *(const f32x4*)(X + o), x1 = *(const f32x4*)(X + o + 16);
        *(f32x4*)(PRE + o) = x0 * ALPHA + g0 * v0; *(f32x4*)(PRE + o + 16) = x1 * ALPHA + g1 * v1;
    }
};
struct FMoeOut {
    bf16_t* Y; const int* RMAP;
    __device__ __forceinline__ float rowscale(int) const { return 1.f; }
    __device__ __forceinline__ void operator()(int row, float rs, int cb, int fq, f32x4 v0, f32x4 v1) const {
        const int s = RMAP[row];
        if (s >= 0) *(u32x4*)(Y + (size_t)s * 1024 + cb + 8 * fq) = pack8(v0, v1);
    }
};

template <int MODE, bool ROUTE>
__device__ __forceinline__ void ln_phase(const Ctx& C, const float* PRE, float* XF, bf16_t* H, const float* lng, const float* lnb, const float* sc, const float* sh,
                                         const bf16_t* Y, const float* GATE, const float* g2, const float* rw, const float* rb, int* SEL, float* GOUT, unsigned* CNT) {
    int lane_ = C.lane; asm volatile("" : "+v"(lane_)); const int lane = lane_; const int wg = blockIdx.x; const int b = (wg * 128) >> 11;
    f32x4 vg[4], vb[4], vsc[4], vsh[4], vg2[4];
#pragma unroll
    for (int j = 0; j < 4; ++j) { const int c = 4 * lane + 256 * j; vg[j] = *(const f32x4*)(lng + c); vb[j] = *(const f32x4*)(lnb + c);
        if (sc) { vsc[j] = *(const f32x4*)(sc + (size_t)b * 6144 + c) + 1.0f; vsh[j] = *(const f32x4*)(sh + (size_t)b * 6144 + c); }
        if (MODE == 1) vg2[j] = *(const f32x4*)(g2 + (size_t)b * 6144 + c); }
    LAS float* rwl = (LAS float*)C.lds;
    LAS unsigned* hist = (LAS unsigned*)(C.lds + 32768);
    if (ROUTE) { for (int i = C.tid; i < 8192; i += NWAVES * 64) rwl[i] = rw[i]; if (C.tid < 8) hist[C.tid] = 0u; __syncthreads(); }
    for (int rr = 0; rr < 8; ++rr) {
        f32x4 vv[2][4]; u32x2 rya[2][4], ryb[2][4]; float rga[2], rgb[2];
#pragma unroll
        for (int h2 = 0; h2 < 2; ++h2) { const int row = wg * 128 + C.wave * 16 + rr + 8 * h2;
            if (MODE == 0) {
#pragma unroll
                for (int j = 0; j < 4; ++j) vv[h2][j] = *(const f32x4*)(PRE + (size_t)row * 1024 + 4 * lane + 256 * j);
            } else {
                rga[h2] = GATE[2 * row]; rgb[h2] = GATE[2 * row + 1];
#pragma unroll
                for (int j = 0; j < 4; ++j) { const int c = 4 * lane + 256 * j; vv[h2][j] = *(const f32x4*)(XF + (size_t)row * 1024 + c);
                    rya[h2][j] = *(const u32x2*)(Y + (size_t)(2 * row) * 1024 + c); ryb[h2][j] = *(const u32x2*)(Y + (size_t)(2 * row + 1) * 1024 + c); }
            } }
#pragma unroll
      for (int h2 = 0; h2 < 2; ++h2) { const int row = wg * 128 + C.wave * 16 + rr + 8 * h2;
        f32x4 v[4];
        if (MODE == 0) {
#pragma unroll
            for (int j = 0; j < 4; ++j) v[j] = vv[h2][j];
        } else {
            const float ga = rga[h2], gb = rgb[h2];
#pragma unroll
            for (int j = 0; j < 4; ++j) { const f32x4 xv = vv[h2][j]; const u32x2 ya = rya[h2][j], yb = ryb[h2][j];
                f32x4 fa, fb; fa[0] = __uint_as_float(ya.x << 16); fa[1] = __uint_as_float(ya.x & 0xffff0000u); fa[2] = __uint_as_float(ya.y << 16); fa[3] = __uint_as_float(ya.y & 0xffff0000u);
                fb[0] = __uint_as_float(yb.x << 16); fb[1] = __uint_as_float(yb.x & 0xffff0000u); fb[2] = __uint_as_float(yb.y << 16); fb[3] = __uint_as_float(yb.y & 0xffff0000u);
                v[j] = xv * ALPHA + vg2[j] * (fa * ga + fb * gb); }
        }
        float s = 0.f;
#pragma unroll
        for (int j = 0; j < 4; ++j) s += (v[j][0] + v[j][1]) + (v[j][2] + v[j][3]);
        const float mean = wave_sum(s) * (1.f / 1024.f); float s2 = 0.f;
#pragma unroll
        for (int j = 0; j < 4; ++j) { v[j] = v[j] - mean; s2 += (v[j][0] * v[j][0] + v[j][1] * v[j][1]) + (v[j][2] * v[j][2] + v[j][3] * v[j][3]); }
        const float rstd = 1.f / sqrtf(wave_sum(s2) * (1.f / 1024.f) + LN_EPS);
        float lg[8];
        if (ROUTE) {
#pragma unroll
            for (int e = 0; e < 8; ++e) lg[e] = 0.f; }
#pragma unroll
        for (int j = 0; j < 4; ++j) { const int c = 4 * lane + 256 * j; const f32x4 y = v[j] * rstd * vg[j] + vb[j];
            *(f32x4*)(XF + (size_t)row * 1024 + c) = y;
            if (sc) { const f32x4 hh = y * vsc[j] + vsh[j];
                u32x2 w; w.x = cvt_pk_bf16(hh[0], hh[1]); w.y = cvt_pk_bf16(hh[2], hh[3]); *(u32x2*)(H + (size_t)row * 1024 + c) = w;
                if (ROUTE) {
#pragma unroll
                    for (int i = 0; i < 4; ++i) { const f32x4 w0 = *(const LAS f32x4*)(rwl + (c + i) * 8), w1 = *(const LAS f32x4*)(rwl + (c + i) * 8 + 4);
#pragma unroll
                        for (int e = 0; e < 4; ++e) { lg[e] += hh[i] * w0[e]; lg[4 + e] += hh[i] * w1[e]; } } } } }
        if (ROUTE) {
#pragma unroll
            for (int e = 0; e < 8; ++e) lg[e] = wave_sum(lg[e]) + rb[e];
            int i0 = 0; float m0 = lg[0];
#pragma unroll
            for (int e = 1; e < 8; ++e) if (lg[e] > m0) { m0 = lg[e]; i0 = e; }
            int i1 = -1; float m1 = -INFINITY;
#pragma unroll
            for (int e = 0; e < 8; ++e) if (e != i0 && lg[e] > m1) { m1 = lg[e]; i1 = e; }
            const float g0 = 1.0f / (1.0f + expf(m1 - m0));
            if (lane == 0) { SEL[row] = i0 | (i1 << 8); GOUT[2 * row] = g0; GOUT[2 * row + 1] = 1.0f - g0; atomicAdd((unsigned*)&hist[i0], 1u); atomicAdd((unsigned*)&hist[i1], 1u); }
        }
      }
    }
    if (ROUTE) { __syncthreads(); if (C.tid < 8) atomicAdd(CNT + C.tid, (unsigned)hist[C.tid]); }
}

constexpr int NPH_L = 10, NPHASE = 2 + DEPTH * NPH_L;
#ifndef LB2
#define LB2 2
#endif
#ifdef NVGPR
__attribute__((amdgpu_num_vgpr(NVGPR)))
#endif
__global__ void __launch_bounds__(NWAVES * 64, LB2) mk_fwd(Args args) {
    extern __shared__ __attribute__((aligned(16))) unsigned char lds[];
    const int wave0 = __builtin_amdgcn_readfirstlane((int)threadIdx.x >> 6);
    Ctx C; C.lds = (LAS unsigned char*)lds; C.wave = wave0; C.lane = (int)__builtin_amdgcn_mbcnt_hi(~0u, __builtin_amdgcn_mbcnt_lo(~0u, 0u)); C.tid = wave0 * 64 + C.lane;
    C.G = gridDim.x; { const int bx = blockIdx.x; C.vcu = (C.G % 8 == 0) ? (bx % 8) * (C.G / 8) + bx / 8 : bx; }
    KArgP ka0 = kargs();
    unsigned* const ctl0 = (unsigned*)(ka0->ws + WS_CTL);
    volatile LAS unsigned* MISC = (volatile LAS unsigned*)(C.lds + MISC_OFF);
    for (int u = C.tid; u < (LDS_BYTES - LDSCTL_OFF) / 4; u += NWAVES * 64) ((LAS unsigned*)(C.lds + LDSCTL_OFF))[u] = 0u;
    __syncthreads();
    XcdBarrier bar; bar.bar = ctl0 + CW_BAR; bar.x = 0; bar.st = nullptr;
    if (!MK_PER_PHASE) bar = xcd_barrier_post(ctl0 + CW_BAR, MISC + 8, C.tid == 0);
    const int lo = ka0->ph_lo, hi = ka0->ph_hi;
#define GEMM_RUN(call) do { call; if (PROBE == 1) { asm volatile("s_waitcnt vmcnt(0)" ::: "memory"); __syncthreads(); call; } } while (0)
#define FRESH() do { int l_; asm volatile("v_mbcnt_lo_u32_b32 %0, -1, 0\n\tv_mbcnt_hi_u32_b32 %0, -1, %0" : "=v"(l_)); C.lane = l_; C.wave = wave0; C.tid = wave0 * 64 + l_; } while (0)
#define IN(k) (lo <= (k) && (k) < hi)
#define SEAM(k) do { if (IN((k) + 1)) { FRESH(); XcdBarrier b2_ = bar; asm volatile("" : "+s"(b2_.bar)); xcd_barrier(b2_, C.tid == 0); if (PROBE == 6) xcd_barrier(b2_, C.tid == 0); } } while (0)
#define MOD ((float*)(ws + WS_MOD))
#define PART ((float*)(ws + WS_PART))
#define RSQ ((float*)(ws + WS_RSQ))
#define COS ((float*)(ws + WS_COS))
#define SIN ((float*)(ws + WS_SIN))
#define H ((bf16_t*)(ws + WS_H))
#define LAT ((bf16_t*)(ws + WS_LAT))
#define ZB ((bf16_t*)(ws + WS_ZB))
#define QM ((bf16_t*)(ws + WS_QM))
#define KM ((bf16_t*)(ws + WS_KM))
#define VM ((bf16_t*)(ws + WS_VM))
#define OM ((bf16_t*)(ws + WS_OM))
#define PRE ((float*)(ws + WS_PRE))
#define T1 ((bf16_t*)(ws + WS_T1))
#define MB ((bf16_t*)(ws + WS_MB))
#define DQ (ZB)
#define DK (ZB + (size_t)T * 1024)
#define DV (ZB + (size_t)2 * T * 1024)
#define SA (ZB + (size_t)3 * T * 1024)
#define SB (ZB + (size_t)4 * T * 1024)
#define XF (ka->out)
#define ctl ((unsigned*)(ws + WS_CTL))
#define gw (C.vcu * NWAVES + C.wave)
#define NGW (C.G * NWAVES)

    if (PHM(10) && IN(0)) { KArgP ka = kargs(); (void)ka; FRESH(); unsigned char* const ws = ka->ws; C.ws = ws;
        for (int rep = 0; rep < (PROBE == 4 ? 2 : 1); ++rep) { cvt_mixer_weights(C, 0); cvt_ffn_weights(C, 0); }
        LAS float* cond = (LAS float*)(C.lds + C.wave * 8448);
        for (int it = gw; it < 4 * 24 * 8; it += NGW) {
            const int kc = it & 7, jb = (it >> 3) % 24, l = it / (8 * 24);
            for (int i = C.lane; i < 2048; i += 64) { const int k = i >> 4, b = i & 15; const float cv = ka->c[b * 1024 + kc * 128 + k]; cond[k * 16 + b] = cv / (1.0f + expf(-cv)); }
            asm volatile("s_waitcnt lgkmcnt(0)" ::: "memory");
            f32x4 acc[16];
#pragma unroll
            for (int b = 0; b < 16; ++b) acc[b] = (f32x4){0.f, 0.f, 0.f, 0.f};
            const float* wp = ka->w_ada + ((size_t)l * 1024 + kc * 128) * 6144 + jb * 256 + 4 * C.lane;
#pragma unroll 4
            for (int k = 0; k < 128; ++k) { const f32x4 w = *(const f32x4*)(wp + (size_t)k * 6144);
                const f32x4 c0 = *(const LAS f32x4*)(cond + k * 16), c1 = *(const LAS f32x4*)(cond + k * 16 + 4), c2 = *(const LAS f32x4*)(cond + k * 16 + 8), c3 = *(const LAS f32x4*)(cond + k * 16 + 12);
#pragma unroll
                for (int b = 0; b < 4; ++b) { acc[b] += w * c0[b]; acc[4 + b] += w * c1[b]; acc[8 + b] += w * c2[b]; acc[12 + b] += w * c3[b]; } }
#pragma unroll
            for (int b = 0; b < 16; ++b) *(f32x4*)(PART + (((size_t)kc * 4 + l) * 16 + b) * 6144 + jb * 256 + 4 * C.lane) = acc[b];
            asm volatile("s_waitcnt lgkmcnt(0)" ::: "memory");
        }
        for (int i = blockIdx.x * (NWAVES * 64) + C.tid; i < T * 16; i += C.G * NWAVES * 64) {
            const int t = i >> 4, j = i & 15; const float inv = powf(10000.0f, -(float)j * (1.0f / 16.0f)); const float ang = (float)ka->pos[t] * inv;
            COS[i] = cosf(ang); SIN[i] = sinf(ang); }
        SEAM(0);
    }
    if (PHM(11) && IN(1)) { KArgP ka = kargs(); (void)ka; FRESH(); unsigned char* const ws = ka->ws; C.ws = ws;
        for (int i = blockIdx.x * (NWAVES * 64) + C.tid; i < 4 * 16 * 6144; i += C.G * NWAVES * 64) {
            const int j = i % 6144, l = i / (16 * 6144); float s = ka->b_ada[l * 6144 + j];
#pragma unroll
            for (int kc = 0; kc < 8; ++kc) s += PART[(size_t)kc * 4 * 16 * 6144 + i];
            MOD[i] = s; }
        { const int wg = blockIdx.x, b = (wg * 128) >> 11; f32x4 vsc[4], vsh[4];
#pragma unroll
          for (int j = 0; j < 4; ++j) { const int c = 4 * C.lane + 256 * j; f32x4 a = *(const f32x4*)(ka->b_ada + c), s = *(const f32x4*)(ka->b_ada + 1024 + c);
#pragma unroll
              for (int kc = 0; kc < 8; ++kc) { const float* p = PART + (((size_t)kc * 4 + 0) * 16 + b) * 6144; a += *(const f32x4*)(p + c); s += *(const f32x4*)(p + 1024 + c); }
              vsh[j] = a; vsc[j] = s + 1.0f; }
          for (int rr = 0; rr < 16; ++rr) { const int row = wg * 128 + C.wave * 16 + rr;
#pragma unroll
              for (int j = 0; j < 4; ++j) { const int c = 4 * C.lane + 256 * j; const f32x4 xv = *(const f32x4*)(ka->x + (size_t)row * 1024 + c); const f32x4 hh = xv * vsc[j] + vsh[j];
                  u32x2 w; w.x = cvt_pk_bf16(hh[0], hh[1]); w.y = cvt_pk_bf16(hh[2], hh[3]); *(u32x2*)(H + (size_t)row * 1024 + c) = w; } } }
        SEAM(1);
    }

    for (int l = 0; l < DEPTH; ++l) {
        const int P = 2 + l * NPH_L;
        const bool moe = (l & 1) != 0; const int li = l >> 1;
        if (PHM(0) && IN(P + 0)) { KArgP ka = kargs(); (void)ka; FRESH(); unsigned char* const ws = ka->ws; C.ws = ws;
            pg8::Gemm g{H, (const bf16_t*)(ws + W_IN), T, NZ, 1024, 1024}; pg8::StaticOrder S; S.init(T, NZ, C.G, (int)blockIdx.x);
            pg8::EpiRow<FIn, true> E{FIn{LAT, ZB, KM, RSQ, COS, SIN}};
            GEMM_RUN(pg8::gemm_phase(C.lds, C.tid, g, S, E));
            SEAM(P + 0);
        }
        if (PHM(1) && IN(P + 1)) { KArgP ka = kargs(); (void)ka; FRESH(); unsigned char* const ws = ka->ws; C.ws = ws;
            { pg8::Gemm g{LAT, (const bf16_t*)(ws + W_QUP), T, 768, 384, 768}; pg8::StaticOrder S; S.init(T, 768, C.G, (int)blockIdx.x);
              pg8::EpiRow<FQup, true> E{FQup{QM, RSQ, COS, SIN}}; GEMM_RUN(pg8::gemm_phase(C.lds, C.tid, g, S, E)); }
            { pg8::Gemm g{LAT + 512, (const bf16_t*)(ws + W_KVUP), T, 1024, 256, 768}; pg8::StaticOrder S; S.init(T, 1024, C.G, (int)blockIdx.x);
              pg8::EpiRow<FKVup, true> E{FKVup{KM, VM, RSQ}}; GEMM_RUN(pg8::gemm_phase(C.lds, C.tid, g, S, E)); }
            SEAM(P + 1);
        }
        if (PHM(2) && IN(P + 2)) { KArgP ka = kargs(); (void)ka; FRESH(); unsigned char* const ws = ka->ws; C.ws = ws;
            float lam;
            { float s1 = 0.f, s2 = 0.f;
              for (int i = 0; i < 64; ++i) { s1 += ka->lq1[l * 64 + i] * ka->lk1[l * 64 + i]; s2 += ka->lq2[l * 64 + i] * ka->lk2[l * 64 + i]; }
              lam = expf(s1) - expf(s2) + ka->lam_init[l]; }
            const int xcd = C.vcu >> 5, jj = C.vcu & 31; const bool g256 = (C.G == 256);
            for (int rep = 0; rep < (PROBE == 2 ? 2 : 1); ++rep)
            for (int i = 0; ; ++i) {
                int u; if (g256) { if (i >= 4) break; u = xcd * 128 + i * 32 + jj; } else { u = i * C.G + C.vcu; if (u >= 1024) break; }
                const int bh = u >> 3, qb = u & 7, b = bh >> 3, h = bh & 7; const size_t r0 = (size_t)b * SEQ;
                att::DiffArgs da{nullptr, 0.f, 0.f, 0.f, nullptr};
                att::attn_unit<false>(QM + (r0 + qb * 256) * 768 + h * 96, KM + r0 * 768 + h * 96, VM + r0 * 512 + h * 64, OM + (r0 + qb * 256) * 512 + h * 64, qb * 256, da, (char*)lds, C.tid);
            }
            for (int rep = 0; rep < (PROBE == 3 ? 2 : 1); ++rep)
            for (int i = 0; ; ++i) {
                int u; if (g256) { if (i >= 8) break; u = xcd * 256 + i * 32 + jj; } else { u = i * C.G + C.vcu; if (u >= 2048) break; }
                const int bh = u >> 4, qb = u & 15, b = bh >> 3, h = bh & 7; const size_t r0 = (size_t)b * SEQ;
                att::DiffArgs da{ka->pos + r0, exp2f(-(float)(h + 1)) * LOG2E, lam, 1.0f - ka->lam_init[l], ka->diff_norm_g + l * 1024 + h * 128};
                att::attn_unit<true>(DQ + (r0 + qb * 128) * 1024 + h * 128, DK + r0 * 1024 + h * 128, DV + r0 * 1024 + h * 128,
                                     ((PROBE == 3 && rep == 0) ? (bf16_t*)(ws + WS_END + 8 * MiB) : DQ) + (r0 + qb * 128) * 1024 + h * 128, qb * 128, da, (char*)lds, C.tid);
            }
            SEAM(P + 2);
        }
        if (PHM(3) && IN(P + 3)) { KArgP ka = kargs(); (void)ka; FRESH(); unsigned char* const ws = ka->ws; C.ws = ws;
            { pg8::Gemm g{OM, (const bf16_t*)(ws + W_BRM), T, 1024, 512, 512}; pg8::StaticOrder S; S.init(T, 1024, C.G, (int)blockIdx.x);
              pg8::EpiRow<FBr1, true> E{FBr1{T1, SA}}; GEMM_RUN(pg8::gemm_phase(C.lds, C.tid, g, S, E)); }
            asm volatile("s_waitcnt vmcnt(0)" ::: "memory"); __syncthreads();
            { pg8::Gemm g{DQ, (const bf16_t*)(ws + W_BRD), T, 1024, 1024, 1024}; pg8::StaticOrder S; S.init(T, 1024, C.G, (int)blockIdx.x);
              pg8::EpiRow<FBr2, true> E{FBr2{MB, T1, SB}}; GEMM_RUN(pg8::gemm_phase(C.lds, C.tid, g, S, E)); }
            SEAM(P + 3);
        }
        if (PHM(4) && IN(P + 4)) { KArgP ka = kargs(); (void)ka; FRESH(); unsigned char* const ws = ka->ws; C.ws = ws;
            pg8::Gemm g{MB, (const bf16_t*)(ws + W_OUT), T, 1024, 1024, 1024}; pg8::StaticOrder S; S.init(T, 1024, C.G, (int)blockIdx.x);
            const float* xres = (l == 0) ? ka->x : XF;
            pg8::EpiRow<FRes, false> E{FRes{PRE, xres, (MOD + (size_t)l * 16 * 6144) + 2048}}; GEMM_RUN(pg8::gemm_phase(C.lds, C.tid, g, S, E));
            SEAM(P + 4);
        }
        if (PHM(5) && IN(P + 5)) { KArgP ka = kargs(); (void)ka; FRESH(); unsigned char* const ws = ka->ws; C.ws = ws;
            if (moe) ln_phase<0, true>(C, PRE, XF, H, ka->ln1_g + l * 1024, ka->ln1_b + l * 1024, (MOD + (size_t)l * 16 * 6144) + 4096, (MOD + (size_t)l * 16 * 6144) + 3072, nullptr, nullptr, nullptr,
                                       ka->router_w + (size_t)li * 8192, ka->router_b + li * 8, (int*)(ws + WS_SEL), (float*)(ws + WS_GATE), ctl + CW_CNT + 64 * li);
            else for (int rep = 0; rep < (PROBE == 5 ? 2 : 1); ++rep) ln_phase<0, false>(C, PRE, XF, H, ka->ln1_g + l * 1024, ka->ln1_b + l * 1024, (MOD + (size_t)l * 16 * 6144) + 4096, (MOD + (size_t)l * 16 * 6144) + 3072, nullptr, nullptr, nullptr, nullptr, nullptr, nullptr, nullptr, nullptr);
            SEAM(P + 5);
        }
        int ts[9];
#pragma unroll
        for (int e = 0; e < 9; ++e) ts[e] = 0;
        if (moe && (IN(P + 6) || IN(P + 7) || IN(P + 8))) { KArgP ka = kargs(); unsigned char* const ws = ka->ws;
            int accp = 0;
#pragma unroll
            for (int e = 0; e < 8; ++e) { ts[e] = accp; const int cnt = (int)__hip_atomic_load(ctl + CW_CNT + 64 * li + e, __ATOMIC_RELAXED, __HIP_MEMORY_SCOPE_AGENT); accp += (cnt + 255) >> 8; }
            ts[8] = accp;
        }
        if (PHM(6) && IN(P + 6)) { KArgP ka = kargs(); (void)ka; FRESH(); unsigned char* const ws = ka->ws; C.ws = ws;
            if (moe) {
                const int* SEL = (const int*)(ws + WS_SEL); int* RMAP = (int*)(ws + WS_RMAP); bf16_t* XB = (bf16_t*)(ws + WS_XB);
                unsigned* CUR = ctl + CW_CUR + 64 * li; const unsigned* CNT = ctl + CW_CNT + 64 * li;
                if (blockIdx.x == 0) {
                    _Pragma("unroll") for (int e = 0; e < 8; ++e) { const int c = (int)CNT[e], beg = ts[e] * 256 + c, end = ts[e + 1] * 256; for (int p = beg + C.tid; p < end; p += NWAVES * 64) RMAP[p] = -1; } }
                for (int s0 = gw * 64; s0 < 2 * T; s0 += NGW * 64) {
                    const int s = s0 + C.lane, t = s >> 1, k = s & 1; const int sel = SEL[t]; const int e = k ? (sel >> 8) : (sel & 255);
                    int pos = 0;
#pragma unroll
                    for (int ee = 0; ee < 8; ++ee) { const unsigned long long m = __ballot(e == ee); const int n = __popcll(m);
                        if (n) { unsigned base = 0; if (C.lane == 0) base = atomicAdd(CUR + ee, (unsigned)n); base = __builtin_amdgcn_readfirstlane(base);
                            if (e == ee) pos = ts[ee] * 256 + (int)base + (int)__builtin_amdgcn_mbcnt_hi((unsigned)(m >> 32), __builtin_amdgcn_mbcnt_lo((unsigned)m, 0u)); } }
                    RMAP[pos] = s;
                    for (int q = 0; q < 64; q += 8) {
                        u32x4 r0[4], r1[4];
#pragma unroll
                        for (int u = 0; u < 4; ++u) { const int tq = (s0 + q + 2 * u) >> 1; const u32x4* src = (const u32x4*)(H + (size_t)tq * 1024); r0[u] = src[C.lane]; r1[u] = src[64 + C.lane]; }
#pragma unroll
                        for (int u = 0; u < 4; ++u) {
#pragma unroll
                            for (int k2 = 0; k2 < 2; ++k2) { const int pq = __builtin_amdgcn_readlane(pos, q + 2 * u + k2); u32x4* dst = (u32x4*)(XB + (size_t)pq * 1024); dst[C.lane] = r0[u]; dst[64 + C.lane] = r1[u]; } }
                    }
                }
            }
            if (moe) SEAM(P + 6);
        }
        if (PHM(7) && IN(P + 7)) { KArgP ka = kargs(); (void)ka; FRESH(); unsigned char* const ws = ka->ws; C.ws = ws;
            if (!moe) { pg8::Gemm g{H, (const bf16_t*)(ws + WS_WFF), T, 5632, 1024, 1024}; pg8::StaticOrder S; S.init(T, 5632, C.G, (int)blockIdx.x);
                pg8::EpiSwiglu E{(bf16_t*)(ws + WS_U), FF}; GEMM_RUN(pg8::gemm_phase(C.lds, C.tid, g, S, E)); }
            else { pg8::Gemm g{(const bf16_t*)(ws + WS_XB), (const bf16_t*)(ws + WS_WFF), ts[8] * 256, 5632, 1024, 1024};
                pg8::MoeOrder S; S.so.init(ts[8] * 256, 5632, C.G, (int)blockIdx.x); S.ts1 = ts[1]; S.ts2 = ts[2]; S.ts3 = ts[3]; S.ts4 = ts[4]; S.ts5 = ts[5]; S.ts6 = ts[6]; S.ts7 = ts[7]; S.estride = W13_ESTRIDE;
                pg8::EpiSwiglu E{(bf16_t*)(ws + WS_UM), FF}; GEMM_RUN(pg8::gemm_phase(C.lds, C.tid, g, S, E)); }
            SEAM(P + 7);
        }
        if (PHM(8) && IN(P + 8)) { KArgP ka = kargs(); (void)ka; FRESH(); unsigned char* const ws = ka->ws; C.ws = ws;
            if (!moe) { pg8::Gemm g{(const bf16_t*)(ws + WS_U), (const bf16_t*)(ws + W2_BASE), T, 1024, FF, FF}; pg8::StaticOrder S; S.init(T, 1024, C.G, (int)blockIdx.x);
                pg8::EpiRow<FRes, false> E{FRes{PRE, XF, (MOD + (size_t)l * 16 * 6144) + 5120}}; GEMM_RUN(pg8::gemm_phase(C.lds, C.tid, g, S, E)); }
            else { pg8::Gemm g{(const bf16_t*)(ws + WS_UM), (const bf16_t*)(ws + W2_BASE), ts[8] * 256, 1024, FF, FF};
                pg8::MoeOrder S; S.so.init(ts[8] * 256, 1024, C.G, (int)blockIdx.x); S.ts1 = ts[1]; S.ts2 = ts[2]; S.ts3 = ts[3]; S.ts4 = ts[4]; S.ts5 = ts[5]; S.ts6 = ts[6]; S.ts7 = ts[7]; S.estride = W2_ESTRIDE;
                pg8::EpiRow<FMoeOut, true> E{FMoeOut{(bf16_t*)(ws + WS_Y), (const int*)(ws + WS_RMAP)}}; GEMM_RUN(pg8::gemm_phase(C.lds, C.tid, g, S, E)); }
            SEAM(P + 8);
        }
        if (PHM(9) && IN(P + 9)) { KArgP ka = kargs(); (void)ka; FRESH(); unsigned char* const ws = ka->ws; C.ws = ws;
            const float* nsc = (l + 1 < DEPTH) ? MOD + (size_t)(l + 1) * 16 * 6144 + 1024 : nullptr; const float* nsh = (l + 1 < DEPTH) ? MOD + (size_t)(l + 1) * 16 * 6144 : nullptr;
            if (moe) ln_phase<1, false>(C, nullptr, XF, H, ka->ln2_g + l * 1024, ka->ln2_b + l * 1024, nsc, nsh, (const bf16_t*)(ws + WS_Y), (const float*)(ws + WS_GATE), (MOD + (size_t)l * 16 * 6144) + 5120, nullptr, nullptr, nullptr, nullptr, nullptr);
            else for (int rep = 0; rep < (PROBE == 5 ? 2 : 1); ++rep) ln_phase<0, false>(C, PRE, XF, H, ka->ln2_g + l * 1024, ka->ln2_b + l * 1024, nsc, nsh, nullptr, nullptr, nullptr, nullptr, nullptr, nullptr, nullptr, nullptr);
            if (l + 1 < DEPTH) for (int rep = 0; rep < (PROBE == 4 ? 2 : 1); ++rep) { __syncthreads(); cvt_mixer_weights(C, l + 1); cvt_ffn_weights(C, l + 1); }
            if (l + 1 < DEPTH) SEAM(P + 9);
        }
    }
#undef IN
#undef SEAM
#undef MOD
#undef PART
#undef RSQ
#undef COS
#undef SIN
#undef H
#undef LAT
#undef ZB
#undef QM
#undef KM
#undef VM
#undef OM
#undef PRE
#undef T1
#undef MB
#undef DQ
#undef DK
#undef DV
#undef SA
#undef SB
#undef XF
#undef ctl
#undef gw
#undef NGW
}

extern "C" void kernel_launch(void* const* d_in, const int* in_sizes, int n_in, void* d_out, int out_size, void* d_ws, size_t ws_size, hipStream_t stream) {
    static int grid = 0;
    if (grid == 0) {
        if (n_in != 30 || in_sizes[0] != T * D || out_size != T * D || ws_size < WS_NEED) { fprintf(stderr, "kernel_launch: unexpected shapes (n_in %d, in0 %d, out %d, ws %zu, need %zu)\n", n_in, n_in > 0 ? in_sizes[0] : -1, out_size, ws_size, (size_t)WS_NEED); grid = -1; return; }
        if (hipFuncSetAttribute((const void*)mk_fwd, hipFuncAttributeMaxDynamicSharedMemorySize, LDS_BYTES) != hipSuccess) { fprintf(stderr, "kernel_launch: hipFuncSetAttribute failed\n"); grid = -1; return; }
        int per_cu = 0;
        if (hipOccupancyMaxActiveBlocksPerMultiprocessor(&per_cu, (const void*)mk_fwd, NWAVES * 64, LDS_BYTES) != hipSuccess || per_cu < 1) fprintf(stderr, "kernel_launch: occupancy query reports %d\n", per_cu);
        (void)hipGetLastError();
        grid = 256;
    }
    if (grid < 0) return;
    if (hipMemsetAsync((char*)d_ws + WS_CTL, 0, CTL_ZERO_BYTES, stream) != hipSuccess) { fprintf(stderr, "kernel_launch: memset failed\n"); return; }
    Args a{};
    const float** fp = (const float**)&a.x;
    a.x = (const float*)d_in[0]; a.c = (const float*)d_in[1]; a.pos = (const int*)d_in[2]; a.w_ada = (const float*)d_in[3]; a.b_ada = (const float*)d_in[4]; a.w_in = (const float*)d_in[5];
    a.q_norm_g = (const float*)d_in[6]; a.w_q_up = (const float*)d_in[7]; a.kv_norm_g = (const float*)d_in[8]; a.w_kv_up = (const float*)d_in[9];
    a.lq1 = (const float*)d_in[10]; a.lk1 = (const float*)d_in[11]; a.lq2 = (const float*)d_in[12]; a.lk2 = (const float*)d_in[13]; a.diff_norm_g = (const float*)d_in[14];
    a.w_br_mla = (const float*)d_in[15]; a.w_br_diff = (const float*)d_in[16]; a.w_out = (const float*)d_in[17];
    a.ln1_g = (const float*)d_in[18]; a.ln1_b = (const float*)d_in[19]; a.ln2_g = (const float*)d_in[20]; a.ln2_b = (const float*)d_in[21];
    a.ffn_w1 = (const float*)d_in[22]; a.ffn_w3 = (const float*)d_in[23]; a.ffn_w2 = (const float*)d_in[24]; a.router_w = (const float*)d_in[25]; a.router_b = (const float*)d_in[26];
    a.moe_w1 = (const float*)d_in[27]; a.moe_w3 = (const float*)d_in[28]; a.moe_w2 = (const float*)d_in[29];
    (void)fp;
    a.out = (float*)d_out; a.ws = (unsigned char*)d_ws;
    for (int l = 0; l < 4; ++l) a.lam_init[l] = (float)(0.8 - 0.6 * exp(-0.3 * (double)l));
#if MK_PER_PHASE
    for (int p = 0; p < NPHASE; ++p) {
        const int k = (p - 2) % NPH_L, l = (p - 2) / NPH_L;
        if (p >= 2 && k == 6 && (l & 1) == 0) continue;
        a.ph_lo = p; a.ph_hi = p + 1;
        hipLaunchKernelGGL(mk_fwd, dim3(grid), dim3(NWAVES * 64), LDS_BYTES, stream, a);
    }
#else
    a.ph_lo = 0; a.ph_hi = NPHASE;
    hipLaunchKernelGGL(mk_fwd, dim3(grid), dim3(NWAVES * 64), LDS_BYTES, stream, a);
#endif
    const hipError_t le = hipPeekAtLastError();
    if (le != hipSuccess) fprintf(stderr, "kernel_launch: launch failed: %s\n", hipGetErrorName(le));
}
```

```cpp
#include <hip/hip_runtime.h>
#include <hip/hip_bf16.h>
#include <cstdio>
#include <cstdint>
#include <cmath>

#ifndef MK_PER_PHASE
#define MK_PER_PHASE 0
#endif
#ifndef PH_MASK
#define PH_MASK 0xFFFF
#endif
#define PHM(k) (((PH_MASK) >> (k)) & 1)
#ifndef PROBE
#define PROBE 0
#endif

constexpr int D = 1024, BATCH = 16, SEQ = 2048, DEPTH = 4, T = BATCH * SEQ;
constexpr int NZ = 5888;
constexpr int FF = 2816, NEXP = 8;
constexpr float ALPHA = 1.681792830507429f;
constexpr float LN_EPS = 1e-5f, RMS_EPS = 1e-6f;
constexpr float LOG2E = 1.4426950408889634f;
constexpr float CQ_MLA = 0.10206207261596575f * LOG2E;
constexpr float CQ_DIFF = 0.125f * LOG2E;

#define LAS __attribute__((address_space(3)))
#define GAS __attribute__((address_space(1)))
typedef unsigned short bf16_t;
typedef short bf16x8 __attribute__((ext_vector_type(8)));
typedef short s16x4 __attribute__((ext_vector_type(4)));
typedef float f32x4 __attribute__((ext_vector_type(4)));
typedef float f32x2 __attribute__((ext_vector_type(2)));
typedef float f32x16 __attribute__((ext_vector_type(16)));
typedef unsigned u32x4 __attribute__((ext_vector_type(4)));
typedef unsigned u32x2 __attribute__((ext_vector_type(2)));

__device__ __forceinline__ unsigned cvt_pk_bf16(float lo, float hi) { unsigned r; asm volatile("v_cvt_pk_bf16_f32 %0, %1, %2" : "=v"(r) : "v"(lo), "v"(hi)); return r; }
__device__ __forceinline__ u32x4 pack8(f32x4 a, f32x4 b) { u32x4 w; w.x = cvt_pk_bf16(a[0], a[1]); w.y = cvt_pk_bf16(a[2], a[3]); w.z = cvt_pk_bf16(b[0], b[1]); w.w = cvt_pk_bf16(b[2], b[3]); return w; }
__device__ __forceinline__ void unpack8(u32x4 w, f32x4& a, f32x4& b) {
    a[0] = __uint_as_float(w.x << 16); a[1] = __uint_as_float(w.x & 0xffff0000u); a[2] = __uint_as_float(w.y << 16); a[3] = __uint_as_float(w.y & 0xffff0000u);
    b[0] = __uint_as_float(w.z << 16); b[1] = __uint_as_float(w.z & 0xffff0000u); b[2] = __uint_as_float(w.w << 16); b[3] = __uint_as_float(w.w & 0xffff0000u); }
__device__ __forceinline__ float bf2f(bf16_t v) { return __uint_as_float(((unsigned)v) << 16); }
template <int X> __device__ __forceinline__ float swz_xor(float v) { return __int_as_float(__builtin_amdgcn_ds_swizzle(__float_as_int(v), (X << 10) | 0x1f)); }
__device__ __forceinline__ float sum_x32(float v) { auto rr = __builtin_amdgcn_permlane32_swap(__float_as_uint(v), __float_as_uint(v), false, false); return __uint_as_float(rr[0]) + __uint_as_float(rr[1]); }
__device__ __forceinline__ float sigmoidf_(float x) { return __builtin_amdgcn_rcpf(1.0f + __builtin_amdgcn_exp2f(-x * LOG2E)); }

namespace pg8 {
constexpr int BM = 256, BK = 64, HALF = 128, HTB = HALF * BK * 2, STAGE_BYTES = 8 * HTB, NXCD = 8, WGM = 8;
__host__ __device__ __forceinline__ int lds_byte(int r, int c) { const int st = (r >> 4) * 2 + (c >> 5), rr = r & 15, cc = c & 31, ob = rr * 64 + cc * 2; return st * 1024 + (ob ^ (((ob >> 9) & 1) << 5)); }
__host__ __device__ __forceinline__ void stage_rc(int b, int& R, int& C) { const int st = b / 1024, sb = b % 1024, swz = sb ^ (((sb >> 9) & 1) << 5); R = (st >> 1) * 16 + swz / 64; C = (st & 1) * 32 + (swz % 64) / 2; }
__host__ __device__ __forceinline__ int perm32(int rho) { const int n = rho >> 4, i = rho & 15; return 8 * (i >> 2) + 4 * n + (i & 3); }

struct Unit { int pm, pn; };
struct Gemm { const bf16_t* A; const bf16_t* Bt; int M, N, K, lda; };

struct StaticOrder {
    int nM, nN, nwg, G, c;
    __host__ __device__ void init(int M, int N, int G_, int c_) { nM = M / BM; nN = N / BM; nwg = nM * nN; G = G_; c = c_; }
    __host__ __device__ bool next(int i, Unit& u) const {
        const long L = (long)i * G + c; if (L >= nwg) return false;
        int wgid = (int)L; { const int q = nwg / NXCD, r = nwg % NXCD, xcd = wgid % NXCD, off = wgid / NXCD; wgid = (xcd < r ? xcd * (q + 1) : r * (q + 1) + (xcd - r) * q) + off; }
        const int nig = WGM * nN, gid = wgid / nig, fm = gid * WGM, gsz = (nM - fm) < WGM ? (nM - fm) : WGM;
        u.pm = fm + ((wgid % nig) % gsz); u.pn = (wgid % nig) / gsz; return true;
    }
    __device__ __forceinline__ size_t bofs(const Unit&) const { return 0; }
};
struct MoeOrder {
    StaticOrder so; int ts1, ts2, ts3, ts4, ts5, ts6, ts7; size_t estride;
    __device__ __forceinline__ bool next(int i, Unit& u) const { return so.next(i, u); }
    __device__ __forceinline__ size_t bofs(const Unit& u) const {
        const int e = (u.pm >= ts1) + (u.pm >= ts2) + (u.pm >= ts3) + (u.pm >= ts4) + (u.pm >= ts5) + (u.pm >= ts6) + (u.pm >= ts7);
        return (size_t)e * estride; }
};

template <class F, bool PERM_> struct EpiRow {
    static constexpr bool PERM = PERM_; F f;
    __device__ __forceinline__ void operator()(const f32x4 (&acc)[2][2][4][2], const Unit& u, int wr, int wc, int fr, int fq) const {
#pragma unroll
        for (int ai = 0; ai < 2; ++ai)
#pragma unroll
            for (int m = 0; m < 4; ++m) { const int row = u.pm * BM + ai * HALF + wr * 64 + m * 16 + fr;
                const float rs = f.rowscale(row);
#pragma unroll
                for (int bj = 0; bj < 2; ++bj) f(row, rs, u.pn * BM + bj * HALF + wc * 32, fq, acc[ai][bj][m][0], acc[ai][bj][m][1]);
                asm volatile("" ::: "memory"); __builtin_amdgcn_sched_barrier(0); }
    }
};
struct EpiSwiglu {
    static constexpr bool PERM = true; bf16_t* U; int ldu;
    __device__ __forceinline__ void operator()(const f32x4 (&acc)[2][2][4][2], const Unit& u, int wr, int wc, int fr, int fq) const {
#pragma unroll
        for (int ai = 0; ai < 2; ++ai)
#pragma unroll
            for (int m = 0; m < 4; ++m) { const int row = u.pm * BM + ai * HALF + wr * 64 + m * 16 + fr;
                f32x4 o[2];
#pragma unroll
                for (int n = 0; n < 2; ++n) { const f32x4 a = acc[ai][0][m][n], b = acc[ai][1][m][n];
#pragma unroll
                    for (int i = 0; i < 4; ++i) o[n][i] = a[i] * sigmoidf_(a[i]) * b[i]; }
                *(u32x4*)(U + (size_t)row * ldu + u.pn * HALF + wc * 32 + 8 * fq) = pack8(o[0], o[1]); __builtin_amdgcn_sched_barrier(0); }
    }
};

template <class Epi, class Sched, bool ALIGN_EPI = true>
__device__ __forceinline__ void gemm_phase(LAS unsigned char* lds, int tid_in, const Gemm g, const Sched& S, const Epi& E) {
    int tid_ = tid_in; asm volatile("" : "+v"(tid_));
    const int tid = tid_, wid = __builtin_amdgcn_readfirstlane(tid >> 6), lane = tid & 63, wr = wid >> 2, wc = wid & 3, fr = lane & 15, fq = lane >> 4;
    const int K = g.K, nt = K / BK, lda = g.lda;
    unsigned voffA[2], voffB[2];
#pragma unroll
    for (int i = 0; i < 2; ++i) { int R, C; stage_rc(tid * 16 + i * 8192, R, C); const int Rb = Epi::PERM ? ((R & ~31) + perm32(R & 31)) : R;
        voffA[i] = (unsigned)(R * lda + C) * 2u; voffB[i] = (unsigned)(Rb * K + C) * 2u; }
    const size_t kstep = (size_t)(BK * 2);
    const size_t hstepA = (size_t)HALF * lda * 2, hstepB = (size_t)HALF * K * 2;
    const size_t tstepA = 2 * hstepA, tstepB = 2 * hstepB;
    const unsigned ldsw = (unsigned)wid * 1024u;
    const int aoff = lds_byte(wr * 64 + fr, fq * 8), boff = lds_byte(wc * 32 + fr, fq * 8);
#define PG8_SA(b, h) (((b) * 2 + (h)) * HTB)
#define PG8_SB(b, h) ((4 + (b) * 2 + (h)) * HTB)
#define PG8_STAGE(bufoff, gbase, voff) do { _Pragma("unroll") for (int _i = 0; _i < 2; ++_i) \
        __builtin_amdgcn_global_load_lds((const unsigned*)((const char*)(gbase) + (voff)[_i]), (LAS unsigned*)(lds + (bufoff) + ldsw + _i * 8192), 16, 0, 0); } while (0)
#define PG8_LDA(dst, b, h) do { _Pragma("unroll") for (int m = 0; m < 4; ++m) _Pragma("unroll") for (int k = 0; k < 2; ++k) dst[m][k] = *(const LAS bf16x8*)(lds + PG8_SA(b, h) + aoff + m * 2048 + k * 1024); } while (0)
#define PG8_LDB(dst, b, h) do { _Pragma("unroll") for (int n = 0; n < 2; ++n) _Pragma("unroll") for (int k = 0; k < 2; ++k) dst[n][k] = *(const LAS bf16x8*)(lds + PG8_SB(b, h) + boff + n * 2048 + k * 1024); } while (0)
#define PG8_MMA(ai, bj, At, Bt) do { __builtin_amdgcn_s_setprio(1); _Pragma("unroll") for (int m = 0; m < 4; ++m) _Pragma("unroll") for (int n = 0; n < 2; ++n) _Pragma("unroll") for (int k = 0; k < 2; ++k) \
        acc[ai][bj][m][n] = __builtin_amdgcn_mfma_f32_16x16x32_bf16(Bt[n][k], At[m][k], acc[ai][bj][m][n], 0, 0, 0); __builtin_amdgcn_s_setprio(0); } while (0)
#define PG8_WAIT_V(n) asm volatile("s_waitcnt vmcnt(" #n ")" ::: "memory")
#define PG8_WAIT_L(n) asm volatile("s_waitcnt lgkmcnt(" #n ")" ::: "memory")
#define PG8_BAR __builtin_amdgcn_s_barrier()
#define PG8_SCHED __builtin_amdgcn_sched_barrier(0)
    Unit cur, nxt; int ui = 0;
    if (!S.next(0, cur)) return;
    f32x4 acc[2][2][4][2];
#pragma unroll
    for (int a = 0; a < 2; ++a)
#pragma unroll
        for (int b = 0; b < 2; ++b)
#pragma unroll
            for (int m = 0; m < 4; ++m)
#pragma unroll
                for (int n = 0; n < 2; ++n) acc[a][b][m][n] = (f32x4){0.f, 0.f, 0.f, 0.f};
    bf16x8 At[4][2], B0[2][2], B1[2][2];
    const char* cA = (const char*)g.A + (size_t)cur.pm * tstepA; const char* cB = (const char*)g.Bt + S.bofs(cur) + (size_t)cur.pn * tstepB;
    PG8_STAGE(PG8_SB(0, 0), cB, voffB); PG8_STAGE(PG8_SB(0, 1), cB + hstepB, voffB); PG8_STAGE(PG8_SA(0, 0), cA, voffA); PG8_STAGE(PG8_SA(0, 1), cA + hstepA, voffA);
    if (wr == 1) PG8_BAR;
    PG8_WAIT_V(2); PG8_BAR;
    PG8_STAGE(PG8_SB(1, 0), cB + kstep, voffB); PG8_STAGE(PG8_SA(1, 0), cA + kstep, voffA); PG8_STAGE(PG8_SB(1, 1), cB + hstepB + kstep, voffB);
    PG8_WAIT_V(6); PG8_BAR;
    for (;;) {
        const bool has_next = S.next(ui + 1, nxt);
        const char* nA = has_next ? (const char*)g.A + (size_t)nxt.pm * tstepA : cA; const char* nB = has_next ? (const char*)g.Bt + S.bofs(nxt) + (size_t)nxt.pn * tstepB : cB;
#pragma unroll 1
        for (int t = 0; t < nt; t += 2) {
            const bool last = (t == nt - 2);
            const char* a1 = cA + (size_t)(t + 1) * kstep;
            const char* a2 = last ? nA : cA + (size_t)(t + 2) * kstep; const char* b2 = last ? nB : cB + (size_t)(t + 2) * kstep;
            const char* a3 = a2 + kstep; const char* b3 = b2 + kstep;
            PG8_LDB(B0, 0, 0); PG8_LDB(B1, 0, 1); PG8_SCHED; PG8_LDA(At, 0, 0); PG8_STAGE(PG8_SA(1, 1), a1 + hstepA, voffA);
            PG8_WAIT_V(8); PG8_WAIT_L(0); PG8_BAR; PG8_MMA(0, 0, At, B0); PG8_MMA(0, 1, At, B1); PG8_BAR; PG8_SCHED;
            PG8_LDA(At, 0, 1); PG8_STAGE(PG8_SB(0, 0), b2, voffB); PG8_STAGE(PG8_SB(0, 1), b2 + hstepB, voffB); PG8_STAGE(PG8_SA(0, 0), a2, voffA);
            PG8_WAIT_V(8); PG8_WAIT_L(0); PG8_BAR; PG8_MMA(1, 0, At, B0); PG8_MMA(1, 1, At, B1); PG8_BAR; PG8_SCHED;
            PG8_LDB(B0, 1, 0); PG8_LDB(B1, 1, 1); PG8_SCHED; PG8_LDA(At, 1, 0); PG8_STAGE(PG8_SA(0, 1), a2 + hstepA, voffA);
            PG8_WAIT_V(8); PG8_WAIT_L(0); PG8_BAR; PG8_MMA(0, 0, At, B0); PG8_MMA(0, 1, At, B1); PG8_BAR; PG8_SCHED;
            PG8_LDA(At, 1, 1); PG8_STAGE(PG8_SB(1, 0), b3, voffB); PG8_STAGE(PG8_SB(1, 1), b3 + hstepB, voffB); PG8_STAGE(PG8_SA(1, 0), a3, voffA);
            PG8_WAIT_V(8); PG8_WAIT_L(0); PG8_BAR; PG8_MMA(1, 0, At, B0); PG8_MMA(1, 1, At, B1); PG8_BAR; PG8_SCHED;
        }
        if constexpr (ALIGN_EPI) { if (wr == 0) PG8_BAR; }
        E(acc, cur, wr, wc, fr, fq);
        if (!has_next) break;
#pragma unroll
        for (int a = 0; a < 2; ++a)
#pragma unroll
            for (int b = 0; b < 2; ++b)
#pragma unroll
                for (int m = 0; m < 4; ++m)
#pragma unroll
                    for (int n = 0; n < 2; ++n) acc[a][b][m][n] = (f32x4){0.f, 0.f, 0.f, 0.f};
        cur = nxt; cA = nA; cB = nB; ++ui;
        if constexpr (ALIGN_EPI) { if (wr == 1) PG8_BAR; }
    }
    PG8_WAIT_V(0);
    if constexpr (!ALIGN_EPI) { if (wr == 0) PG8_BAR; }
    PG8_BAR;
#undef PG8_SA
#undef PG8_SB
#undef PG8_STAGE
#undef PG8_LDA
#undef PG8_LDB
#undef PG8_MMA
#undef PG8_WAIT_V
#undef PG8_WAIT_L
#undef PG8_BAR
#undef PG8_SCHED
}
}

namespace att {
constexpr int NW = 8, QBLK = 32, KVBLK = 64;
constexpr float THR = 11.5f;
constexpr size_t SHM_V = 16384, SHM_K = 16384;
constexpr size_t OFF_V = 0, OFF_K = 2 * SHM_V, OFF_WS = OFF_K + 2 * SHM_K, OFF_POS = OFF_WS + NW * 64 * 4, OFF_EXT = OFF_POS + SEQ * 4, ATT_LDS = OFF_EXT + 512;
#define KSWZ(row, colB) ((row) * 256 + ((colB) ^ (((row) & 7) << 4)))
#define SBAR() __builtin_amdgcn_sched_barrier(0)
__device__ __forceinline__ int crow(int r, int hi) { return (r & 3) + 8 * (r >> 2) + 4 * hi; }
__device__ __forceinline__ unsigned cvtpk(float lo, float hi) { unsigned r; asm volatile("v_cvt_pk_bf16_f32 %0, %1, %2" : "=v"(r) : "v"(lo), "v"(hi)); return r; }

__device__ __forceinline__ void partialSM(f32x16& p0, f32x16& p1, float& m_reg, float& mn, float& alpha) {
  float pmax = p0[0];
#pragma unroll
  for (int r = 1; r < 16; ++r) pmax = fmaxf(pmax, p0[r]);
#pragma unroll
  for (int r = 0; r < 16; ++r) pmax = fmaxf(pmax, p1[r]);
  { auto rr = __builtin_amdgcn_permlane32_swap(__float_as_uint(pmax), __float_as_uint(pmax), false, false);
    pmax = fmaxf(__uint_as_float(rr[0]), __uint_as_float(rr[1])); }
  if (__builtin_expect(__all(pmax - m_reg <= THR), 1)) { mn = m_reg; alpha = 1.f; }
  else { mn = fmaxf(m_reg, pmax); alpha = __builtin_amdgcn_exp2f(m_reg - mn); m_reg = mn; }
#pragma unroll
  for (int r = 0; r < 16; ++r) p0[r] = p0[r] - mn;
#pragma unroll
  for (int r = 0; r < 16; ++r) p1[r] = p1[r] - mn;
#pragma unroll
  for (int r = 0; r < 16; ++r) p0[r] = __builtin_amdgcn_exp2f(p0[r]);
}
__device__ __forceinline__ void finishSM(f32x16& p0, f32x16& p1, float alpha, float& l_reg, bf16x8& pa0, bf16x8& pa1, bf16x8& pa2, bf16x8& pa3) {
#pragma unroll
  for (int r = 0; r < 16; ++r) p1[r] = __builtin_amdgcn_exp2f(p1[r]);
  float ps = 0;
#pragma unroll
  for (int r = 0; r < 16; ++r) ps += p0[r];
#pragma unroll
  for (int r = 0; r < 16; ++r) ps += p1[r];
  { auto rr = __builtin_amdgcn_permlane32_swap(__float_as_uint(ps), __float_as_uint(ps), false, false);
    ps = __uint_as_float(rr[0]) + __uint_as_float(rr[1]); }
  l_reg = l_reg * alpha + ps;
#define PK4(P, BASE, OUT) do { unsigned a0 = cvtpk(P[BASE + 0], P[BASE + 1]), a1 = cvtpk(P[BASE + 2], P[BASE + 3]);   \
    unsigned b0 = cvtpk(P[BASE + 4], P[BASE + 5]), b1 = cvtpk(P[BASE + 6], P[BASE + 7]);                              \
    auto r0 = __builtin_amdgcn_permlane32_swap(a0, b0, false, false); auto r1 = __builtin_amdgcn_permlane32_swap(a1, b1, false, false); \
    u32x4 w = {r0[0], r1[0], r0[1], r1[1]}; OUT = *reinterpret_cast<bf16x8*>(&w); } while (0)
  PK4(p0, 0, pa0); PK4(p0, 8, pa1); PK4(p1, 0, pa2); PK4(p1, 8, pa3);
#undef PK4
}
template <int NQK> __device__ __forceinline__ void qkt(f32x16& p0, f32x16& p1, const char* Ks, const bf16x8* qr, int r32, int hi, int colb0) {
  p0 = f32x16{}; p1 = f32x16{};
#pragma unroll
  for (int d0 = 0; d0 < NQK; ++d0) { const int cb = colb0 + (d0 * 16 + hi * 8) * 2;
    bf16x8 b0 = *reinterpret_cast<const bf16x8*>(Ks + KSWZ(r32, cb));
    bf16x8 b1 = *reinterpret_cast<const bf16x8*>(Ks + KSWZ(32 + r32, cb));
    p0 = __builtin_amdgcn_mfma_f32_32x32x16_bf16(b0, qr[d0], p0, 0, 0, 0);
    p1 = __builtin_amdgcn_mfma_f32_32x32x16_bf16(b1, qr[d0], p1, 0, 0, 0); }
}
template <int NCB> __device__ __forceinline__ int v_st(int k, int c) { const int kk = (k & ~0xC) | ((k & 4) << 1) | ((k & 8) >> 1); return ((kk >> 3) * NCB + (c >> 5)) * 512 + ((kk & 7) * 32 + (c & 31)) * 2; }
__device__ __forceinline__ int v_rd_base(int lane) { return ((lane & 3) << 3) | (((lane >> 2) & 3) << 6) | (((lane >> 4) & 1) << 5) | (((lane >> 5) & 1) << 8); }
template <int NCB> constexpr int v_rd_off(int d0, int ks, int half) { return d0 * 512 + (2 * ks + half) * NCB * 512; }
template <int OFF> __device__ __forceinline__ s16x4 tr_read(int vb) { s16x4 r; asm volatile("ds_read_b64_tr_b16 %0, %1 offset:%2" : "=&v"(r) : "v"(vb), "i"(OFF) : "memory"); return r; }
template <int NCB, int D0> __device__ __forceinline__ void pv_one(f32x16& od, int vb, bf16x8 pa0, bf16x8 pa1, bf16x8 pa2, bf16x8 pa3) {
  const s16x4 l0 = tr_read<v_rd_off<NCB>(D0, 0, 0)>(vb), h0 = tr_read<v_rd_off<NCB>(D0, 0, 1)>(vb), l1 = tr_read<v_rd_off<NCB>(D0, 1, 0)>(vb), h1 = tr_read<v_rd_off<NCB>(D0, 1, 1)>(vb);
  const s16x4 l2 = tr_read<v_rd_off<NCB>(D0, 2, 0)>(vb), h2 = tr_read<v_rd_off<NCB>(D0, 2, 1)>(vb), l3 = tr_read<v_rd_off<NCB>(D0, 3, 0)>(vb), h3 = tr_read<v_rd_off<NCB>(D0, 3, 1)>(vb);
  asm volatile("s_waitcnt lgkmcnt(0)" ::: "memory"); SBAR();
#define PK(L, H) (bf16x8){L[0], L[1], L[2], L[3], H[0], H[1], H[2], H[3]}
  od = __builtin_amdgcn_mfma_f32_32x32x16_bf16(pa0, PK(l0, h0), od, 0, 0, 0);
  od = __builtin_amdgcn_mfma_f32_32x32x16_bf16(pa1, PK(l1, h1), od, 0, 0, 0);
  od = __builtin_amdgcn_mfma_f32_32x32x16_bf16(pa2, PK(l2, h2), od, 0, 0, 0);
  od = __builtin_amdgcn_mfma_f32_32x32x16_bf16(pa3, PK(l3, h3), od, 0, 0, 0);
#undef PK
}
template <int NCB> __device__ __forceinline__ void pv_all(f32x16* o, int vb, bf16x8 pa0, bf16x8 pa1, bf16x8 pa2, bf16x8 pa3) {
  pv_one<NCB, 0>(o[0], vb, pa0, pa1, pa2, pa3); pv_one<NCB, 1>(o[1], vb, pa0, pa1, pa2, pa3);
  if constexpr (NCB == 4) { pv_one<NCB, 2>(o[2], vb, pa0, pa1, pa2, pa3); pv_one<NCB, 3>(o[3], vb, pa0, pa1, pa2, pa3); }
}
__device__ __forceinline__ void alibi(f32x16& p0, f32x16& p1, const float* posl, int k0, int hi, float pq, float sl) {
  const float* pk = posl + k0 + 4 * hi;
#pragma unroll
  for (int g = 0; g < 4; ++g) { const f32x4 a = *(const f32x4*)(pk + 8 * g), b = *(const f32x4*)(pk + 32 + 8 * g);
#pragma unroll
    for (int i = 0; i < 4; ++i) { p0[4 * g + i] -= sl * fabsf(pq - a[i]); p1[4 * g + i] -= sl * fabsf(pq - b[i]); } }
}

__device__ __forceinline__ float wmin64(float v) { v = fminf(v, swz_xor<1>(v)); v = fminf(v, swz_xor<2>(v)); v = fminf(v, swz_xor<4>(v)); v = fminf(v, swz_xor<8>(v)); v = fminf(v, swz_xor<16>(v));
  auto rr = __builtin_amdgcn_permlane32_swap(__float_as_uint(v), __float_as_uint(v), false, false); return fminf(__uint_as_float(rr[0]), __uint_as_float(rr[1])); }
__device__ __forceinline__ float wmax64(float v) { v = fmaxf(v, swz_xor<1>(v)); v = fmaxf(v, swz_xor<2>(v)); v = fmaxf(v, swz_xor<4>(v)); v = fmaxf(v, swz_xor<8>(v)); v = fmaxf(v, swz_xor<16>(v));
  auto rr = __builtin_amdgcn_permlane32_swap(__float_as_uint(v), __float_as_uint(v), false, false); return fmaxf(__uint_as_float(rr[0]), __uint_as_float(rr[1])); }
constexpr float SKIP_TH = 40.f;
struct DiffArgs { const int* pos; float sl; float lam; float oscale; const float* ng; float kmax2; };

template <bool DIFF>
__device__ __forceinline__ void attn_unit(const bf16_t* __restrict__ Qb, const bf16_t* __restrict__ Kh, const bf16_t* __restrict__ Vh, bf16_t* __restrict__ Ob, int q0, const DiffArgs da, char* lds, int tid_in) {
  constexpr int LDQ = DIFF ? 1024 : 768, LDK = DIFF ? 1024 : 768, LDV = DIFF ? 1024 : 512, LDO = DIFF ? 1024 : 512;
  constexpr int NQK = DIFF ? 4 : 6, NDV = DIFF ? 4 : 2, KCH = DIFF ? 16 : 12, VCH = DIFF ? 16 : 8;
  int tid_ = tid_in; asm volatile("" : "+v"(tid_));
  const int tid = tid_, wid = tid >> 6, lane = tid & 63, r32 = lane & 31, hi = lane >> 5;
  const int mp = DIFF ? (wid >> 2) : 0, wrow = DIFF ? (wid & 3) * QBLK : wid * QBLK;
  char* V_lds = lds + OFF_V; char* K_lds = lds + OFF_K;
  float* ws = (float*)(lds + OFF_WS) + wid * 64; float* li_l = ws; float* al_l = ws + 32;
  float* posl = (float*)(lds + OFF_POS);
  float m_reg = -1e30f, l_reg = 0; f32x16 o[NDV]; bf16x8 qr[NQK];
#pragma unroll
  for (int d = 0; d < NDV; ++d) o[d] = f32x16{};
  const bf16_t* Qw = Qb + (long)(wrow + r32) * LDQ + mp * 64 + hi * 8;
#pragma unroll
  for (int d0 = 0; d0 < NQK; ++d0) qr[d0] = *reinterpret_cast<const bf16x8*>(Qw + d0 * 16);
  float pq = 0.f;
  if constexpr (DIFF) {
    for (int i = tid; i < SEQ; i += NW * 64) posl[i] = (float)da.pos[i];
    pq = (float)da.pos[q0 + wrow + r32];
  }
  const int sr = tid >> 4, ch = tid & 15, sc = ch * 8;
  const bool kact = ch < KCH, vact = ch < VCH;
  const int vst0 = v_st<NDV>(sr, sc), vst1 = v_st<NDV>(32 + sr, sc);
  const int vb0 = (int)(uintptr_t)V_lds + v_rd_base(lane);
  const int kcol0 = mp * 128;
  constexpr int SDEPTH = DIFF ? 1 : 2;
  struct { bf16x8 vs0, vs1, ks0, ks1; } sr_[SDEPTH];
#define SLOAD(i, k0) do { if (vact) { sr_[i].vs0 = *(const bf16x8*)(&Vh[(long)((k0) + sr) * LDV + sc]); sr_[i].vs1 = *(const bf16x8*)(&Vh[(long)((k0) + 32 + sr) * LDV + sc]); } \
    if (kact) { sr_[i].ks0 = *(const bf16x8*)(&Kh[(long)((k0) + sr) * LDK + sc]); sr_[i].ks1 = *(const bf16x8*)(&Kh[(long)((k0) + 32 + sr) * LDK + sc]); } } while (0)
#define SWRITE(b, i) do { if (vact) { *(bf16x8*)(V_lds + (b) * SHM_V + vst0) = sr_[i].vs0; *(bf16x8*)(V_lds + (b) * SHM_V + vst1) = sr_[i].vs1; } \
    if (kact) { const int kc = sc * 2; *(bf16x8*)(K_lds + (b) * SHM_K + KSWZ(sr, kc)) = sr_[i].ks0; *(bf16x8*)(K_lds + (b) * SHM_K + KSWZ(32 + sr, kc)) = sr_[i].ks1; } } while (0)
#define SWAIT() do { if constexpr (SDEPTH == 2) asm volatile("s_waitcnt vmcnt(4)" ::: "memory"); else asm volatile("s_waitcnt vmcnt(0)" ::: "memory"); } while (0)
#define RESC(a) do { if (__any((a) < 1.f)) { if (hi == 0) al_l[r32] = (a); asm volatile("s_waitcnt lgkmcnt(0)" ::: "memory"); \
    _Pragma("unroll") for (int d = 0; d < NDV; ++d) _Pragma("unroll") for (int r = 0; r < 16; ++r) o[d][r] *= al_l[crow(r, hi)]; } } while (0)
#define BIAS(P0, P1, k0) do { if constexpr (DIFF) alibi(P0, P1, posl, (k0), hi, pq, da.sl); } while (0)
  f32x16 pA0, pA1, pB0, pB1; float mnA, mnB, alA, alB; bf16x8 pa0, pa1, pa2, pa3; constexpr int NTALL = SEQ / KVBLK;
  constexpr int SE = 0, SO = SDEPTH - 1;
  float* ext = (float*)(lds + OFF_EXT);
  int td0 = 0, lo = 0, hiT = NTALL; float Bq = 0.f, qpmin = 0.f, qpmax = 0.f;
  if constexpr (DIFF) {
    __syncthreads();
#pragma unroll
    for (int tt = 0; tt < 4; ++tt) { const int t = 4 * wid + tt; const float v = posl[t * 64 + lane]; const float mn_ = wmin64(v), mx_ = wmax64(v); if (lane == 0) { ext[t] = mn_; ext[32 + t] = mx_; } }
    { const float a = posl[q0 + lane], b = posl[q0 + 64 + lane]; qpmin = wmin64(fminf(a, b)); qpmax = wmax64(fmaxf(a, b)); }
    { float qs = 0.f;
#pragma unroll
      for (int d0 = 0; d0 < NQK; ++d0)
#pragma unroll
        for (int e = 0; e < 8; ++e) { const float f = bf2f((bf16_t)qr[d0][e]); qs += f * f; }
      qs = sum_x32(qs); qs = wmax64(qs); if (lane == 0) ext[64 + wid] = qs; }
    __syncthreads();
    float q2 = ext[64];
#pragma unroll
    for (int w = 1; w < 8; ++w) q2 = fmaxf(q2, ext[64 + w]);
    Bq = sqrtf(q2 * da.kmax2); td0 = q0 >> 6;
  }
  for (int rg = 0; rg < (DIFF ? 3 : 1); ++rg) {
  int t0 = 0, NT = NTALL;
  if constexpr (DIFF) {
    if (rg == 0) { t0 = td0; NT = 2; }
    else {
      if (rg == 1) {
        const float mm = wmin64(m_reg); if (lane == 0) ext[72 + wid] = mm; __syncthreads();
        float mmin = ext[72];
#pragma unroll
        for (int w = 1; w < 8; ++w) mmin = fminf(mmin, ext[72 + w]);
        const float thr = Bq - mmin + SKIP_TH;
        lo = td0; hiT = td0 + 2;
        for (int t = 0; t < NTALL; ++t) { const float dmin = fmaxf(0.f, fmaxf(ext[t] - qpmax, qpmin - ext[32 + t]));
          if (da.sl * dmin <= thr) { lo = min(lo, t); hiT = max(hiT, t + 1); } }
        lo = __builtin_amdgcn_readfirstlane(lo & ~1); hiT = __builtin_amdgcn_readfirstlane((hiT + 1) & ~1);
      }
      t0 = (rg == 1) ? lo : td0 + 2; NT = (rg == 1) ? td0 - lo : hiT - (td0 + 2);
    }
    if (NT <= 0) continue;
    __syncthreads();
  }
  const int kb = t0 * KVBLK;
  SLOAD(SE, kb); asm volatile("s_waitcnt vmcnt(0)" ::: "memory"); SWRITE(0, SE); __syncthreads();
  qkt<NQK>(pA0, pA1, K_lds, qr, r32, hi, kcol0); BIAS(pA0, pA1, kb); partialSM(pA0, pA1, m_reg, mnA, alA);
  SLOAD(SO, kb + KVBLK); if constexpr (SDEPTH == 2) SLOAD(SE, kb + 2 * KVBLK);
  SWAIT(); SWRITE(1, SO); __syncthreads();
  for (int j = 1; j + 1 < NT; j += 2) {
    SBAR(); qkt<NQK>(pB0, pB1, K_lds + SHM_K, qr, r32, hi, kcol0); BIAS(pB0, pB1, kb + j * KVBLK);
    finishSM(pA0, pA1, alA, l_reg, pa0, pa1, pa2, pa3); SBAR();
    SLOAD(SO, kb + (j + SDEPTH) * KVBLK); SBAR();
    pv_all<NDV>(o, vb0, pa0, pa1, pa2, pa3); partialSM(pB0, pB1, m_reg, mnB, alB);
    __syncthreads(); SWAIT(); SWRITE(0, SE);
    RESC(alB); __syncthreads();
    SBAR(); qkt<NQK>(pA0, pA1, K_lds, qr, r32, hi, kcol0); BIAS(pA0, pA1, kb + (j + 1) * KVBLK);
    finishSM(pB0, pB1, alB, l_reg, pa0, pa1, pa2, pa3); SBAR();
    if (SDEPTH == 1 || j + 3 < NT) SLOAD(SE, kb + (j + 1 + SDEPTH) * KVBLK); SBAR();
    pv_all<NDV>(o, vb0 + (int)SHM_V, pa0, pa1, pa2, pa3); partialSM(pA0, pA1, m_reg, mnA, alA);
    __syncthreads(); SWAIT(); SWRITE(1, SO);
    RESC(alA); __syncthreads();
  }
  SBAR(); qkt<NQK>(pB0, pB1, K_lds + SHM_K, qr, r32, hi, kcol0); BIAS(pB0, pB1, kb + (NT - 1) * KVBLK);
  finishSM(pA0, pA1, alA, l_reg, pa0, pa1, pa2, pa3); SBAR();
  pv_all<NDV>(o, vb0, pa0, pa1, pa2, pa3); partialSM(pB0, pB1, m_reg, mnB, alB);
  __syncthreads(); RESC(alB);
  finishSM(pB0, pB1, alB, l_reg, pa0, pa1, pa2, pa3); SBAR();
  pv_all<NDV>(o, vb0 + (int)SHM_V, pa0, pa1, pa2, pa3);
  }
  if (hi == 0) li_l[r32] = l_reg; asm volatile("s_waitcnt lgkmcnt(0)" ::: "memory");
  float rli[16];
#pragma unroll
  for (int r = 0; r < 16; ++r) rli[r] = __builtin_amdgcn_rcpf(li_l[crow(r, hi)]);
  if constexpr (!DIFF) {
    bf16_t* Ow = Ob + (long)wrow * LDO;
#pragma unroll
    for (int r = 0; r < 16; ++r) { const int orow = crow(r, hi);
#pragma unroll
      for (int d0 = 0; d0 < NDV; ++d0) { const float v = o[d0][r] * rli[r]; Ow[(long)orow * LDO + d0 * 32 + r32] = (bf16_t)(cvtpk(v, v) & 0xffffu); } }
    __syncthreads();
  } else {
    __syncthreads();
    float* cmb = (float*)lds + (wid & 3) * 4096;
    if (mp == 1) {
#pragma unroll
      for (int r = 0; r < 16; ++r) { const int orow = crow(r, hi);
#pragma unroll
        for (int d0 = 0; d0 < 4; ++d0) cmb[orow * 128 + d0 * 32 + r32] = o[d0][r] * rli[r]; }
    }
    __syncthreads();
    if (mp == 0) {
      float ss[16];
#pragma unroll
      for (int r = 0; r < 16; ++r) { const int orow = crow(r, hi); float s = 0.f;
#pragma unroll
        for (int d0 = 0; d0 < 4; ++d0) { const float v = o[d0][r] * rli[r] - da.lam * cmb[orow * 128 + d0 * 32 + r32]; o[d0][r] = v; s += v * v; }
        ss[r] = s; }
#pragma unroll
      for (int r = 0; r < 16; ++r) { float s = ss[r];
        s += swz_xor<1>(s); s += swz_xor<2>(s); s += swz_xor<4>(s); s += swz_xor<8>(s); s += swz_xor<16>(s);
        ss[r] = da.oscale * __builtin_amdgcn_rsqf(s * (1.0f / 128.0f) + RMS_EPS); }
      bf16_t* Ow = Ob + (long)wrow * LDO;
      float gn[4];
#pragma unroll
      for (int d0 = 0; d0 < 4; ++d0) gn[d0] = da.ng[d0 * 32 + r32];
#pragma unroll
      for (int r = 0; r < 16; ++r) { const int orow = crow(r, hi);
#pragma unroll
        for (int d0 = 0; d0 < 4; ++d0) { const float v = o[d0][r] * ss[r] * gn[d0]; Ow[(long)orow * LDO + d0 * 32 + r32] = (bf16_t)(cvtpk(v, v) & 0xffffu); } }
    }
    __syncthreads();
  }
#undef SLOAD
#undef SWRITE
#undef SWAIT
#undef RESC
#undef BIAS
}
#undef KSWZ
#undef SBAR
}

constexpr size_t MiB = 1u << 20;
constexpr size_t WS_CTL = 0, CTL_ZERO_BYTES = 1 * MiB;
constexpr size_t WS_MOD = 1 * MiB;
constexpr size_t WS_RSQ = 3 * MiB;
constexpr size_t WS_COS = 6 * MiB;
constexpr size_t WS_SIN = 8 * MiB;
constexpr size_t WS_SEL = 10 * MiB;
constexpr size_t WS_GATE = 10 * MiB + 256 * 1024;
constexpr size_t WS_RMAP = 11 * MiB;
constexpr size_t WS_WMIX = 12 * MiB;
constexpr size_t W_IN = WS_WMIX, W_QUP = W_IN + (size_t)NZ * 1024 * 2, W_KVUP = W_QUP + 768 * 384 * 2, W_BRM = W_KVUP + 1024 * 256 * 2, W_BRD = W_BRM + 1024 * 512 * 2, W_OUT = W_BRD + 1024 * 1024 * 2;
constexpr size_t WS_WFF = 30 * MiB;
constexpr size_t W13_ESTRIDE = (size_t)5632 * 1024 * 2, W2_ESTRIDE = (size_t)1024 * 2816 * 2, W2_BASE = WS_WFF + 8 * W13_ESTRIDE;
constexpr size_t WS_ACT = 162 * MiB;
constexpr size_t WS_H = WS_ACT;
constexpr size_t WS_LAT = WS_H + 64 * MiB;
constexpr size_t WS_ZB = WS_LAT + 48 * MiB;
constexpr size_t WS_QM = WS_ZB + 320 * MiB;
constexpr size_t WS_KM = WS_QM + 48 * MiB;
constexpr size_t WS_VM = WS_KM + 48 * MiB;
constexpr size_t WS_OM = WS_VM + 32 * MiB;
constexpr size_t WS_END = WS_OM + 32 * MiB;
constexpr size_t WS_PRE = WS_QM;
constexpr size_t WS_PART = WS_QM;
constexpr size_t WS_T1 = WS_ZB + 64 * MiB;
constexpr size_t WS_MB = WS_ZB + 128 * MiB;
constexpr size_t WS_U = WS_LAT;
constexpr size_t WS_XB = WS_LAT;
constexpr size_t WS_Y = WS_LAT;
constexpr size_t WS_UM = WS_LAT + 132 * MiB;
static_assert(WS_UM + (size_t)67584 * 2816 * 2 <= WS_END + 64 * MiB, "ws map");
constexpr size_t WS_NEED = WS_END + 8 * MiB;
constexpr int CW_BAR = 4096;
constexpr int CW_CNT = 8192;
constexpr int CW_CUR = 8192 + 256;
constexpr int CW_KMAX = 16384;

constexpr int RING_BYTES = 131072, LDSCTL_OFF = RING_BYTES, MISC_OFF = LDSCTL_OFF + 320, LDS_BYTES = 147456;
constexpr int NWAVES = 8;

#define XB_TMO      128
#define XB_XCNT(j)  (256  + 64 * (j))
#define XB_XSUB(j)  (1280 + 64 * (j))
#define XB_XGEN(j)  (2304 + 64 * (j))
#define XB_TOP      3328
#define XB_TOPGEN   3392
#define XCD_BAR_WORDS 3456
#define XB_SPIN_CAP (1u << 18)
__device__ __forceinline__ unsigned xb_ld(unsigned* p)              { return __hip_atomic_load(p, __ATOMIC_RELAXED, __HIP_MEMORY_SCOPE_AGENT); }
__device__ __forceinline__ unsigned xb_add(unsigned* p, unsigned v) { return __hip_atomic_fetch_add(p, v, __ATOMIC_RELAXED, __HIP_MEMORY_SCOPE_AGENT); }
__device__ __forceinline__ unsigned xb_xcc_id() { return (unsigned)__builtin_amdgcn_s_getreg((3 << 11) | 20) & 0xFu; }
#define XB_SPIN(cond, bar) do { unsigned _sp = 0; while (cond) { __builtin_amdgcn_s_sleep(1); \
    if ((++_sp & 255u) == 0u) { if (xb_ld(&(bar)[XB_TMO])) break; if (_sp > XB_SPIN_CAP) { atomicAdd(&(bar)[XB_TMO], 1u); break; } } } } while (0)
struct XcdBarrier { unsigned* bar; unsigned x; volatile LAS unsigned* st; };
__device__ __forceinline__ XcdBarrier xcd_barrier_post(unsigned* bar, volatile LAS unsigned* st, bool leader) {
    XcdBarrier b; b.bar = bar; b.x = xb_xcc_id(); b.st = st;
    if (leader) (void)xb_add(&bar[XB_XCNT(b.x)], 1u);
    return b;
}
__device__ __forceinline__ void xcd_barrier_complete(unsigned* bar, unsigned x, unsigned& nloc, unsigned& nx) {
    const unsigned G = gridDim.x * gridDim.y * gridDim.z;
    unsigned sum, cnt, mine, sp = 0u;
    for (;;) {
        sum = 0u; cnt = 0u; mine = 0u;
#pragma unroll
        for (unsigned j = 0; j < 16; ++j) { const unsigned c = xb_ld(&bar[XB_XCNT(j)]); sum += c; cnt += (c > 0u) ? 1u : 0u; mine = (j == x) ? c : mine; }
        if (sum == G) break;
        __builtin_amdgcn_s_sleep(1);
        if ((++sp & 255u) == 0u) { if (xb_ld(&bar[XB_TMO])) break; if (sp > XB_SPIN_CAP) { atomicAdd(&bar[XB_TMO], 1u); break; } }
    }
    nloc = mine > 0u ? mine : 1u; nx = cnt > 0u ? cnt : 1u;
}
__device__ __forceinline__ void xcd_barrier(const XcdBarrier& b, bool leader) {
    asm volatile("s_waitcnt vmcnt(0)" ::: "memory");
    __syncthreads();
    if (leader) {
        unsigned* bar = b.bar;
        __builtin_amdgcn_s_waitcnt(0);
        unsigned nloc = b.st[0], nx = b.st[1];
        if (nloc == 0u) { xcd_barrier_complete(bar, b.x, nloc, nx); b.st[0] = nloc; b.st[1] = nx; }
        const unsigned old = xb_add(&bar[XB_XSUB(b.x)], 1u);
        const unsigned gen = old / nloc;
        if (old + 1u == (gen + 1u) * nloc) {
            __builtin_amdgcn_fence(__ATOMIC_RELEASE, "agent");
            asm volatile("s_waitcnt vmcnt(0)" ::: "memory");
            const unsigned og = xb_add(&bar[XB_TOP], 1u);
            const unsigned tg = og / nx;
            if (og + 1u == (tg + 1u) * nx) xb_add(&bar[XB_TOPGEN], 1u);
            else XB_SPIN(xb_ld(&bar[XB_TOPGEN]) == tg, bar);
            __builtin_amdgcn_fence(__ATOMIC_ACQUIRE, "agent");
            xb_add(&bar[XB_XGEN(b.x)], 1u);
            asm volatile("s_waitcnt vmcnt(0)" ::: "memory");
        } else {
            XB_SPIN(xb_ld(&bar[XB_XGEN(b.x)]) == gen, bar);
            __builtin_amdgcn_fence(__ATOMIC_ACQUIRE, "agent");
            asm volatile("s_waitcnt vmcnt(0)" ::: "memory");
        }
    }
    __syncthreads();
}

__device__ __forceinline__ float wave_sum(float v) {
    v += swz_xor<1>(v); v += swz_xor<2>(v); v += swz_xor<4>(v); v += swz_xor<8>(v); v += swz_xor<16>(v);
    return sum_x32(v);
}
__device__ __forceinline__ unsigned f2bf(float f) { unsigned u = __builtin_bit_cast(unsigned, f); return (u + 0x7fffu + ((u >> 16) & 1u)) >> 16; }
__device__ __forceinline__ unsigned pk2(float lo, float hi) { return f2bf(lo) | (f2bf(hi) << 16); }

template <class MapF>
__device__ __forceinline__ void transpose_item(const float* W, int N, bf16_t* WT, int ldk, const float* gain, LAS float* scr, int kb, int nb, int lane, MapF map) {
    const int k0 = 64 * kb, n0 = 32 * nb;
    float tv[32];
#pragma unroll
    for (int i = 0; i < 32; ++i) { const int kk = 2 * i + (lane >> 5); tv[i] = W[(size_t)(k0 + kk) * N + n0 + (lane & 31)]; }
#pragma unroll
    for (int i = 0; i < 32; ++i) { const int kk = 2 * i + (lane >> 5); float v = tv[i]; if (gain) v *= gain[k0 + kk]; scr[kk * 33 + (lane & 31)] = v; }
    asm volatile("s_waitcnt lgkmcnt(0)" ::: "memory");
    const int c = lane & 7;
#pragma unroll
    for (int j = 0; j < 4; ++j) { const int n = (lane >> 3) + 8 * j; const LAS float* s = scr + (8 * c) * 33 + n;
        u32x4 o; o.x = pk2(s[0 * 33], s[1 * 33]); o.y = pk2(s[2 * 33], s[3 * 33]); o.z = pk2(s[4 * 33], s[5 * 33]); o.w = pk2(s[6 * 33], s[7 * 33]);
        const int dr = map(n0 + n);
        *(GAS u32x4*)(WT + (size_t)dr * ldk + k0 + 8 * c) = o; }
    asm volatile("s_waitcnt lgkmcnt(0)" ::: "memory");
}
__host__ __device__ __forceinline__ int rope_virt(int rho) { const int n = rho >> 4, fq = (rho & 15) >> 2, i = rho & 3; return 8 * fq + 4 * n + i; }
struct MapIn  { __device__ __forceinline__ int operator()(int n) const { if (n < 384) return n; if (n < 640) return n + 128; if (n < 672) return 384 + rope_virt(n - 640); return n + 96; } };
struct MapQup { __device__ __forceinline__ int operator()(int n) const { const int h = n / 96, w = n - h * 96; return w < 64 ? n : h * 96 + 64 + rope_virt(w - 64); } };
struct MapId  { __device__ __forceinline__ int operator()(int n) const { return n; } };
struct MapW13 { int half; __device__ __forceinline__ int operator()(int n) const { return 256 * (n >> 7) + 128 * half + (n & 127); } };

struct Args {
    const float* x; const float* c; const int* pos; const float* w_ada; const float* b_ada; const float* w_in; const float* q_norm_g; const float* w_q_up; const float* kv_norm_g; const float* w_kv_up;
    const float* lq1; const float* lk1; const float* lq2; const float* lk2; const float* diff_norm_g; const float* w_br_mla; const float* w_br_diff; const float* w_out;
    const float* ln1_g; const float* ln1_b; const float* ln2_g; const float* ln2_b; const float* ffn_w1; const float* ffn_w3; const float* ffn_w2; const float* router_w; const float* router_b;
    const float* moe_w1; const float* moe_w3; const float* moe_w2;
    float* out; unsigned char* ws; int ph_lo, ph_hi; float lam_init[4];
};

typedef const __attribute__((address_space(4))) Args* KArgP;
__device__ __forceinline__ KArgP kargs() { KArgP p = (KArgP)__builtin_amdgcn_kernarg_segment_ptr(); asm volatile("" : "+s"(p)); return p; }
struct Ctx { LAS unsigned char* lds; int tid, lane, wave, vcu, G; unsigned char* ws; };

__device__ __forceinline__ void cvt_mixer_weights(const Ctx& C, int l) {
    KArgP a = kargs();
    LAS float* scr = (LAS float*)(C.lds + C.wave * 8448);
    const int gw = C.vcu * NWAVES + C.wave, NGW = C.G * NWAVES;
    constexpr int I_IN = 16 * 181, I_QUP = 6 * 24, I_KVUP = 4 * 32, I_BRM = 8 * 32, I_BRD = 16 * 32, I_OUT = 16 * 32;
    constexpr int NIT = I_IN + I_QUP + I_KVUP + I_BRM + I_BRD + I_OUT;
    unsigned char* ws = C.ws;
    for (int it = gw; it < NIT; it += NGW) {
        int r = it;
        if (r < I_IN) { transpose_item(a->w_in + (size_t)l * 1024 * 5792, 5792, (bf16_t*)(ws + W_IN), 1024, nullptr, scr, r / 181, r % 181, C.lane, MapIn{}); continue; } r -= I_IN;
        if (r < I_QUP) { transpose_item(a->w_q_up + (size_t)l * 384 * 768, 768, (bf16_t*)(ws + W_QUP), 384, a->q_norm_g + l * 384, scr, r / 24, r % 24, C.lane, MapQup{}); continue; } r -= I_QUP;
        if (r < I_KVUP) { transpose_item(a->w_kv_up + (size_t)l * 256 * 1024, 1024, (bf16_t*)(ws + W_KVUP), 256, a->kv_norm_g + l * 256, scr, r / 32, r % 32, C.lane, MapId{}); continue; } r -= I_KVUP;
        if (r < I_BRM) { transpose_item(a->w_br_mla + (size_t)l * 512 * 1024, 1024, (bf16_t*)(ws + W_BRM), 512, nullptr, scr, r / 32, r % 32, C.lane, MapId{}); continue; } r -= I_BRM;
        if (r < I_BRD) { transpose_item(a->w_br_diff + (size_t)l * 1024 * 1024, 1024, (bf16_t*)(ws + W_BRD), 1024, nullptr, scr, r / 32, r % 32, C.lane, MapId{}); continue; } r -= I_BRD;
        transpose_item(a->w_out + (size_t)l * 1024 * 1024, 1024, (bf16_t*)(ws + W_OUT), 1024, nullptr, scr, r / 32, r % 32, C.lane, MapId{});
    }
}
__device__ __forceinline__ void cvt_ffn_weights(const Ctx& C, int l) {
    KArgP a = kargs();
    LAS float* scr = (LAS float*)(C.lds + C.wave * 8448);
    const int gw = C.vcu * NWAVES + C.wave, NGW = C.G * NWAVES;
    constexpr int I_W1 = 16 * 88, I_W2 = 44 * 32, I_E = 2 * I_W1 + I_W2;
    unsigned char* ws = C.ws;
    const bool moe = (l & 1) != 0; const int li = l >> 1;
    const int nE = moe ? NEXP : 1;
    const float* w1 = moe ? a->moe_w1 + (size_t)li * NEXP * 1024 * FF : a->ffn_w1 + (size_t)li * 1024 * FF;
    const float* w3 = moe ? a->moe_w3 + (size_t)li * NEXP * 1024 * FF : a->ffn_w3 + (size_t)li * 1024 * FF;
    const float* w2 = moe ? a->moe_w2 + (size_t)li * NEXP * 1024 * FF : a->ffn_w2 + (size_t)li * 1024 * FF;
    for (int it = gw; it < nE * I_E; it += NGW) {
        const int e = it / I_E; int r = it - e * I_E;
        bf16_t* d13 = (bf16_t*)(ws + WS_WFF + (size_t)e * W13_ESTRIDE); bf16_t* d2 = (bf16_t*)(ws + W2_BASE + (size_t)e * W2_ESTRIDE);
        const size_t eo = (size_t)e * 1024 * FF;
        if (r < I_W1) { transpose_item(w1 + eo, FF, d13, 1024, nullptr, scr, r / 88, r % 88, C.lane, MapW13{0}); continue; } r -= I_W1;
        if (r < I_W1) { transpose_item(w3 + eo, FF, d13, 1024, nullptr, scr, r / 88, r % 88, C.lane, MapW13{1}); continue; } r -= I_W1;
        transpose_item(w2 + eo, 1024, d2, FF, nullptr, scr, r / 32, r % 32, C.lane, MapId{});
    }
}

struct FIn {
    bf16_t* LAT; bf16_t* ZB; bf16_t* KM; float* RSQ; const float* COS; const float* SIN;
    __device__ __forceinline__ float rowscale(int) const { return 1.f; }
    __device__ __forceinline__ void operator()(int row, float rs, int cb, int fq, f32x4 v0, f32x4 v1) const {
        if (cb < 384 || (cb >= 512 && cb < 768)) {
            *(u32x4*)(LAT + (size_t)row * 768 + cb + 8 * fq) = pack8(v0, v1);
            float ss = (v0[0] * v0[0] + v0[1] * v0[1]) + (v0[2] * v0[2] + v0[3] * v0[3]) + (v1[0] * v1[0] + v1[1] * v1[1]) + (v1[2] * v1[2] + v1[3] * v1[3]);
            ss += swz_xor<16>(ss); ss = sum_x32(ss);
            const int slot = cb < 384 ? (cb >> 5) : 12 + ((cb - 512) >> 5);
            if (fq == 0) RSQ[(size_t)row * 24 + slot] = ss;
        } else if (cb < 416) {
            const f32x4 cs = *(const f32x4*)(COS + (size_t)row * 16 + 4 * fq), sn = *(const f32x4*)(SIN + (size_t)row * 16 + 4 * fq);
            const f32x4 o1 = v0 * cs - v1 * sn, o2 = v0 * sn + v1 * cs;
            const u32x4 w = pack8(o1, o2);
#pragma unroll
            for (int h = 0; h < 8; ++h) *(u32x4*)(KM + (size_t)row * 768 + h * 96 + 64 + 8 * fq) = w;
        } else if (cb >= 768) {
            const int g = (cb - 768) >> 10, c = (cb - 768) & 1023;
            if (g == 0) { v0 = v0 * CQ_DIFF; v1 = v1 * CQ_DIFF; }
            if (g >= 3) {
#pragma unroll
                for (int i = 0; i < 4; ++i) { v0[i] = sigmoidf_(v0[i]); v1[i] = sigmoidf_(v1[i]); } }
            *(u32x4*)(ZB + (size_t)g * T * 1024 + (size_t)row * 1024 + c + 8 * fq) = pack8(v0, v1);
        }
    }
};
struct FQup {
    bf16_t* QM; const float* RSQ; const float* COS; const float* SIN;
    __device__ __forceinline__ float rowscale(int row) const {
        const f32x4 a = *(const f32x4*)(RSQ + (size_t)row * 24), b = *(const f32x4*)(RSQ + (size_t)row * 24 + 4), c = *(const f32x4*)(RSQ + (size_t)row * 24 + 8);
        const float ss = ((a[0] + a[1]) + (a[2] + a[3])) + ((b[0] + b[1]) + (b[2] + b[3])) + ((c[0] + c[1]) + (c[2] + c[3]));
        return CQ_MLA * __builtin_amdgcn_rsqf(ss * (1.0f / 384.0f) + RMS_EPS); }
    __device__ __forceinline__ void operator()(int row, float r, int cb, int fq, f32x4 v0, f32x4 v1) const {
        v0 = v0 * r; v1 = v1 * r;
        if ((cb % 96) == 64) {
            const f32x4 cs = *(const f32x4*)(COS + (size_t)row * 16 + 4 * fq), sn = *(const f32x4*)(SIN + (size_t)row * 16 + 4 * fq);
            const f32x4 o1 = v0 * cs - v1 * sn, o2 = v0 * sn + v1 * cs; v0 = o1; v1 = o2;
        }
        *(u32x4*)(QM + (size_t)row * 768 + cb + 8 * fq) = pack8(v0, v1);
    }
};
struct FKVup {
    bf16_t* KM; bf16_t* VM; const float* RSQ;
    __device__ __forceinline__ float rowscale(int row) const {
        const f32x4 a = *(const f32x4*)(RSQ + (size_t)row * 24 + 12), b = *(const f32x4*)(RSQ + (size_t)row * 24 + 16);
        const float ss = ((a[0] + a[1]) + (a[2] + a[3])) + ((b[0] + b[1]) + (b[2] + b[3]));
        return __builtin_amdgcn_rsqf(ss * (1.0f / 256.0f) + RMS_EPS); }
    __device__ __forceinline__ void operator()(int row, float r, int cb, int fq, f32x4 v0, f32x4 v1) const {
        v0 = v0 * r; v1 = v1 * r;
        const int h = cb >> 7, w = cb & 127;
        if (w < 64) *(u32x4*)(KM + (size_t)row * 768 + h * 96 + w + 8 * fq) = pack8(v0, v1);
        else *(u32x4*)(VM + (size_t)row * 512 + h * 64 + (w - 64) + 8 * fq) = pack8(v0, v1);
    }
};
struct FBr1 {
    bf16_t* T1; const bf16_t* SA;
    __device__ __forceinline__ float rowscale(int) const { return 1.f; }
    __device__ __forceinline__ void operator()(int row, float rs, int cb, int fq, f32x4 v0, f32x4 v1) const {
        const size_t o = (size_t)row * 1024 + cb + 8 * fq; f32x4 s0, s1; unpack8(*(const u32x4*)(SA + o), s0, s1);
        *(u32x4*)(T1 + o) = pack8(v0 * s0, v1 * s1);
    }
};
struct FBr2 {
    bf16_t* MB; const bf16_t* T1; const bf16_t* SB;
    __device__ __forceinline__ float rowscale(int) const { return 1.f; }
    __device__ __forceinline__ void operator()(int row, float rs, int cb, int fq, f32x4 v0, f32x4 v1) const {
        const size_t o = (size_t)row * 1024 + cb + 8 * fq; f32x4 s0, s1, t0, t1; unpack8(*(const u32x4*)(SB + o), s0, s1); unpack8(*(const u32x4*)(T1 + o), t0, t1);
        *(u32x4*)(MB + o) = pack8(t0 + v0 * s0, t1 + v1 * s1);
    }
};
struct FRes {
    float* PRE; const float* X; const float* gate;
    __device__ __forceinline__ float rowscale(int) const { return 1.f; }
    __device__ __forceinline__ void operator()(int row, float rs, int cb, int fq, f32x4 v0, f32x4 v1) const {
        const int b = row >> 11; const float* gp = gate + (size_t)b * 6144 + cb + 4 * fq;
        const size_t o = (size_t)row * 1024 + cb + 4 * fq;
        const f32x4 g0 = *(const f32x4*)gp, g1 = *(const f32x4*)(gp + 16), x0 = *(const f32x4*)(X + o), x1 = *(const f32x4*)(X + o + 16);
        *(f32x4*)(PRE + o) = x0 * ALPHA + g0 * v0; *(f32x4*)(PRE + o + 16) = x1 * ALPHA + g1 * v1;
    }
};
struct FMoeOut {
    bf16_t* Y; const int* RMAP;
    __device__ __forceinline__ float rowscale(int) const { return 1.f; }
    __device__ __forceinline__ void operator()(int row, float rs, int cb, int fq, f32x4 v0, f32x4 v1) const {
        const int s = RMAP[row];
        if (s >= 0) *(u32x4*)(Y + (size_t)s * 1024 + cb + 8 * fq) = pack8(v0, v1);
    }
};

template <int MODE, bool ROUTE>
__device__ __forceinline__ void ln_phase(const Ctx& C, const float* PRE, float* XF, bf16_t* H, const float* lng, const float* lnb, const float* sc, const float* sh,
                                         const bf16_t* Y, const float* GATE, const float* g2, const float* rw, const float* rb, int* SEL, float* GOUT, unsigned* CNT) {
    int lane_ = C.lane; asm volatile("" : "+v"(lane_)); const int lane = lane_; const int wg = blockIdx.x; const int b = (wg * 128) >> 11;
    f32x4 vg[4], vb[4], vsc[4], vsh[4], vg2[4];
#pragma unroll
    for (int j = 0; j < 4; ++j) { const int c = 4 * lane + 256 * j; vg[j] = *(const f32x4*)(lng + c); vb[j] = *(const f32x4*)(lnb + c);
        if (sc) { vsc[j] = *(const f32x4*)(sc + (size_t)b * 6144 + c) + 1.0f; vsh[j] = *(const f32x4*)(sh + (size_t)b * 6144 + c); }
        if (MODE == 1) vg2[j] = *(const f32x4*)(g2 + (size_t)b * 6144 + c); }
    LAS float* rwl = (LAS float*)C.lds;
    LAS unsigned* hist = (LAS unsigned*)(C.lds + 32768);
    if (ROUTE) { for (int i = C.tid; i < 8192; i += NWAVES * 64) rwl[i] = rw[i]; if (C.tid < 8) hist[C.tid] = 0u; __syncthreads(); }
    for (int rr = 0; rr < 8; ++rr) {
        f32x4 vv[2][4]; u32x2 rya[2][4], ryb[2][4]; float rga[2], rgb[2];
#pragma unroll
        for (int h2 = 0; h2 < 2; ++h2) { const int row = wg * 128 + C.wave * 16 + rr + 8 * h2;
            if (MODE == 0) {
#pragma unroll
                for (int j = 0; j < 4; ++j) vv[h2][j] = *(const f32x4*)(PRE + (size_t)row * 1024 + 4 * lane + 256 * j);
            } else {
                rga[h2] = GATE[2 * row]; rgb[h2] = GATE[2 * row + 1];
#pragma unroll
                for (int j = 0; j < 4; ++j) { const int c = 4 * lane + 256 * j; vv[h2][j] = *(const f32x4*)(XF + (size_t)row * 1024 + c);
                    rya[h2][j] = *(const u32x2*)(Y + (size_t)(2 * row) * 1024 + c); ryb[h2][j] = *(const u32x2*)(Y + (size_t)(2 * row + 1) * 1024 + c); }
            } }
#pragma unroll
      for (int h2 = 0; h2 < 2; ++h2) { const int row = wg * 128 + C.wave * 16 + rr + 8 * h2;
        f32x4 v[4];
        if (MODE == 0) {
#pragma unroll
            for (int j = 0; j < 4; ++j) v[j] = vv[h2][j];
        } else {
            const float ga = rga[h2], gb = rgb[h2];
#pragma unroll
            for (int j = 0; j < 4; ++j) { const f32x4 xv = vv[h2][j]; const u32x2 ya = rya[h2][j], yb = ryb[h2][j];
                f32x4 fa, fb; fa[0] = __uint_as_float(ya.x << 16); fa[1] = __uint_as_float(ya.x & 0xffff0000u); fa[2] = __uint_as_float(ya.y << 16); fa[3] = __uint_as_float(ya.y & 0xffff0000u);
                fb[0] = __uint_as_float(yb.x << 16); fb[1] = __uint_as_float(yb.x & 0xffff0000u); fb[2] = __uint_as_float(yb.y << 16); fb[3] = __uint_as_float(yb.y & 0xffff0000u);
                v[j] = xv * ALPHA + vg2[j] * (fa * ga + fb * gb); }
        }
        float s = 0.f;
#pragma unroll
        for (int j = 0; j < 4; ++j) s += (v[j][0] + v[j][1]) + (v[j][2] + v[j][3]);
        const float mean = wave_sum(s) * (1.f / 1024.f); float s2 = 0.f;
#pragma unroll
        for (int j = 0; j < 4; ++j) { v[j] = v[j] - mean; s2 += (v[j][0] * v[j][0] + v[j][1] * v[j][1]) + (v[j][2] * v[j][2] + v[j][3] * v[j][3]); }
        const float rstd = 1.f / sqrtf(wave_sum(s2) * (1.f / 1024.f) + LN_EPS);
        float lg[8];
        if (ROUTE) {
#pragma unroll
            for (int e = 0; e < 8; ++e) lg[e] = 0.f; }
#pragma unroll
        for (int j = 0; j < 4; ++j) { const int c = 4 * lane + 256 * j; const f32x4 y = v[j] * rstd * vg[j] + vb[j];
            *(f32x4*)(XF + (size_t)row * 1024 + c) = y;
            if (sc) { const f32x4 hh = y * vsc[j] + vsh[j];
                u32x2 w; w.x = cvt_pk_bf16(hh[0], hh[1]); w.y = cvt_pk_bf16(hh[2], hh[3]); *(u32x2*)(H + (size_t)row * 1024 + c) = w;
                if (ROUTE) {
#pragma unroll
                    for (int i = 0; i < 4; ++i) { const f32x4 w0 = *(const LAS f32x4*)(rwl + (c + i) * 8), w1 = *(const LAS f32x4*)(rwl + (c + i) * 8 + 4);
#pragma unroll
                        for (int e = 0; e < 4; ++e) { lg[e] += hh[i] * w0[e]; lg[4 + e] += hh[i] * w1[e]; } } } } }
        if (ROUTE) {
#pragma unroll
            for (int e = 0; e < 8; ++e) lg[e] = wave_sum(lg[e]) + rb[e];
            int i0 = 0; float m0 = lg[0];
#pragma unroll
            for (int e = 1; e < 8; ++e) if (lg[e] > m0) { m0 = lg[e]; i0 = e; }
            int i1 = -1; float m1 = -INFINITY;
#pragma unroll
            for (int e = 0; e < 8; ++e) if (e != i0 && lg[e] > m1) { m1 = lg[e]; i1 = e; }
            const float g0 = 1.0f / (1.0f + expf(m1 - m0));
            if (lane == 0) { SEL[row] = i0 | (i1 << 8); GOUT[2 * row] = g0; GOUT[2 * row + 1] = 1.0f - g0; atomicAdd((unsigned*)&hist[i0], 1u); atomicAdd((unsigned*)&hist[i1], 1u); }
        }
      }
    }
    if (ROUTE) { __syncthreads(); if (C.tid < 8) atomicAdd(CNT + C.tid, (unsigned)hist[C.tid]); }
}

constexpr int NPH_L = 10, NPHASE = 2 + DEPTH * NPH_L;
#ifndef LB2
#define LB2 2
#endif
#ifdef NVGPR
__attribute__((amdgpu_num_vgpr(NVGPR)))
#endif
__global__ void __launch_bounds__(NWAVES * 64, LB2) mk_fwd(Args args) {
    extern __shared__ __attribute__((aligned(16))) unsigned char lds[];
    const int wave0 = __builtin_amdgcn_readfirstlane((int)threadIdx.x >> 6);
    Ctx C; C.lds = (LAS unsigned char*)lds; C.wave = wave0; C.lane = (int)__builtin_amdgcn_mbcnt_hi(~0u, __builtin_amdgcn_mbcnt_lo(~0u, 0u)); C.tid = wave0 * 64 + C.lane;
    C.G = gridDim.x; { const int bx = blockIdx.x; C.vcu = (C.G % 8 == 0) ? (bx % 8) * (C.G / 8) + bx / 8 : bx; }
    KArgP ka0 = kargs();
    unsigned* const ctl0 = (unsigned*)(ka0->ws + WS_CTL);
    volatile LAS unsigned* MISC = (volatile LAS unsigned*)(C.lds + MISC_OFF);
    for (int u = C.tid; u < (LDS_BYTES - LDSCTL_OFF) / 4; u += NWAVES * 64) ((LAS unsigned*)(C.lds + LDSCTL_OFF))[u] = 0u;
    __syncthreads();
    XcdBarrier bar; bar.bar = ctl0 + CW_BAR; bar.x = 0; bar.st = nullptr;
    if (!MK_PER_PHASE) bar = xcd_barrier_post(ctl0 + CW_BAR, MISC + 8, C.tid == 0);
    const int lo = ka0->ph_lo, hi = ka0->ph_hi;
#define GEMM_RUN(call) do { call; if (PROBE == 1) { asm volatile("s_waitcnt vmcnt(0)" ::: "memory"); __syncthreads(); call; } } while (0)
#define FRESH() do { int l_; asm volatile("v_mbcnt_lo_u32_b32 %0, -1, 0\n\tv_mbcnt_hi_u32_b32 %0, -1, %0" : "=v"(l_)); C.lane = l_; C.wave = wave0; C.tid = wave0 * 64 + l_; } while (0)
#define IN(k) (lo <= (k) && (k) < hi)
#define SEAM(k) do { if (IN((k) + 1)) { FRESH(); XcdBarrier b2_ = bar; asm volatile("" : "+s"(b2_.bar)); xcd_barrier(b2_, C.tid == 0); if (PROBE == 6) xcd_barrier(b2_, C.tid == 0); } } while (0)
#define MOD ((float*)(ws + WS_MOD))
#define PART ((float*)(ws + WS_PART))
#define RSQ ((float*)(ws + WS_RSQ))
#define COS ((float*)(ws + WS_COS))
#define SIN ((float*)(ws + WS_SIN))
#define H ((bf16_t*)(ws + WS_H))
#define LAT ((bf16_t*)(ws + WS_LAT))
#define ZB ((bf16_t*)(ws + WS_ZB))
#define QM ((bf16_t*)(ws + WS_QM))
#define KM ((bf16_t*)(ws + WS_KM))
#define VM ((bf16_t*)(ws + WS_VM))
#define OM ((bf16_t*)(ws + WS_OM))
#define PRE ((float*)(ws + WS_PRE))
#define T1 ((bf16_t*)(ws + WS_T1))
#define MB ((bf16_t*)(ws + WS_MB))
#define DQ (ZB)
#define DK (ZB + (size_t)T * 1024)
#define DV (ZB + (size_t)2 * T * 1024)
#define SA (ZB + (size_t)3 * T * 1024)
#define SB (ZB + (size_t)4 * T * 1024)
#define XF (ka->out)
#define ctl ((unsigned*)(ws + WS_CTL))
#define gw (C.vcu * NWAVES + C.wave)
#define NGW (C.G * NWAVES)

    if (PHM(10) && IN(0)) { KArgP ka = kargs(); (void)ka; FRESH(); unsigned char* const ws = ka->ws; C.ws = ws;
        for (int rep = 0; rep < (PROBE == 4 ? 2 : 1); ++rep) { cvt_mixer_weights(C, 0); cvt_ffn_weights(C, 0); }
        LAS float* cond = (LAS float*)(C.lds + C.wave * 8448);
        for (int it = gw; it < 4 * 24 * 8; it += NGW) {
            const int kc = it & 7, jb = (it >> 3) % 24, l = it / (8 * 24);
            for (int i = C.lane; i < 2048; i += 64) { const int k = i >> 4, b = i & 15; const float cv = ka->c[b * 1024 + kc * 128 + k]; cond[k * 16 + b] = cv / (1.0f + expf(-cv)); }
            asm volatile("s_waitcnt lgkmcnt(0)" ::: "memory");
            f32x4 acc[16];
#pragma unroll
            for (int b = 0; b < 16; ++b) acc[b] = (f32x4){0.f, 0.f, 0.f, 0.f};
            const float* wp = ka->w_ada + ((size_t)l * 1024 + kc * 128) * 6144 + jb * 256 + 4 * C.lane;
#pragma unroll 4
            for (int k = 0; k < 128; ++k) { const f32x4 w = *(const f32x4*)(wp + (size_t)k * 6144);
                const f32x4 c0 = *(const LAS f32x4*)(cond + k * 16), c1 = *(const LAS f32x4*)(cond + k * 16 + 4), c2 = *(const LAS f32x4*)(cond + k * 16 + 8), c3 = *(const LAS f32x4*)(cond + k * 16 + 12);
#pragma unroll
                for (int b = 0; b < 4; ++b) { acc[b] += w * c0[b]; acc[4 + b] += w * c1[b]; acc[8 + b] += w * c2[b]; acc[12 + b] += w * c3[b]; } }
#pragma unroll
            for (int b = 0; b < 16; ++b) *(f32x4*)(PART + (((size_t)kc * 4 + l) * 16 + b) * 6144 + jb * 256 + 4 * C.lane) = acc[b];
            asm volatile("s_waitcnt lgkmcnt(0)" ::: "memory");
        }
        for (int i = blockIdx.x * (NWAVES * 64) + C.tid; i < T * 16; i += C.G * NWAVES * 64) {
            const int t = i >> 4, j = i & 15; const float inv = powf(10000.0f, -(float)j * (1.0f / 16.0f)); const float ang = (float)ka->pos[t] * inv;
            COS[i] = cosf(ang); SIN[i] = sinf(ang); }
        SEAM(0);
    }
    if (PHM(11) && IN(1)) { KArgP ka = kargs(); (void)ka; FRESH(); unsigned char* const ws = ka->ws; C.ws = ws;
        for (int i = blockIdx.x * (NWAVES * 64) + C.tid; i < 4 * 16 * 6144; i += C.G * NWAVES * 64) {
            const int j = i % 6144, l = i / (16 * 6144); float s = ka->b_ada[l * 6144 + j];
#pragma unroll
            for (int kc = 0; kc < 8; ++kc) s += PART[(size_t)kc * 4 * 16 * 6144 + i];
            MOD[i] = s; }
        { const int wg = blockIdx.x, b = (wg * 128) >> 11; f32x4 vsc[4], vsh[4];
#pragma unroll
          for (int j = 0; j < 4; ++j) { const int c = 4 * C.lane + 256 * j; f32x4 a = *(const f32x4*)(ka->b_ada + c), s = *(const f32x4*)(ka->b_ada + 1024 + c);
#pragma unroll
              for (int kc = 0; kc < 8; ++kc) { const float* p = PART + (((size_t)kc * 4 + 0) * 16 + b) * 6144; a += *(const f32x4*)(p + c); s += *(const f32x4*)(p + 1024 + c); }
              vsh[j] = a; vsc[j] = s + 1.0f; }
          for (int rr = 0; rr < 16; ++rr) { const int row = wg * 128 + C.wave * 16 + rr;
#pragma unroll
              for (int j = 0; j < 4; ++j) { const int c = 4 * C.lane + 256 * j; const f32x4 xv = *(const f32x4*)(ka->x + (size_t)row * 1024 + c); const f32x4 hh = xv * vsc[j] + vsh[j];
                  u32x2 w; w.x = cvt_pk_bf16(hh[0], hh[1]); w.y = cvt_pk_bf16(hh[2], hh[3]); *(u32x2*)(H + (size_t)row * 1024 + c) = w; } } }
        SEAM(1);
    }

    for (int l = 0; l < DEPTH; ++l) {
        const int P = 2 + l * NPH_L;
        const bool moe = (l & 1) != 0; const int li = l >> 1;
        if (PHM(0) && IN(P + 0)) { KArgP ka = kargs(); (void)ka; FRESH(); unsigned char* const ws = ka->ws; C.ws = ws;
            pg8::Gemm g{H, (const bf16_t*)(ws + W_IN), T, NZ, 1024, 1024}; pg8::StaticOrder S; S.init(T, NZ, C.G, (int)blockIdx.x);
            pg8::EpiRow<FIn, true> E{FIn{LAT, ZB, KM, RSQ, COS, SIN}};
            GEMM_RUN(pg8::gemm_phase(C.lds, C.tid, g, S, E));
            SEAM(P + 0);
        }
        if (PHM(1) && IN(P + 1)) { KArgP ka = kargs(); (void)ka; FRESH(); unsigned char* const ws = ka->ws; C.ws = ws;
            { pg8::Gemm g{LAT, (const bf16_t*)(ws + W_QUP), T, 768, 384, 768}; pg8::StaticOrder S; S.init(T, 768, C.G, (int)blockIdx.x);
              pg8::EpiRow<FQup, true> E{FQup{QM, RSQ, COS, SIN}}; GEMM_RUN(pg8::gemm_phase(C.lds, C.tid, g, S, E)); }
            { pg8::Gemm g{LAT + 512, (const bf16_t*)(ws + W_KVUP), T, 1024, 256, 768}; pg8::StaticOrder S; S.init(T, 1024, C.G, (int)blockIdx.x);
              pg8::EpiRow<FKVup, true> E{FKVup{KM, VM, RSQ}}; GEMM_RUN(pg8::gemm_phase(C.lds, C.tid, g, S, E)); }
            for (int rb = gw * 16; rb < T; rb += NGW * 16) { float mx = 0.f;
#pragma unroll 4
                for (int r = 0; r < 16; ++r) { const u32x4* p = (const u32x4*)(DK + (size_t)(rb + r) * 1024) + C.lane * 2; f32x4 a0, a1, b0, b1; unpack8(p[0], a0, a1); unpack8(p[1], b0, b1);
                    float sq = (a0[0] * a0[0] + a0[1] * a0[1]) + (a0[2] * a0[2] + a0[3] * a0[3]) + (a1[0] * a1[0] + a1[1] * a1[1]) + (a1[2] * a1[2] + a1[3] * a1[3])
                             + (b0[0] * b0[0] + b0[1] * b0[1]) + (b0[2] * b0[2] + b0[3] * b0[3]) + (b1[0] * b1[0] + b1[1] * b1[1]) + (b1[2] * b1[2] + b1[3] * b1[3]);
                    sq += swz_xor<1>(sq); sq += swz_xor<2>(sq); mx = fmaxf(mx, sq); }
                if ((C.lane & 3) == 0) atomicMax(ctl + CW_KMAX + l * 256 + (rb >> 11) * 16 + (C.lane >> 2), __float_as_uint(mx)); }
            SEAM(P + 1);
        }
        if (PHM(2) && IN(P + 2)) { KArgP ka = kargs(); (void)ka; FRESH(); unsigned char* const ws = ka->ws; C.ws = ws;
            float lam;
            { float s1 = 0.f, s2 = 0.f;
              for (int i = 0; i < 64; ++i) { s1 += ka->lq1[l * 64 + i] * ka->lk1[l * 64 + i]; s2 += ka->lq2[l * 64 + i] * ka->lk2[l * 64 + i]; }
              lam = expf(s1) - expf(s2) + ka->lam_init[l]; }
            const int xcd = C.vcu >> 5, jj = C.vcu & 31; const bool g256 = (C.G == 256);
            for (int rep = 0; rep < (PROBE == 2 ? 2 : 1); ++rep)
            for (int i = 0; ; ++i) {
                int u; if (g256) { if (i >= 4) break; u = xcd * 128 + i * 32 + jj; } else { u = i * C.G + C.vcu; if (u >= 1024) break; }
                const int bh = u >> 3, qb = u & 7, b = bh >> 3, h = bh & 7; const size_t r0 = (size_t)b * SEQ;
                att::DiffArgs da{nullptr, 0.f, 0.f, 0.f, nullptr, 0.f};
                att::attn_unit<false>(QM + (r0 + qb * 256) * 768 + h * 96, KM + r0 * 768 + h * 96, VM + r0 * 512 + h * 64, OM + (r0 + qb * 256) * 512 + h * 64, qb * 256, da, (char*)lds, C.tid);
            }
            for (int rep = 0; rep < (PROBE == 3 ? 2 : 1); ++rep)
            for (int i = 0; ; ++i) {
                int b, h, qb;
                if (g256) { if (i >= 8) break; h = i; b = xcd * 2 + (jj >> 4); qb = jj & 15; } else { const int u = i * C.G + C.vcu; if (u >= 2048) break; const int bh = u >> 4; qb = u & 15; b = bh >> 3; h = bh & 7; }
                const size_t r0 = (size_t)b * SEQ;
                const unsigned* km = ctl + CW_KMAX + l * 256 + (b * 8 + h) * 2;
                att::DiffArgs da{ka->pos + r0, exp2f(-(float)(h + 1)) * LOG2E, lam, 1.0f - ka->lam_init[l], ka->diff_norm_g + l * 1024 + h * 128, fmaxf(__uint_as_float(km[0]), __uint_as_float(km[1]))};
                att::attn_unit<true>(DQ + (r0 + qb * 128) * 1024 + h * 128, DK + r0 * 1024 + h * 128, DV + r0 * 1024 + h * 128,
                                     ((PROBE == 3 && rep == 0) ? (bf16_t*)(ws + WS_END + 8 * MiB) : DQ) + (r0 + qb * 128) * 1024 + h * 128, qb * 128, da, (char*)lds, C.tid);
            }
            SEAM(P + 2);
        }
        if (PHM(3) && IN(P + 3)) { KArgP ka = kargs(); (void)ka; FRESH(); unsigned char* const ws = ka->ws; C.ws = ws;
            { pg8::Gemm g{OM, (const bf16_t*)(ws + W_BRM), T, 1024, 512, 512}; pg8::StaticOrder S; S.init(T, 1024, C.G, (int)blockIdx.x);
              pg8::EpiRow<FBr1, true> E{FBr1{T1, SA}}; GEMM_RUN(pg8::gemm_phase(C.lds, C.tid, g, S, E)); }
            asm volatile("s_waitcnt vmcnt(0)" ::: "memory"); __syncthreads();
            { pg8::Gemm g{DQ, (const bf16_t*)(ws + W_BRD), T, 1024, 1024, 1024}; pg8::StaticOrder S; S.init(T, 1024, C.G, (int)blockIdx.x);
              pg8::EpiRow<FBr2, true> E{FBr2{MB, T1, SB}}; GEMM_RUN(pg8::gemm_phase(C.lds, C.tid, g, S, E)); }
            SEAM(P + 3);
        }
        if (PHM(4) && IN(P + 4)) { KArgP ka = kargs(); (void)ka; FRESH(); unsigned char* const ws = ka->ws; C.ws = ws;
            pg8::Gemm g{MB, (const bf16_t*)(ws + W_OUT), T, 1024, 1024, 1024}; pg8::StaticOrder S; S.init(T, 1024, C.G, (int)blockIdx.x);
            const float* xres = (l == 0) ? ka->x : XF;
            pg8::EpiRow<FRes, false> E{FRes{PRE, xres, (MOD + (size_t)l * 16 * 6144) + 2048}}; GEMM_RUN(pg8::gemm_phase(C.lds, C.tid, g, S, E));
            SEAM(P + 4);
        }
        if (PHM(5) && IN(P + 5)) { KArgP ka = kargs(); (void)ka; FRESH(); unsigned char* const ws = ka->ws; C.ws = ws;
            if (moe) ln_phase<0, true>(C, PRE, XF, H, ka->ln1_g + l * 1024, ka->ln1_b + l * 1024, (MOD + (size_t)l * 16 * 6144) + 4096, (MOD + (size_t)l * 16 * 6144) + 3072, nullptr, nullptr, nullptr,
                                       ka->router_w + (size_t)li * 8192, ka->router_b + li * 8, (int*)(ws + WS_SEL), (float*)(ws + WS_GATE), ctl + CW_CNT + 64 * li);
            else for (int rep = 0; rep < (PROBE == 5 ? 2 : 1); ++rep) ln_phase<0, false>(C, PRE, XF, H, ka->ln1_g + l * 1024, ka->ln1_b + l * 1024, (MOD + (size_t)l * 16 * 6144) + 4096, (MOD + (size_t)l * 16 * 6144) + 3072, nullptr, nullptr, nullptr, nullptr, nullptr, nullptr, nullptr, nullptr);
            SEAM(P + 5);
        }
        int ts[9];
#pragma unroll
        for (int e = 0; e < 9; ++e) ts[e] = 0;
        if (moe && (IN(P + 6) || IN(P + 7) || IN(P + 8))) { KArgP ka = kargs(); unsigned char* const ws = ka->ws;
            int accp = 0;
#pragma unroll
            for (int e = 0; e < 8; ++e) { ts[e] = accp; const int cnt = (int)__hip_atomic_load(ctl + CW_CNT + 64 * li + e, __ATOMIC_RELAXED, __HIP_MEMORY_SCOPE_AGENT); accp += (cnt + 255) >> 8; }
            ts[8] = accp;
        }
        if (PHM(6) && IN(P + 6)) { KArgP ka = kargs(); (void)ka; FRESH(); unsigned char* const ws = ka->ws; C.ws = ws;
            if (moe) {
                const int* SEL = (const int*)(ws + WS_SEL); int* RMAP = (int*)(ws + WS_RMAP); bf16_t* XB = (bf16_t*)(ws + WS_XB);
                unsigned* CUR = ctl + CW_CUR + 64 * li; const unsigned* CNT = ctl + CW_CNT + 64 * li;
                if (blockIdx.x == 0) {
                    _Pragma("unroll") for (int e = 0; e < 8; ++e) { const int c = (int)CNT[e], beg = ts[e] * 256 + c, end = ts[e + 1] * 256; for (int p = beg + C.tid; p < end; p += NWAVES * 64) RMAP[p] = -1; } }
                for (int s0 = gw * 64; s0 < 2 * T; s0 += NGW * 64) {
                    const int s = s0 + C.lane, t = s >> 1, k = s & 1; const int sel = SEL[t]; const int e = k ? (sel >> 8) : (sel & 255);
                    int pos = 0;
#pragma unroll
                    for (int ee = 0; ee < 8; ++ee) { const unsigned long long m = __ballot(e == ee); const int n = __popcll(m);
                        if (n) { unsigned base = 0; if (C.lane == 0) base = atomicAdd(CUR + ee, (unsigned)n); base = __builtin_amdgcn_readfirstlane(base);
                            if (e == ee) pos = ts[ee] * 256 + (int)base + (int)__builtin_amdgcn_mbcnt_hi((unsigned)(m >> 32), __builtin_amdgcn_mbcnt_lo((unsigned)m, 0u)); } }
                    RMAP[pos] = s;
                    for (int q = 0; q < 64; q += 8) {
                        u32x4 r0[4], r1[4];
#pragma unroll
                        for (int u = 0; u < 4; ++u) { const int tq = (s0 + q + 2 * u) >> 1; const u32x4* src = (const u32x4*)(H + (size_t)tq * 1024); r0[u] = src[C.lane]; r1[u] = src[64 + C.lane]; }
#pragma unroll
                        for (int u = 0; u < 4; ++u) {
#pragma unroll
                            for (int k2 = 0; k2 < 2; ++k2) { const int pq = __builtin_amdgcn_readlane(pos, q + 2 * u + k2); u32x4* dst = (u32x4*)(XB + (size_t)pq * 1024); dst[C.lane] = r0[u]; dst[64 + C.lane] = r1[u]; } }
                    }
                }
            }
            if (moe) SEAM(P + 6);
        }
        if (PHM(7) && IN(P + 7)) { KArgP ka = kargs(); (void)ka; FRESH(); unsigned char* const ws = ka->ws; C.ws = ws;
            if (!moe) { pg8::Gemm g{H, (const bf16_t*)(ws + WS_WFF), T, 5632, 1024, 1024}; pg8::StaticOrder S; S.init(T, 5632, C.G, (int)blockIdx.x);
                pg8::EpiSwiglu E{(bf16_t*)(ws + WS_U), FF}; GEMM_RUN(pg8::gemm_phase(C.lds, C.tid, g, S, E)); }
            else { pg8::Gemm g{(const bf16_t*)(ws + WS_XB), (const bf16_t*)(ws + WS_WFF), ts[8] * 256, 5632, 1024, 1024};
                pg8::MoeOrder S; S.so.init(ts[8] * 256, 5632, C.G, (int)blockIdx.x); S.ts1 = ts[1]; S.ts2 = ts[2]; S.ts3 = ts[3]; S.ts4 = ts[4]; S.ts5 = ts[5]; S.ts6 = ts[6]; S.ts7 = ts[7]; S.estride = W13_ESTRIDE;
                pg8::EpiSwiglu E{(bf16_t*)(ws + WS_UM), FF}; GEMM_RUN(pg8::gemm_phase(C.lds, C.tid, g, S, E)); }
            SEAM(P + 7);
        }
        if (PHM(8) && IN(P + 8)) { KArgP ka = kargs(); (void)ka; FRESH(); unsigned char* const ws = ka->ws; C.ws = ws;
            if (!moe) { pg8::Gemm g{(const bf16_t*)(ws + WS_U), (const bf16_t*)(ws + W2_BASE), T, 1024, FF, FF}; pg8::StaticOrder S; S.init(T, 1024, C.G, (int)blockIdx.x);
                pg8::EpiRow<FRes, false> E{FRes{PRE, XF, (MOD + (size_t)l * 16 * 6144) + 5120}}; GEMM_RUN(pg8::gemm_phase(C.lds, C.tid, g, S, E)); }
            else { pg8::Gemm g{(const bf16_t*)(ws + WS_UM), (const bf16_t*)(ws + W2_BASE), ts[8] * 256, 1024, FF, FF};
                pg8::MoeOrder S; S.so.init(ts[8] * 256, 1024, C.G, (int)blockIdx.x); S.ts1 = ts[1]; S.ts2 = ts[2]; S.ts3 = ts[3]; S.ts4 = ts[4]; S.ts5 = ts[5]; S.ts6 = ts[6]; S.ts7 = ts[7]; S.estride = W2_ESTRIDE;
                pg8::EpiRow<FMoeOut, true> E{FMoeOut{(bf16_t*)(ws + WS_Y), (const int*)(ws + WS_RMAP)}}; GEMM_RUN(pg8::gemm_phase(C.lds, C.tid, g, S, E)); }
            SEAM(P + 8);
        }
        if (PHM(9) && IN(P + 9)) { KArgP ka = kargs(); (void)ka; FRESH(); unsigned char* const ws = ka->ws; C.ws = ws;
            const float* nsc = (l + 1 < DEPTH) ? MOD + (size_t)(l + 1) * 16 * 6144 + 1024 : nullptr; const float* nsh = (l + 1 < DEPTH) ? MOD + (size_t)(l + 1) * 16 * 6144 : nullptr;
            if (moe) ln_phase<1, false>(C, nullptr, XF, H, ka->ln2_g + l * 1024, ka->ln2_b + l * 1024, nsc, nsh, (const bf16_t*)(ws + WS_Y), (const float*)(ws + WS_GATE), (MOD + (size_t)l * 16 * 6144) + 5120, nullptr, nullptr, nullptr, nullptr, nullptr);
            else for (int rep = 0; rep < (PROBE == 5 ? 2 : 1); ++rep) ln_phase<0, false>(C, PRE, XF, H, ka->ln2_g + l * 1024, ka->ln2_b + l * 1024, nsc, nsh, nullptr, nullptr, nullptr, nullptr, nullptr, nullptr, nullptr, nullptr);
            if (l + 1 < DEPTH) for (int rep = 0; rep < (PROBE == 4 ? 2 : 1); ++rep) { __syncthreads(); cvt_mixer_weights(C, l + 1); cvt_ffn_weights(C, l + 1); }
            if (l + 1 < DEPTH) SEAM(P + 9);
        }
    }
#undef IN
#undef SEAM
#undef MOD
#undef PART
#undef RSQ
#undef COS
#undef SIN
#undef H
#undef LAT
#undef ZB
#undef QM
#undef KM
#undef VM
#undef OM
#undef PRE
#undef T1
#undef MB
#undef DQ
#undef DK
#undef DV
#undef SA
#undef SB
#undef XF
#undef ctl
#undef gw
#undef NGW
}

extern "C" void kernel_launch(void* const* d_in, const int* in_sizes, int n_in, void* d_out, int out_size, void* d_ws, size_t ws_size, hipStream_t stream) {
    static int grid = 0;
    if (grid == 0) {
        if (n_in != 30 || in_sizes[0] != T * D || out_size != T * D || ws_size < WS_NEED) { fprintf(stderr, "kernel_launch: unexpected shapes (n_in %d, in0 %d, out %d, ws %zu, need %zu)\n", n_in, n_in > 0 ? in_sizes[0] : -1, out_size, ws_size, (size_t)WS_NEED); grid = -1; return; }
        if (hipFuncSetAttribute((const void*)mk_fwd, hipFuncAttributeMaxDynamicSharedMemorySize, LDS_BYTES) != hipSuccess) { fprintf(stderr, "kernel_launch: hipFuncSetAttribute failed\n"); grid = -1; return; }
        int per_cu = 0;
        if (hipOccupancyMaxActiveBlocksPerMultiprocessor(&per_cu, (const void*)mk_fwd, NWAVES * 64, LDS_BYTES) != hipSuccess || per_cu < 1) fprintf(stderr, "kernel_launch: occupancy query reports %d\n", per_cu);
        (void)hipGetLastError();
        grid = 256;
    }
    if (grid < 0) return;
    if (hipMemsetAsync((char*)d_ws + WS_CTL, 0, CTL_ZERO_BYTES, stream) != hipSuccess) { fprintf(stderr, "kernel_launch: memset failed\n"); return; }
    Args a{};
    const float** fp = (const float**)&a.x;
    a.x = (const float*)d_in[0]; a.c = (const float*)d_in[1]; a.pos = (const int*)d_in[2]; a.w_ada = (const float*)d_in[3]; a.b_ada = (const float*)d_in[4]; a.w_in = (const float*)d_in[5];
    a.q_norm_g = (const float*)d_in[6]; a.w_q_up = (const float*)d_in[7]; a.kv_norm_g = (const float*)d_in[8]; a.w_kv_up = (const float*)d_in[9];
    a.lq1 = (const float*)d_in[10]; a.lk1 = (const float*)d_in[11]; a.lq2 = (const float*)d_in[12]; a.lk2 = (const float*)d_in[13]; a.diff_norm_g = (const float*)d_in[14];
    a.w_br_mla = (const float*)d_in[15]; a.w_br_diff = (const float*)d_in[16]; a.w_out = (const float*)d_in[17];
    a.ln1_g = (const float*)d_in[18]; a.ln1_b = (const float*)d_in[19]; a.ln2_g = (const float*)d_in[20]; a.ln2_b = (const float*)d_in[21];
    a.ffn_w1 = (const float*)d_in[22]; a.ffn_w3 = (const float*)d_in[23]; a.ffn_w2 = (const float*)d_in[24]; a.router_w = (const float*)d_in[25]; a.router_b = (const float*)d_in[26];
    a.moe_w1 = (const float*)d_in[27]; a.moe_w3 = (const float*)d_in[28]; a.moe_w2 = (const float*)d_in[29];
    (void)fp;
    a.out = (float*)d_out; a.ws = (unsigned char*)d_ws;
    for (int l = 0; l < 4; ++l) a.lam_init[l] = (float)(0.8 - 0.6 * exp(-0.3 * (double)l));
#if MK_PER_PHASE
    for (int p = 0; p < NPHASE; ++p) {
        const int k = (p - 2) % NPH_L, l = (p - 2) / NPH_L;
        if (p >= 2 && k == 6 && (l & 1) == 0) continue;
        a.ph_lo = p; a.ph_hi = p + 1;
        hipLaunchKernelGGL(mk_fwd, dim3(grid), dim3(NWAVES * 64), LDS_BYTES, stream, a);
    }
#else
    a.ph_lo = 0; a.ph_hi = NPHASE;
    hipLaunchKernelGGL(mk_fwd, dim3(grid), dim3(NWAVES * 64), LDS_BYTES, stream, a);
#endif
    const hipError_t le = hipPeekAtLastError();
    if (le != hipSuccess) fprintf(stderr, "kernel_launch: launch failed: %s\n", hipGetErrorName(le));
}
```

```cpp
#include <hip/hip_runtime.h>
#include <hip/hip_bf16.h>
#include <cstdio>
#include <cstdint>
#include <cmath>

#ifndef MK_PER_PHASE
#define MK_PER_PHASE 0
#endif
#ifndef PH_MASK
#define PH_MASK 0xFFFF
#endif
#define PHM(k) (((PH_MASK) >> (k)) & 1)
#ifndef STG_IN
#define STG_IN 0
#endif
#ifndef STG_BR
#define STG_BR 0
#endif
#ifndef STG_OUT
#define STG_OUT 0
#endif
#ifndef PROBE
#define PROBE 0
#endif

constexpr int D = 1024, BATCH = 16, SEQ = 2048, DEPTH = 4, T = BATCH * SEQ;
constexpr int NZ = 5888;
constexpr int FF = 2816, NEXP = 8;
constexpr float ALPHA = 1.681792830507429f;
constexpr float LN_EPS = 1e-5f, RMS_EPS = 1e-6f;
constexpr float LOG2E = 1.4426950408889634f;
constexpr float CQ_MLA = 0.10206207261596575f * LOG2E;
constexpr float CQ_DIFF = 0.125f * LOG2E;

#define LAS __attribute__((address_space(3)))
#define GAS __attribute__((address_space(1)))
typedef unsigned short bf16_t;
typedef short bf16x8 __attribute__((ext_vector_type(8)));
typedef short s16x4 __attribute__((ext_vector_type(4)));
typedef float f32x4 __attribute__((ext_vector_type(4)));
typedef float f32x2 __attribute__((ext_vector_type(2)));
typedef float f32x16 __attribute__((ext_vector_type(16)));
typedef unsigned u32x4 __attribute__((ext_vector_type(4)));
typedef unsigned u32x2 __attribute__((ext_vector_type(2)));

typedef __bf16 bf16x2_t __attribute__((ext_vector_type(2)));
__device__ __forceinline__ unsigned cvt_pk_bf16(float lo, float hi) { const f32x2 v = {lo, hi}; return __builtin_bit_cast(unsigned, __builtin_convertvector(v, bf16x2_t)); }
__device__ __forceinline__ u32x4 pack8(f32x4 a, f32x4 b) { u32x4 w; w.x = cvt_pk_bf16(a[0], a[1]); w.y = cvt_pk_bf16(a[2], a[3]); w.z = cvt_pk_bf16(b[0], b[1]); w.w = cvt_pk_bf16(b[2], b[3]); return w; }
__device__ __forceinline__ void unpack8(u32x4 w, f32x4& a, f32x4& b) {
    a[0] = __uint_as_float(w.x << 16); a[1] = __uint_as_float(w.x & 0xffff0000u); a[2] = __uint_as_float(w.y << 16); a[3] = __uint_as_float(w.y & 0xffff0000u);
    b[0] = __uint_as_float(w.z << 16); b[1] = __uint_as_float(w.z & 0xffff0000u); b[2] = __uint_as_float(w.w << 16); b[3] = __uint_as_float(w.w & 0xffff0000u); }
__device__ __forceinline__ unsigned pack4_fp8(float a, float b, float c, float d) {
    a = fminf(fmaxf(a, -448.f), 448.f); b = fminf(fmaxf(b, -448.f), 448.f); c = fminf(fmaxf(c, -448.f), 448.f); d = fminf(fmaxf(d, -448.f), 448.f);
    int w = 0; w = __builtin_amdgcn_cvt_pk_fp8_f32(a, b, w, false); w = __builtin_amdgcn_cvt_pk_fp8_f32(c, d, w, true); return (unsigned)w; }
constexpr float W8_SCALE_W2 = 128.0f;
constexpr float W8_SCALE = 32.0f;
__device__ __forceinline__ float bf2f(bf16_t v) { return __uint_as_float(((unsigned)v) << 16); }
template <int X> __device__ __forceinline__ float swz_xor(float v) { return __int_as_float(__builtin_amdgcn_ds_swizzle(__float_as_int(v), (X << 10) | 0x1f)); }
__device__ __forceinline__ float sum_x32(float v) { auto rr = __builtin_amdgcn_permlane32_swap(__float_as_uint(v), __float_as_uint(v), false, false); return __uint_as_float(rr[0]) + __uint_as_float(rr[1]); }
constexpr float O8_SCALE = 16.0f, W8_SCALE_BR = 64.0f;
__device__ __forceinline__ float sigmoidf_(float x) { return __builtin_amdgcn_rcpf(1.0f + __builtin_amdgcn_exp2f(-x * LOG2E)); }

namespace pg8 {
constexpr int BM = 256, BK = 64, HALF = 128, HTB = HALF * BK * 2, STAGE_BYTES = 8 * HTB, NXCD = 8, WGM = 8;
__host__ __device__ __forceinline__ int lds_byte(int r, int c) { const int st = (r >> 4) * 2 + (c >> 5), rr = r & 15, cc = c & 31, ob = rr * 64 + cc * 2; return st * 1024 + (ob ^ (((ob >> 9) & 1) << 5)); }
__host__ __device__ __forceinline__ void stage_rc(int b, int& R, int& C) { const int st = b / 1024, sb = b % 1024, swz = sb ^ (((sb >> 9) & 1) << 5); R = (st >> 1) * 16 + swz / 64; C = (st & 1) * 32 + (swz % 64) / 2; }
__host__ __device__ __forceinline__ int perm32(int rho) { const int n = rho >> 4, i = rho & 15; return 8 * (i >> 2) + 4 * n + (i & 3); }

struct Unit { int pm, pn; };
struct Gemm { const bf16_t* A; const bf16_t* Bt; int M, N, K, lda; };

struct StaticOrder {
    int nM, nN, nwg, G, c;
    __host__ __device__ void init(int M, int N, int G_, int c_) { nM = M / BM; nN = N / BM; nwg = nM * nN; G = G_; c = c_; }
    static constexpr bool GATHER = false; const int* rmap = nullptr;
    __host__ __device__ bool next(int i, Unit& u) const {
        const long L = (long)i * G + c; if (L >= nwg) return false;
        int wgid = (int)L; { const int q = nwg / NXCD, r = nwg % NXCD, xcd = wgid % NXCD, off = wgid / NXCD; wgid = (xcd < r ? xcd * (q + 1) : r * (q + 1) + (xcd - r) * q) + off; }
        const int nig = WGM * nN, gid = wgid / nig, fm = gid * WGM, gsz = (nM - fm) < WGM ? (nM - fm) : WGM;
        u.pm = fm + ((wgid % nig) % gsz); u.pn = (wgid % nig) / gsz; return true;
    }
    __device__ __forceinline__ size_t bofs(const Unit&) const { return 0; }
};
template <bool GATHER_> struct MoeOrderT {
    static constexpr bool GATHER = GATHER_;
    StaticOrder so; int ts1, ts2, ts3, ts4, ts5, ts6, ts7; size_t estride; const int* rmap;
    __device__ __forceinline__ bool next(int i, Unit& u) const { return so.next(i, u); }
    __device__ __forceinline__ size_t bofs(const Unit& u) const {
        const int e = (u.pm >= ts1) + (u.pm >= ts2) + (u.pm >= ts3) + (u.pm >= ts4) + (u.pm >= ts5) + (u.pm >= ts6) + (u.pm >= ts7);
        return (size_t)e * estride; }
};

template <class F, bool PERM_, bool WIDE_ = false> struct EpiRow {
    static constexpr bool PERM = PERM_, WIDE = WIDE_; F f;
    __device__ __forceinline__ void operator()(const f32x4 (&acc)[2][2][4][2], const Unit& u, int wr, int wc, int fr, int fq) const {
#pragma unroll
        for (int ai = 0; ai < 2; ++ai) {
            float rs[4];
#pragma unroll
            for (int m = 0; m < 4; ++m) rs[m] = f.rowscale(u.pm * BM + ai * HALF + wr * 64 + m * 16 + fr);
#pragma unroll
            for (int m = 0; m < 4; ++m) { const int row = u.pm * BM + ai * HALF + wr * 64 + m * 16 + fr;
#pragma unroll
                for (int bj = 0; bj < 2; ++bj) f(row, rs[m], u.pn * BM + (WIDE ? wc * 64 + bj * 32 : bj * HALF + wc * 32), fq, acc[ai][bj][m][0], acc[ai][bj][m][1]);
                asm volatile("" ::: "memory"); __builtin_amdgcn_sched_barrier(0); }
        }
    }
};
struct EpiGate {
    static constexpr bool PERM = true, WIDE = true; bf16_t* G; float inscale;
    __device__ __forceinline__ void operator()(const f32x4 (&acc)[2][2][4][2], const Unit& u, int wr, int wc, int fr, int fq) const {
        const int col0 = u.pn * BM + wc * 64 + 8 * fq;
#pragma unroll
        for (int ai = 0; ai < 2; ++ai)
#pragma unroll
            for (int m = 0; m < 4; ++m) { const size_t o = (size_t)(u.pm * BM + ai * HALF + wr * 64 + m * 16 + fr) * 1024 + col0;
#pragma unroll
                for (int bj = 0; bj < 2; ++bj) *(u32x4*)(G + o + bj * 32) = pack8(acc[ai][bj][m][0] * inscale, acc[ai][bj][m][1] * inscale);
                __builtin_amdgcn_sched_barrier(0); }
    }
};
__device__ __forceinline__ void unpack8_fp8(u32x2 w, f32x4& a, f32x4& b) {
    const f32x2 a0 = __builtin_amdgcn_cvt_pk_f32_fp8((int)w.x, false), a1 = __builtin_amdgcn_cvt_pk_f32_fp8((int)w.x, true);
    const f32x2 b0 = __builtin_amdgcn_cvt_pk_f32_fp8((int)w.y, false), b1 = __builtin_amdgcn_cvt_pk_f32_fp8((int)w.y, true);
    a[0] = a0[0]; a[1] = a0[1]; a[2] = a1[0]; a[3] = a1[1]; b[0] = b0[0]; b[1] = b0[1]; b[2] = b1[0]; b[3] = b1[1]; }
constexpr float Y8_SCALE = 16.0f, MB8_SCALE = 32.0f;
template <int MODE> struct EpiBr {
    static constexpr bool PERM = true, WIDE = true; void* O; const unsigned char* SA8; const unsigned char* SB8; const unsigned char* Y8; float inscale;
    __device__ __forceinline__ void operator()(const f32x4 (&acc)[2][2][4][2], const Unit& u, int wr, int wc, int fr, int fq) const {
        const int col0 = u.pn * BM + wc * 64 + 8 * fq;
#pragma unroll
        for (int ai = 0; ai < 2; ++ai) {
            if (MODE == 1) {
#pragma unroll
                for (int m = 0; m < 4; ++m) { const size_t o = (size_t)(u.pm * BM + ai * HALF + wr * 64 + m * 16 + fr) * 1024 + col0;
#pragma unroll
                    for (int bj = 0; bj < 2; ++bj) { const f32x4 r0 = acc[ai][bj][m][0] * (Y8_SCALE * inscale), r1 = acc[ai][bj][m][1] * (Y8_SCALE * inscale);
                        u32x2 w8; w8.x = pack4_fp8(r0[0], r0[1], r0[2], r0[3]); w8.y = pack4_fp8(r1[0], r1[1], r1[2], r1[3]);
                        *(u32x2*)((unsigned char*)O + o + bj * 32) = w8; }
                    __builtin_amdgcn_sched_barrier(0); }
            } else {
                u32x2 av[4][2], bv[4][2], yv[4][2];
#pragma unroll
                for (int m = 0; m < 4; ++m) { const size_t o = (size_t)(u.pm * BM + ai * HALF + wr * 64 + m * 16 + fr) * 1024 + col0;
#pragma unroll
                    for (int bj = 0; bj < 2; ++bj) { av[m][bj] = *(const u32x2*)(SA8 + o + bj * 32); bv[m][bj] = *(const u32x2*)(SB8 + o + bj * 32); yv[m][bj] = *(const u32x2*)(Y8 + o + bj * 32); } }
#pragma unroll
                for (int m = 0; m < 4; ++m) { const size_t o = (size_t)(u.pm * BM + ai * HALF + wr * 64 + m * 16 + fr) * 1024 + col0;
#pragma unroll
                    for (int bj = 0; bj < 2; ++bj) { f32x4 a0, a1, b0, b1, y0, y1; unpack8_fp8(av[m][bj], a0, a1); unpack8_fp8(bv[m][bj], b0, b1); unpack8_fp8(yv[m][bj], y0, y1);
                        const f32x4 r0 = acc[ai][bj][m][0] * b0 * (MB8_SCALE * inscale) + a0 * y0 * (MB8_SCALE / Y8_SCALE), r1 = acc[ai][bj][m][1] * b1 * (MB8_SCALE * inscale) + a1 * y1 * (MB8_SCALE / Y8_SCALE);
                        u32x2 w8; w8.x = pack4_fp8(r0[0], r0[1], r0[2], r0[3]); w8.y = pack4_fp8(r1[0], r1[1], r1[2], r1[3]);
                        *(u32x2*)((unsigned char*)O + o + bj * 32) = w8; } }
                asm volatile("" ::: "memory"); __builtin_amdgcn_sched_barrier(0);
            }
        }
    }
};
struct EpiMoeOut {
    static constexpr bool PERM = true, WIDE = true; bf16_t* Y; const int* RMAP; float inscale;
    __device__ __forceinline__ void operator()(const f32x4 (&acc)[2][2][4][2], const Unit& u, int wr, int wc, int fr, int fq) const {
        const int col0 = u.pn * BM + wc * 64 + 8 * fq; int sl[2][4];
#pragma unroll
        for (int ai = 0; ai < 2; ++ai)
#pragma unroll
            for (int m = 0; m < 4; ++m) sl[ai][m] = RMAP[u.pm * BM + ai * HALF + wr * 64 + m * 16 + fr];
#pragma unroll
        for (int ai = 0; ai < 2; ++ai)
#pragma unroll
            for (int m = 0; m < 4; ++m) { if (sl[ai][m] >= 0) {
#pragma unroll
                for (int bj = 0; bj < 2; ++bj) *(u32x4*)(Y + (size_t)sl[ai][m] * 1024 + col0 + bj * 32) = pack8(acc[ai][bj][m][0] * inscale, acc[ai][bj][m][1] * inscale); }
                __builtin_amdgcn_sched_barrier(0); }
    }
};
struct EpiSwiglu {
    static constexpr bool PERM = true, WIDE = false; bf16_t* U; int ldu; float inscale; bool out8;
    __device__ __forceinline__ void operator()(const f32x4 (&acc)[2][2][4][2], const Unit& u, int wr, int wc, int fr, int fq) const {
#pragma unroll
        for (int ai = 0; ai < 2; ++ai)
#pragma unroll
            for (int m = 0; m < 4; ++m) { const int row = u.pm * BM + ai * HALF + wr * 64 + m * 16 + fr;
                f32x4 o[2];
#pragma unroll
                for (int n = 0; n < 2; ++n) { const f32x4 a = acc[ai][0][m][n] * inscale, b = acc[ai][1][m][n] * inscale;
#pragma unroll
                    for (int i = 0; i < 4; ++i) o[n][i] = a[i] * sigmoidf_(a[i]) * b[i]; }
                if (out8) { u32x2 w8; w8.x = pack4_fp8(o[0][0], o[0][1], o[0][2], o[0][3]); w8.y = pack4_fp8(o[1][0], o[1][1], o[1][2], o[1][3]);
                    *(u32x2*)((unsigned char*)U + (size_t)row * ldu + u.pn * HALF + wc * 32 + 8 * fq) = w8; }
                else *(u32x4*)(U + (size_t)row * ldu + u.pn * HALF + wc * 32 + 8 * fq) = pack8(o[0], o[1]);
                __builtin_amdgcn_sched_barrier(0); }
    }
};

template <int STG_US = 0, bool FP8 = false, class Epi, class Sched, bool ALIGN_EPI = true>
__device__ __forceinline__ void gemm_phase(LAS unsigned char* lds, int tid_in, const Gemm g, const Sched& S, const Epi& E) {
    int tid_ = tid_in; asm volatile("" : "+v"(tid_));
    const int tid = tid_, wid = __builtin_amdgcn_readfirstlane(tid >> 6), lane = tid & 63, wr = wid >> 2, wc = wid & 3, fr = lane & 15, fq = lane >> 4;
    const int K = g.K, nt = K / BK, lda = g.lda;
    unsigned voffA[2], voffB[2];
#pragma unroll
    for (int i = 0; i < 2; ++i) { int R, C; stage_rc(tid * 16 + i * 8192, R, C);
        const int Rb = Epi::WIDE ? (64 * (R >> 5) + perm32(R & 31)) : (Epi::PERM ? ((R & ~31) + perm32(R & 31)) : R);
        voffA[i] = (unsigned)(R * lda + C) * 2u; voffB[i] = (unsigned)(Rb * K + C) * 2u; }
    const size_t kstep = (size_t)(BK * 2);
    constexpr bool GATHER = Sched::GATHER;
    unsigned oc[2], on[2], cb2[2];
    const size_t hstepA = (size_t)HALF * lda * 2, hstepB = Epi::WIDE ? (size_t)32 * K * 2 : (size_t)HALF * K * 2;
    const size_t tstepA = 2 * hstepA, tstepB = (size_t)BM * K * 2;
    const unsigned ldsw = (unsigned)wid * 1024u;
    const int aoff = lds_byte(wr * 64 + fr, FP8 ? fq * 16 : fq * 8), boff = lds_byte(wc * 32 + fr, FP8 ? fq * 16 : fq * 8);
#define PG8_SA(b, h) (((b) * 2 + (h)) * HTB)
#define PG8_SB(b, h) ((4 + (b) * 2 + (h)) * HTB)
#define PG8_STAGE(bufoff, gbase, voff) do { _Pragma("unroll") for (int _i = 0; _i < 2; ++_i) \
        __builtin_amdgcn_global_load_lds((const unsigned*)((const char*)(gbase) + (voff)[_i]), (LAS unsigned*)(lds + (bufoff) + ldsw + _i * 8192), 16, 0, 0); } while (0)
#define PG8_GOFF(dst, u) do { if constexpr (GATHER) { _Pragma("unroll") for (int h_ = 0; h_ < 2; ++h_) { unsigned pk_ = 0u; _Pragma("unroll") for (int i_ = 0; i_ < 2; ++i_) { int R_, C_; stage_rc(tid * 16 + i_ * 8192, R_, C_); \
        const int sl_ = S.rmap[(u).pm * BM + h_ * HALF + R_]; pk_ |= (unsigned)((sl_ < 0 ? 0 : sl_) >> 1) << (16 * i_); } dst[h_] = pk_; } } } while (0)
#define PG8_STAGE_A(bufoff, gptr, h, NXT) do { if constexpr (GATHER) { const unsigned pk_ = ((NXT) && last_) ? on[h] : oc[h]; \
        unsigned go_[2]; go_[0] = (pk_ & 0xffffu) * (unsigned)(lda * 2) + cb2[0]; go_[1] = (pk_ >> 16) * (unsigned)(lda * 2) + cb2[1]; PG8_STAGE(bufoff, gptr, go_); } \
        else PG8_STAGE(bufoff, (gptr) + (h) * hstepA, voffA); } while (0)
#define PG8_LDA(dst, b, h) do { if constexpr (FP8) { _Pragma("unroll") for (int m = 0; m < 4; ++m) { const i32x4_ lo_ = *(const LAS i32x4_*)(lds + PG8_SA(b, h) + aoff + m * 2048), hi_ = *(const LAS i32x4_*)(lds + PG8_SA(b, h) + aoff + m * 2048 + 16); \
        dst##8[m] = __builtin_shufflevector(lo_, hi_, 0, 1, 2, 3, 4, 5, 6, 7); } } \
    else { _Pragma("unroll") for (int m = 0; m < 4; ++m) _Pragma("unroll") for (int k = 0; k < 2; ++k) dst[m][k] = *(const LAS bf16x8*)(lds + PG8_SA(b, h) + aoff + m * 2048 + k * 1024); } } while (0)
#define PG8_LDB(dst, b, h) do { if constexpr (FP8) { _Pragma("unroll") for (int n = 0; n < 2; ++n) { const i32x4_ lo_ = *(const LAS i32x4_*)(lds + PG8_SB(b, h) + boff + n * 2048), hi_ = *(const LAS i32x4_*)(lds + PG8_SB(b, h) + boff + n * 2048 + 16); \
        dst##8[n] = __builtin_shufflevector(lo_, hi_, 0, 1, 2, 3, 4, 5, 6, 7); } } \
    else { _Pragma("unroll") for (int n = 0; n < 2; ++n) _Pragma("unroll") for (int k = 0; k < 2; ++k) dst[n][k] = *(const LAS bf16x8*)(lds + PG8_SB(b, h) + boff + n * 2048 + k * 1024); } } while (0)
#define PG8_MMA(ai, bj, At, Bt) do { __builtin_amdgcn_s_setprio(1); if constexpr (FP8) { _Pragma("unroll") for (int m = 0; m < 4; ++m) _Pragma("unroll") for (int n = 0; n < 2; ++n) \
        asm volatile("v_mfma_scale_f32_16x16x128_f8f6f4 %0, %1, %2, %0, %3, %3 op_sel_hi:[0,0,0]" : "+v"(acc[ai][bj][m][n]) : "v"(Bt##8[n]), "v"(At##8[m]), "v"(scl8)); } \
      else { _Pragma("unroll") for (int m = 0; m < 4; ++m) _Pragma("unroll") for (int n = 0; n < 2; ++n) _Pragma("unroll") for (int k = 0; k < 2; ++k) \
        acc[ai][bj][m][n] = __builtin_amdgcn_mfma_f32_16x16x32_bf16(Bt[n][k], At[m][k], acc[ai][bj][m][n], 0, 0, 0); } __builtin_amdgcn_s_setprio(0); } while (0)
#define PG8_WAIT_V(n) asm volatile("s_waitcnt vmcnt(" #n ")" ::: "memory")
#define PG8_WAIT_L(n) asm volatile("s_waitcnt lgkmcnt(" #n ")" ::: "memory")
#define PG8_BAR __builtin_amdgcn_s_barrier()
#define PG8_SCHED __builtin_amdgcn_sched_barrier(0)
    Unit cur, nxt; int ui = 0;
    if (!S.next(0, cur)) return;
    if (STG_US > 0 && blockIdx.x >= 128) { const unsigned long long t0_ = __builtin_amdgcn_s_memrealtime(); while (__builtin_amdgcn_s_memrealtime() - t0_ < (unsigned long long)(STG_US * 100)) __builtin_amdgcn_s_sleep(8); }
    f32x4 acc[2][2][4][2];
#pragma unroll
    for (int a = 0; a < 2; ++a)
#pragma unroll
        for (int b = 0; b < 2; ++b)
#pragma unroll
            for (int m = 0; m < 4; ++m)
#pragma unroll
                for (int n = 0; n < 2; ++n) acc[a][b][m][n] = (f32x4){0.f, 0.f, 0.f, 0.f};
    typedef int i32x4_ __attribute__((ext_vector_type(4))); typedef int i32x8_ __attribute__((ext_vector_type(8)));
    int scl8 = 0x7f7f7f7f; asm volatile("" : "+v"(scl8));
    bf16x8 At[4][2], B0[2][2], B1[2][2]; i32x8_ At8[4], B08[2], B18[2];
    const char* cA = (const char*)g.A + (GATHER ? (size_t)0 : (size_t)cur.pm * tstepA); const char* cB = (const char*)g.Bt + S.bofs(cur) + (size_t)cur.pn * tstepB;
    if constexpr (GATHER) { _Pragma("unroll") for (int i_ = 0; i_ < 2; ++i_) { int R_, C_; stage_rc(tid * 16 + i_ * 8192, R_, C_); cb2[i_] = (unsigned)C_ * 2u; } }
    PG8_GOFF(oc, cur); bool last_ = false;
    PG8_STAGE(PG8_SB(0, 0), cB, voffB); PG8_STAGE(PG8_SB(0, 1), cB + hstepB, voffB); PG8_STAGE_A(PG8_SA(0, 0), cA, 0, false); PG8_STAGE_A(PG8_SA(0, 1), cA, 1, false);
    if (wr == 1) PG8_BAR;
    PG8_WAIT_V(2); PG8_BAR;
    PG8_STAGE(PG8_SB(1, 0), cB + kstep, voffB); PG8_STAGE_A(PG8_SA(1, 0), cA + kstep, 0, false); PG8_STAGE(PG8_SB(1, 1), cB + hstepB + kstep, voffB);
    PG8_WAIT_V(6); PG8_BAR;
    for (;;) {
        const bool has_next = S.next(ui + 1, nxt);
        if (has_next) PG8_GOFF(on, nxt); else { if constexpr (GATHER) { on[0] = oc[0]; on[1] = oc[1]; } }
        const char* nA = (has_next && !GATHER) ? (const char*)g.A + (size_t)nxt.pm * tstepA : cA; const char* nB = has_next ? (const char*)g.Bt + S.bofs(nxt) + (size_t)nxt.pn * tstepB : cB;
        const int nte = (PROBE == 20) ? 2 * nt : nt;
#define PG8_KT(x) (((x) >= nt) ? (x) - nt : (x))
#pragma unroll 1
        for (int t = 0; t < nte; t += 2) {
            const bool last = (t == nte - 2); last_ = last;
            asm volatile("" : "+v"(voffA[0]), "+v"(voffA[1]), "+v"(voffB[0]), "+v"(voffB[1]));
            const char* a1 = cA + (size_t)PG8_KT(t + 1) * kstep;
            const char* a2 = last ? nA : cA + (size_t)PG8_KT(t + 2) * kstep; const char* b2 = last ? nB : cB + (size_t)PG8_KT(t + 2) * kstep;
            const char* a3 = a2 + kstep; const char* b3 = b2 + kstep;
            PG8_LDB(B0, 0, 0); PG8_LDB(B1, 0, 1); PG8_SCHED; PG8_LDA(At, 0, 0); PG8_STAGE_A(PG8_SA(1, 1), a1, 1, false);
            PG8_WAIT_V(8); PG8_WAIT_L(0); PG8_BAR; PG8_MMA(0, 0, At, B0); PG8_MMA(0, 1, At, B1); PG8_BAR; PG8_SCHED;
            PG8_LDA(At, 0, 1); PG8_STAGE(PG8_SB(0, 0), b2, voffB); PG8_STAGE(PG8_SB(0, 1), b2 + hstepB, voffB); PG8_STAGE_A(PG8_SA(0, 0), a2, 0, true);
            PG8_WAIT_V(8); PG8_WAIT_L(0); PG8_BAR; PG8_MMA(1, 0, At, B0); PG8_MMA(1, 1, At, B1); PG8_BAR; PG8_SCHED;
            PG8_LDB(B0, 1, 0); PG8_LDB(B1, 1, 1); PG8_SCHED; PG8_LDA(At, 1, 0); PG8_STAGE_A(PG8_SA(0, 1), a2, 1, true);
            PG8_WAIT_V(8); PG8_WAIT_L(0); PG8_BAR; PG8_MMA(0, 0, At, B0); PG8_MMA(0, 1, At, B1); PG8_BAR; PG8_SCHED;
            PG8_LDA(At, 1, 1); PG8_STAGE(PG8_SB(1, 0), b3, voffB); PG8_STAGE(PG8_SB(1, 1), b3 + hstepB, voffB); PG8_STAGE_A(PG8_SA(1, 0), a3, 0, true);
            PG8_WAIT_V(8); PG8_WAIT_L(0); PG8_BAR; PG8_MMA(1, 0, At, B0); PG8_MMA(1, 1, At, B1); PG8_BAR; PG8_SCHED;
        }
        if constexpr (FP8) asm volatile("s_nop 15\n\ts_nop 15" ::: "memory");
        if constexpr (ALIGN_EPI) { if (wr == 0) PG8_BAR; }
        if (PROBE == 20) {
#pragma unroll
            for (int a = 0; a < 2; ++a)
#pragma unroll
                for (int b = 0; b < 2; ++b)
#pragma unroll
                    for (int m = 0; m < 4; ++m)
#pragma unroll
                        for (int n = 0; n < 2; ++n) acc[a][b][m][n] = acc[a][b][m][n] * 0.5f; }
        _Pragma("unroll 1") for (int rep_ = 0; rep_ < (PROBE == 21 ? 2 : 1); ++rep_) { E(acc, cur, wr, wc, fr, fq); if (PROBE == 21) asm volatile("" ::: "memory"); }
        if (!has_next) break;
#pragma unroll
        for (int a = 0; a < 2; ++a)
#pragma unroll
            for (int b = 0; b < 2; ++b)
#pragma unroll
                for (int m = 0; m < 4; ++m)
#pragma unroll
                    for (int n = 0; n < 2; ++n) acc[a][b][m][n] = (f32x4){0.f, 0.f, 0.f, 0.f};
        cur = nxt; cA = nA; cB = nB; ++ui;
        if constexpr (GATHER) { oc[0] = on[0]; oc[1] = on[1]; }
        if constexpr (ALIGN_EPI) { if (wr == 1) PG8_BAR; }
    }
    PG8_WAIT_V(0);
    if constexpr (!ALIGN_EPI) { if (wr == 0) PG8_BAR; }
    PG8_BAR;
#undef PG8_KT
#undef PG8_GOFF
#undef PG8_STAGE_A
#undef PG8_SA
#undef PG8_SB
#undef PG8_STAGE
#undef PG8_LDA
#undef PG8_LDB
#undef PG8_MMA
#undef PG8_WAIT_V
#undef PG8_WAIT_L
#undef PG8_BAR
#undef PG8_SCHED
}
}

namespace att {
constexpr int NW = 8, QBLK = 32, KVBLK = 64;
constexpr float THR = 11.5f;
constexpr size_t SHM_V = 16384, SHM_K = 16384;
constexpr size_t OFF_RAW = 101120, OFF_R32 = OFF_RAW + 2048 * 4;
constexpr size_t OFF_V = 0, OFF_K = 3 * SHM_V, OFF_WS = OFF_K + 2 * SHM_K, OFF_POS = OFF_WS + NW * 64 * 4, OFF_NCL = OFF_POS + SEQ * 4, OFF_ZER = OFF_NCL + SEQ * 4, OFF_EXT = OFF_ZER + 256, ATT_LDS = OFF_EXT + 512;
static_assert(ATT_LDS == 101120, "attention LDS layout");
#define KSWZ(row, colB) ((row) * 256 + ((colB) ^ (((row) & 15) << 4)))
#define SBAR() __builtin_amdgcn_sched_barrier(0)
__device__ __forceinline__ int crow(int r, int hi) { return (r & 3) + 8 * (r >> 2) + 4 * hi; }
__device__ __forceinline__ unsigned cvtpk(float lo, float hi) { return cvt_pk_bf16(lo, hi); }
__device__ __forceinline__ unsigned char cvt_fp8_1(float v) { v = __builtin_amdgcn_fmed3f(v, -448.0f, 448.0f); return (unsigned char)(__builtin_amdgcn_cvt_pk_fp8_f32(v, v, 0, false) & 0xff); }

__device__ __forceinline__ void partialSM(f32x16& p0, f32x16& p1, float& m_reg, float& mn, float& alpha) {
  float pmax = p0[0];
#pragma unroll
  for (int r = 1; r < 16; ++r) pmax = fmaxf(pmax, p0[r]);
#pragma unroll
  for (int r = 0; r < 16; ++r) pmax = fmaxf(pmax, p1[r]);
  { auto rr = __builtin_amdgcn_permlane32_swap(__float_as_uint(pmax), __float_as_uint(pmax), false, false);
    pmax = fmaxf(__uint_as_float(rr[0]), __uint_as_float(rr[1])); }
  if (__builtin_expect(__all(pmax - m_reg <= THR), 1)) { mn = m_reg; alpha = 1.f; }
  else { mn = fmaxf(m_reg, pmax); alpha = __builtin_amdgcn_exp2f(m_reg - mn); m_reg = mn; }
#pragma unroll
  for (int r = 0; r < 16; ++r) p0[r] = p0[r] - mn;
#pragma unroll
  for (int r = 0; r < 16; ++r) p1[r] = p1[r] - mn;
#pragma unroll
  for (int r = 0; r < 16; ++r) p0[r] = __builtin_amdgcn_exp2f(p0[r]);
}
__device__ __forceinline__ bool partialSM_adj(f32x16& p0, f32x16& p1, float& m_reg, float& mn, float& alpha, float radj, float skip_th) {
  float pmax = p0[0];
#pragma unroll
  for (int r = 1; r < 16; ++r) pmax = fmaxf(pmax, p0[r]);
#pragma unroll
  for (int r = 0; r < 16; ++r) pmax = fmaxf(pmax, p1[r]);
  { auto rr = __builtin_amdgcn_permlane32_swap(__float_as_uint(pmax), __float_as_uint(pmax), false, false);
    pmax = fmaxf(__uint_as_float(rr[0]), __uint_as_float(rr[1])); }
  pmax += radj;
  if (__all(pmax < m_reg - skip_th)) { mn = m_reg; alpha = 1.f; return true; }
  if (__builtin_expect(__all(pmax - m_reg <= THR), 1)) { mn = m_reg; alpha = 1.f; }
  else { mn = fmaxf(m_reg, pmax); alpha = __builtin_amdgcn_exp2f(m_reg - mn); m_reg = mn; }
  const float off = mn - radj;
#pragma unroll
  for (int r = 0; r < 16; ++r) p0[r] = p0[r] - off;
#pragma unroll
  for (int r = 0; r < 16; ++r) p1[r] = p1[r] - off;
#pragma unroll
  for (int r = 0; r < 16; ++r) p0[r] = __builtin_amdgcn_exp2f(p0[r]);
  return false;
}
__device__ __forceinline__ void partialSM_rel(f32x16& p0, f32x16& p1, float& m_reg, f32x16& negm, float& alpha, bool first) {
  float pmax = p0[0];
#pragma unroll
  for (int r = 1; r < 16; ++r) pmax = fmaxf(pmax, p0[r]);
#pragma unroll
  for (int r = 0; r < 16; ++r) pmax = fmaxf(pmax, p1[r]);
  { auto rr = __builtin_amdgcn_permlane32_swap(__float_as_uint(pmax), __float_as_uint(pmax), false, false);
    pmax = fmaxf(__uint_as_float(rr[0]), __uint_as_float(rr[1])); }
  if (__builtin_expect(!first && __all(pmax <= THR), 1)) { alpha = 1.f; }
  else { const float dl = first ? pmax : fmaxf(pmax, 0.f); m_reg += dl; alpha = first ? 0.f : __builtin_amdgcn_exp2f(-dl);
#pragma unroll
    for (int r = 0; r < 16; ++r) { p0[r] -= dl; p1[r] -= dl; }
#pragma unroll
    for (int r = 0; r < 16; ++r) negm[r] = -m_reg;
    asm volatile("" : "+v"(negm)); }
#pragma unroll
  for (int r = 0; r < 16; ++r) p0[r] = __builtin_amdgcn_exp2f(p0[r]);
}
__device__ __forceinline__ void finishSM(f32x16& p0, f32x16& p1, float alpha, float& l_reg, bf16x8& pa0, bf16x8& pa1, bf16x8& pa2, bf16x8& pa3) {
#pragma unroll
  for (int r = 0; r < 16; ++r) p1[r] = __builtin_amdgcn_exp2f(p1[r]);
  float ps = 0;
#pragma unroll
  for (int r = 0; r < 16; ++r) ps += p0[r];
#pragma unroll
  for (int r = 0; r < 16; ++r) ps += p1[r];
  { auto rr = __builtin_amdgcn_permlane32_swap(__float_as_uint(ps), __float_as_uint(ps), false, false);
    ps = __uint_as_float(rr[0]) + __uint_as_float(rr[1]); }
  l_reg = l_reg * alpha + ps;
#define PK4(P, BASE, OUT) do { unsigned a0 = cvtpk(P[BASE + 0], P[BASE + 1]), a1 = cvtpk(P[BASE + 2], P[BASE + 3]);   \
    unsigned b0 = cvtpk(P[BASE + 4], P[BASE + 5]), b1 = cvtpk(P[BASE + 6], P[BASE + 7]);                              \
    auto r0 = __builtin_amdgcn_permlane32_swap(a0, b0, false, false); auto r1 = __builtin_amdgcn_permlane32_swap(a1, b1, false, false); \
    u32x4 w = {r0[0], r1[0], r0[1], r1[1]}; OUT = *reinterpret_cast<bf16x8*>(&w); } while (0)
  PK4(p0, 0, pa0); PK4(p0, 8, pa1); PK4(p1, 0, pa2); PK4(p1, 8, pa3);
#undef PK4
}
template <int NQK> __device__ __forceinline__ void qkt(f32x16& p0, f32x16& p1, const char* Ks, const bf16x8* qr, int r32, int hi, int colb0) {
#pragma unroll
  for (int d0 = 0; d0 < NQK; ++d0) { const int cb = colb0 + (d0 * 16 + hi * 8) * 2;
    bf16x8 b0 = *reinterpret_cast<const bf16x8*>(Ks + KSWZ(r32, cb));
    bf16x8 b1 = *reinterpret_cast<const bf16x8*>(Ks + KSWZ(32 + r32, cb));
    p0 = __builtin_amdgcn_mfma_f32_32x32x16_bf16(b0, qr[d0], p0, 0, 0, 0);
    p1 = __builtin_amdgcn_mfma_f32_32x32x16_bf16(b1, qr[d0], p1, 0, 0, 0); }
}
template <int NCB> __device__ __forceinline__ int v_st(int k, int c) { const int kk = (k & ~0xC) | ((k & 4) << 1) | ((k & 8) >> 1); return ((kk >> 3) * NCB + (c >> 5)) * 512 + ((kk & 7) * 32 + (c & 31)) * 2; }
__device__ __forceinline__ int v_rd_base(int lane) { return ((lane & 3) << 3) | (((lane >> 2) & 3) << 6) | (((lane >> 4) & 1) << 5) | (((lane >> 5) & 1) << 8); }
template <int NCB> constexpr int v_rd_off(int d0, int ks, int half) { return d0 * 512 + (2 * ks + half) * NCB * 512; }
template <int OFF> __device__ __forceinline__ s16x4 tr_read(int vb) { s16x4 r; asm volatile("ds_read_b64_tr_b16 %0, %1 offset:%2" : "=&v"(r) : "v"(vb), "i"(OFF) : "memory"); return r; }
template <int NCB, int D0> __device__ __forceinline__ void pv_one(f32x16& od, int vb, bf16x8 pa0, bf16x8 pa1, bf16x8 pa2, bf16x8 pa3) {
  const s16x4 l0 = tr_read<v_rd_off<NCB>(D0, 0, 0)>(vb), h0 = tr_read<v_rd_off<NCB>(D0, 0, 1)>(vb), l1 = tr_read<v_rd_off<NCB>(D0, 1, 0)>(vb), h1 = tr_read<v_rd_off<NCB>(D0, 1, 1)>(vb);
  const s16x4 l2 = tr_read<v_rd_off<NCB>(D0, 2, 0)>(vb), h2 = tr_read<v_rd_off<NCB>(D0, 2, 1)>(vb), l3 = tr_read<v_rd_off<NCB>(D0, 3, 0)>(vb), h3 = tr_read<v_rd_off<NCB>(D0, 3, 1)>(vb);
  asm volatile("s_waitcnt lgkmcnt(0)" ::: "memory"); SBAR();
#define PK(L, H) (bf16x8){L[0], L[1], L[2], L[3], H[0], H[1], H[2], H[3]}
  od = __builtin_amdgcn_mfma_f32_32x32x16_bf16(pa0, PK(l0, h0), od, 0, 0, 0);
  od = __builtin_amdgcn_mfma_f32_32x32x16_bf16(pa1, PK(l1, h1), od, 0, 0, 0);
  od = __builtin_amdgcn_mfma_f32_32x32x16_bf16(pa2, PK(l2, h2), od, 0, 0, 0);
  od = __builtin_amdgcn_mfma_f32_32x32x16_bf16(pa3, PK(l3, h3), od, 0, 0, 0);
#undef PK
}
template <int NCB> __device__ __forceinline__ void pv_all(f32x16* o, int vb, bf16x8 pa0, bf16x8 pa1, bf16x8 pa2, bf16x8 pa3) {
  pv_one<NCB, 0>(o[0], vb, pa0, pa1, pa2, pa3); pv_one<NCB, 1>(o[1], vb, pa0, pa1, pa2, pa3);
  if constexpr (NCB == 4) { pv_one<NCB, 2>(o[2], vb, pa0, pa1, pa2, pa3); pv_one<NCB, 3>(o[3], vb, pa0, pa1, pa2, pa3); }
}
__device__ __forceinline__ void alibi(f32x16& p0, f32x16& p1, const float* cl, int k0, int hi, float rl) {
  const float* pk = cl + k0 + 4 * hi;
#pragma unroll
  for (int g = 0; g < 4; ++g) { const f32x4 a = *(const f32x4*)(pk + 8 * g), b = *(const f32x4*)(pk + 32 + 8 * g);
#pragma unroll
    for (int i = 0; i < 4; ++i) { p0[4 * g + i] -= fabsf(rl - a[i]); p1[4 * g + i] -= fabsf(rl - b[i]); } }
}
__device__ __forceinline__ void load_c(f32x16& p0, f32x16& p1, const float* cp, int hi) {
  const float* pk = cp + 4 * hi;
#pragma unroll
  for (int g = 0; g < 4; ++g) { const f32x4 a = *(const f32x4*)(pk + 8 * g), b = *(const f32x4*)(pk + 32 + 8 * g);
#pragma unroll
    for (int i = 0; i < 4; ++i) { p0[4 * g + i] = a[i]; p1[4 * g + i] = b[i]; } }
}

__device__ __forceinline__ float wmin64(float v) { v = fminf(v, swz_xor<1>(v)); v = fminf(v, swz_xor<2>(v)); v = fminf(v, swz_xor<4>(v)); v = fminf(v, swz_xor<8>(v)); v = fminf(v, swz_xor<16>(v));
  auto rr = __builtin_amdgcn_permlane32_swap(__float_as_uint(v), __float_as_uint(v), false, false); return fminf(__uint_as_float(rr[0]), __uint_as_float(rr[1])); }
__device__ __forceinline__ float wmax64(float v) { v = fmaxf(v, swz_xor<1>(v)); v = fmaxf(v, swz_xor<2>(v)); v = fmaxf(v, swz_xor<4>(v)); v = fmaxf(v, swz_xor<8>(v)); v = fmaxf(v, swz_xor<16>(v));
  auto rr = __builtin_amdgcn_permlane32_swap(__float_as_uint(v), __float_as_uint(v), false, false); return fmaxf(__uint_as_float(rr[0]), __uint_as_float(rr[1])); }
constexpr float SKIP_TH = 20.f;
struct DiffArgs { const int* pos; float sl; float lam; float oscale; const float* ng; float kmax2; };

__device__ __forceinline__ void diff_pos_setup(const int* __restrict__ pos, char* lds, int tid) {
  float* rawp = (float*)(lds + OFF_RAW); float* r32t = (float*)(lds + OFF_R32);
  const int p0 = pos[0];
  for (int i = tid; i < SEQ; i += NW * 64) { const float v = (float)(pos[i] - p0); rawp[i] = v;
    float mn = v, mx = v;
    mn = fminf(mn, swz_xor<1>(mn)); mn = fminf(mn, swz_xor<2>(mn)); mn = fminf(mn, swz_xor<4>(mn)); mn = fminf(mn, swz_xor<8>(mn)); mn = fminf(mn, swz_xor<16>(mn));
    mx = fmaxf(mx, swz_xor<1>(mx)); mx = fmaxf(mx, swz_xor<2>(mx)); mx = fmaxf(mx, swz_xor<4>(mx)); mx = fmaxf(mx, swz_xor<8>(mx)); mx = fmaxf(mx, swz_xor<16>(mx));
    if ((tid & 31) == 0) { r32t[i >> 5] = mn; r32t[64 + (i >> 5)] = mx; } }
  __syncthreads();
}
template <bool DIFF>
__device__ __forceinline__ void attn_unit(const bf16_t* __restrict__ Qb, const bf16_t* __restrict__ Kh, const bf16_t* __restrict__ Vh, unsigned char* __restrict__ Ob, int q0, const DiffArgs da, char* lds, LAS unsigned char* ldsl, int tid_in) {
  constexpr int LDQ = DIFF ? 1024 : 768, LDK = DIFF ? 1024 : 768, LDV = DIFF ? 1024 : 512, LDO = DIFF ? 1024 : 512;
  constexpr int NQK = DIFF ? 4 : 6, NDV = DIFF ? 4 : 2, KCH = DIFF ? 16 : 12, NVP = DIFF ? 2 : 1;
  int tid_ = tid_in; asm volatile("" : "+v"(tid_));
  const int tid = tid_, wid = __builtin_amdgcn_readfirstlane(tid >> 6), lane = tid & 63, r32 = lane & 31, hi = lane >> 5;
  const int mp = DIFF ? (wid >> 2) : 0, wrow = DIFF ? (wid & 3) * QBLK : wid * QBLK;
  char* V_lds = lds + OFF_V; char* K_lds = lds + OFF_K;
  float* ws = (float*)(lds + OFF_WS) + wid * 64; float* li_l = ws; float* al_l = ws + 32;
  float* posl = (float*)(lds + OFF_POS);
  float* ncl = (float*)(lds + OFF_NCL); float* zer = (float*)(lds + OFF_ZER);
  float m_reg = DIFF ? -1e30f : 0.f, l_reg = 0; bool first = true; f32x16 o[NDV]; bf16x8 qr[NQK];
#pragma unroll
  for (int d = 0; d < NDV; ++d) o[d] = f32x16{};
  unsigned koff[2]; bool kact[2]; unsigned voff[NVP];
#pragma unroll
  for (int i = 0; i < 2; ++i) { const int piece = wid + 8 * i, row = 4 * piece + (lane >> 4), pos = lane & 15, chunk = pos ^ (row & 15); kact[i] = chunk < KCH; koff[i] = (unsigned)(row * LDK + chunk * 8); }
#pragma unroll
  for (int i = 0; i < NVP; ++i) { const int q = (wid + 8 * i) * 64 + lane, st = q >> 5, kkhi = st / NDV, cblk = st % NDV, kk = kkhi * 8 + ((q & 31) >> 2), cc = q & 3;
    const int key = (kk & ~0xC) | ((kk & 4) << 1) | ((kk & 8) >> 1); voff[i] = (unsigned)(key * LDV + cblk * 32 + cc * 8); }
  const int vb0 = (int)(uintptr_t)V_lds + v_rd_base(lane);
  const int kcol0 = mp * 128;
  LAS unsigned char* Kl = ldsl + OFF_K + wid * 1024; LAS unsigned char* Vl = ldsl + OFF_V + wid * 1024;
#define DMA_K(buf, k0) do { _Pragma("unroll") for (int i_ = 0; i_ < 2; ++i_) if (kact[i_]) \
    __builtin_amdgcn_global_load_lds((const unsigned*)(Kh + (size_t)(k0) * LDK + koff[i_]), (LAS unsigned*)(Kl + (buf) * SHM_K + i_ * 8192), 16, 0, 0); } while (0)
#define DMA_V(bufoff, k0) do { _Pragma("unroll") for (int i_ = 0; i_ < NVP; ++i_) \
    __builtin_amdgcn_global_load_lds((const unsigned*)(Vh + (size_t)(k0) * LDV + voff[i_]), (LAS unsigned*)(Vl + (bufoff) + i_ * 8192), 16, 0, 0); } while (0)
#define TILE_BAR() do { asm volatile("s_waitcnt vmcnt(0) lgkmcnt(0)" ::: "memory"); __builtin_amdgcn_s_barrier(); asm volatile("" ::: "memory"); } while (0)
  const bf16_t* Qw = Qb + (long)(wrow + r32) * LDQ + mp * 64 + hi * 8;
#pragma unroll
  for (int d0 = 0; d0 < NQK; ++d0) qr[d0] = *reinterpret_cast<const bf16x8*>(Qw + d0 * 16);
  if constexpr (DIFF) {
    __syncthreads();
    DMA_K(0, ((q0 >> 6) + 0) * KVBLK); DMA_V(0, ((q0 >> 6) + 0) * KVBLK); DMA_K(1, ((q0 >> 6) + 1) * KVBLK); DMA_V((int)SHM_V, ((q0 >> 6) + 1) * KVBLK);
  }
  float pq = 0.f;
  float* ext = (float*)(lds + OFF_EXT);
  float wqmin = 0.f, wqmax = 0.f;
  if constexpr (DIFF) {
    const float* rawp = (const float*)(lds + OFF_RAW); const float* r32t = (const float*)(lds + OFF_R32);
    const float bp = rawp[q0];
    for (int i = tid; i < SEQ; i += NW * 64) { const float c = da.sl * (rawp[i] - bp); posl[i] = c; ncl[i] = -c; }
    if (tid < 64) zer[tid] = 0.f;
    pq = da.sl * (rawp[q0 + wrow + r32] - bp);
    if (wid == 0) { const int t = lane & 31; const float v = (lane < 32) ? fminf(r32t[2 * t], r32t[2 * t + 1]) : fmaxf(r32t[64 + 2 * t], r32t[64 + 2 * t + 1]); ext[lane] = da.sl * (v - bp); }
    { const int g = (q0 + wrow) >> 5; wqmin = da.sl * (r32t[g] - bp); wqmax = da.sl * (r32t[64 + g] - bp); }
    { float qs = 0.f;
#pragma unroll
      for (int d0 = 0; d0 < NQK; ++d0)
#pragma unroll
        for (int e = 0; e < 8; ++e) { const float f = bf2f((bf16_t)qr[d0][e]); qs += f * f; }
      qs = sum_x32(qs); qs = wmax64(qs); if (lane == 0) ext[64 + wid] = qs; }
  }
#define RESC(a) do { if (__any((a) < 1.f)) { if (hi == 0) al_l[r32] = (a); asm volatile("s_waitcnt lgkmcnt(0)" ::: "memory"); \
    _Pragma("unroll") for (int d = 0; d < NDV; ++d) _Pragma("unroll") for (int r = 0; r < 16; ++r) o[d][r] *= al_l[crow(r, hi)]; } } while (0)
  f32x16 negm;
#pragma unroll
  for (int r = 0; r < 16; ++r) negm[r] = 0.f;
#define QK(P0, P1, RADJ, MODE, KBUF, k0) do { \
    if constexpr (DIFF) { const int t_ = (k0) >> 6; const float tmn_ = ext[t_], tmx_ = ext[32 + t_]; \
      const int mode_ = __builtin_amdgcn_readfirstlane((tmx_ <= wqmin) ? 1 : ((tmn_ >= wqmax) ? 2 : 0)); \
      const float* cp_ = mode_ == 0 ? zer : (mode_ == 1 ? posl + (k0) : ncl + (k0)); \
      load_c(P0, P1, cp_, hi); RADJ = mode_ == 1 ? -pq : (mode_ == 2 ? pq : 0.f); MODE = mode_; \
      qkt<NQK>(P0, P1, KBUF, qr, r32, hi, kcol0); \
    } else { P0 = negm; P1 = negm; qkt<NQK>(P0, P1, KBUF, qr, r32, hi, kcol0); } } while (0)
#define PSM(P0, P1, MN, AL, RADJ, MODE, K0, SK) do { if constexpr (DIFF) { if (MODE == 0) alibi(P0, P1, posl, (K0), hi, pq); SK = partialSM_adj(P0, P1, m_reg, MN, AL, RADJ, SKIP_TH); } else { partialSM_rel(P0, P1, m_reg, negm, AL, first); first = false; } } while (0)
  f32x16 pA0, pA1, pB0, pB1; float mnA = 0.f, mnB = 0.f, alA, alB, raA = 0.f, raB = 0.f; int mdA = 0, mdB = 0; bf16x8 pa0, pa1, pa2, pa3; constexpr int NTALL = SEQ / KVBLK;
  int td0 = 0, lo = 0, hiT = NTALL; float Bq = 0.f, qpmin = 0.f, qpmax = 0.f;
  if constexpr (DIFF) {
    __syncthreads();
    td0 = q0 >> 6; qpmin = fminf(ext[td0], ext[td0 + 1]); qpmax = fmaxf(ext[32 + td0], ext[32 + td0 + 1]);
    float q2 = ext[64];
#pragma unroll
    for (int w = 1; w < 8; ++w) q2 = fmaxf(q2, ext[64 + w]);
    Bq = sqrtf(q2 * da.kmax2); td0 = q0 >> 6;
  }
  for (int rg = 0; rg < (DIFF ? 2 : 1); ++rg) {
  int t0 = 0, NT = NTALL;
  if constexpr (DIFF) {
    if (rg == 0) { t0 = td0; NT = 2; }
    else {
      const float mm = wmin64(m_reg); if (lane == 0) ext[72 + wid] = mm; __syncthreads();
      float mmin = ext[72];
#pragma unroll
      for (int w = 1; w < 8; ++w) mmin = fminf(mmin, ext[72 + w]);
      const float thr = Bq - mmin + SKIP_TH;
      { const int t = lane & 31; const float dmin = fmaxf(0.f, fmaxf(ext[t] - qpmax, qpmin - ext[32 + t]));
        const unsigned keep = (unsigned)__ballot(dmin <= thr) | (3u << td0);
        lo = __builtin_ctz(keep); hiT = 32 - __builtin_clz(keep); }
      lo = __builtin_amdgcn_readfirstlane(lo & ~1); hiT = __builtin_amdgcn_readfirstlane((hiT + 1) & ~1);
      t0 = lo; NT = hiT - lo - 2;
    }
    if (NT <= 0) continue;
  }
#define TK(j) ((DIFF && rg == 1 && t0 + (j) >= td0 ? t0 + (j) + 2 : t0 + (j)) * KVBLK)
  int vprev = 0, vcur = (int)SHM_V, vnext = 2 * (int)SHM_V;
  if (!DIFF || rg == 1) {
    __syncthreads();
    DMA_K(0, TK(0)); DMA_V(0, TK(0)); DMA_K(1, TK(1)); DMA_V((int)SHM_V, TK(1)); }
  TILE_BAR();
  bool skA = false, skB = false;
  QK(pA0, pA1, raA, mdA, K_lds, TK(0)); PSM(pA0, pA1, mnA, alA, raA, mdA, TK(0), skA);
  TILE_BAR();
#define ROT() do { const int t_ = vprev; vprev = vcur; vcur = vnext; vnext = t_; } while (0)
  for (int j = 1; j + 1 < NT; j += 2) {
    DMA_K(0, TK(j + 1)); DMA_V(vnext, TK(j + 1));
    SBAR(); QK(pB0, pB1, raB, mdB, K_lds + SHM_K, TK(j));
    if (!skA) { finishSM(pA0, pA1, alA, l_reg, pa0, pa1, pa2, pa3); SBAR();
                pv_all<NDV>(o, vb0 + vprev, pa0, pa1, pa2, pa3); }
    PSM(pB0, pB1, mnB, alB, raB, mdB, TK(j), skB);
    RESC(alB); TILE_BAR(); ROT();
    if (j + 2 < NT) { DMA_K(1, TK(j + 2)); DMA_V(vnext, TK(j + 2)); }
    SBAR(); QK(pA0, pA1, raA, mdA, K_lds, TK(j + 1));
    if (!skB) { finishSM(pB0, pB1, alB, l_reg, pa0, pa1, pa2, pa3); SBAR();
                pv_all<NDV>(o, vb0 + vprev, pa0, pa1, pa2, pa3); }
    PSM(pA0, pA1, mnA, alA, raA, mdA, TK(j + 1), skA);
    RESC(alA); TILE_BAR(); ROT();
  }
  SBAR(); QK(pB0, pB1, raB, mdB, K_lds + SHM_K, TK(NT - 1));
  if (!skA) { finishSM(pA0, pA1, alA, l_reg, pa0, pa1, pa2, pa3); SBAR();
              pv_all<NDV>(o, vb0 + vprev, pa0, pa1, pa2, pa3); }
  PSM(pB0, pB1, mnB, alB, raB, mdB, TK(NT - 1), skB);
  RESC(alB);
  if (!skB) { finishSM(pB0, pB1, alB, l_reg, pa0, pa1, pa2, pa3); SBAR();
              pv_all<NDV>(o, vb0 + vcur, pa0, pa1, pa2, pa3); }
#undef TK
#undef ROT
  }
  if (hi == 0) li_l[r32] = l_reg; asm volatile("s_waitcnt lgkmcnt(0)" ::: "memory");
  float rli[16];
#pragma unroll
  for (int r = 0; r < 16; ++r) rli[r] = __builtin_amdgcn_rcpf(li_l[crow(r, hi)]);
  if constexpr (!DIFF) {
    __syncthreads();
    LAS float* blk = (LAS float*)(ldsl + wid * 9216);
#pragma unroll
    for (int r = 0; r < 16; ++r) { const int orow = crow(r, hi);
#pragma unroll
      for (int d0 = 0; d0 < NDV; ++d0) blk[orow * 72 + d0 * 36 + r32] = o[d0][r] * (rli[r] * O8_SCALE); }
    asm volatile("s_waitcnt lgkmcnt(0)" ::: "memory");
    const int row = lane >> 1, half = lane & 1; const LAS float* rp = blk + row * 72 + half * 36;
    unsigned char* Op = Ob + (long)(wrow + row) * LDO + half * 32;
#pragma unroll
    for (int j4 = 0; j4 < 2; ++j4) { u32x4 w;
#pragma unroll
      for (int k = 0; k < 4; ++k) { const f32x4 y = *(const LAS f32x4*)(rp + 4 * (4 * j4 + k)); w[k] = pack4_fp8(y[0], y[1], y[2], y[3]); }
      *(u32x4*)(Op + 16 * j4) = w; }
  } else {
    __syncthreads();
    LAS float* blk = (LAS float*)(ldsl + (wid & 3) * 17408);
#define BIDX(orow, d0) ((orow) * 136 + ((d0) >> 1) * 68 + ((d0) & 1) * 32 + r32)
    if (mp == 1) {
#pragma unroll
      for (int r = 0; r < 16; ++r) { const int orow = crow(r, hi);
#pragma unroll
        for (int d0 = 0; d0 < 4; ++d0) blk[BIDX(orow, d0)] = o[d0][r] * rli[r]; }
    }
    __syncthreads();
    if (mp == 0) {
#pragma unroll
      for (int r = 0; r < 16; ++r) { const int orow = crow(r, hi);
#pragma unroll
        for (int d0 = 0; d0 < 4; ++d0) { LAS float* p = blk + BIDX(orow, d0); *p = o[d0][r] * rli[r] - da.lam * *p; } }
      asm volatile("s_waitcnt lgkmcnt(0)" ::: "memory");
      const int row = lane >> 1, half = lane & 1; const LAS float* rp = blk + row * 136 + half * 68;
      f32x4 v[16]; float s = 0.f;
#pragma unroll
      for (int j = 0; j < 16; ++j) { v[j] = *(const LAS f32x4*)(rp + 4 * j); s += (v[j][0] * v[j][0] + v[j][1] * v[j][1]) + (v[j][2] * v[j][2] + v[j][3] * v[j][3]); }
      s += swz_xor<1>(s);
      const float sc = da.oscale * O8_SCALE * __builtin_amdgcn_rsqf(s * (1.0f / 128.0f) + RMS_EPS);
      unsigned char* Op = Ob + (long)(wrow + row) * LDO + half * 64;
#pragma unroll
      for (int j4 = 0; j4 < 4; ++j4) { u32x4 w;
#pragma unroll
        for (int k = 0; k < 4; ++k) { const int j = 4 * j4 + k; const f32x4 g = *(const f32x4*)(da.ng + half * 64 + 4 * j); const f32x4 y = v[j] * sc * g; w[k] = pack4_fp8(y[0], y[1], y[2], y[3]); }
        *(u32x4*)(Op + 16 * j4) = w; }
    }
#undef BIDX
  }
#undef DMA_K
#undef DMA_V
#undef TILE_BAR
#undef RESC
#undef QK
#undef PSM
}
#undef KSWZ
#undef SBAR
}

constexpr size_t MiB = 1u << 20;
constexpr size_t WS_CTL = 0, CTL_ZERO_BYTES = 1 * MiB;
constexpr size_t WS_MOD = 1 * MiB;
constexpr size_t WS_RSQ = 3 * MiB;
constexpr size_t WS_COS = 6 * MiB;
constexpr size_t WS_SIN = 8 * MiB;
constexpr size_t WS_SEL = 10 * MiB;
constexpr size_t WS_GATE = 10 * MiB + 256 * 1024;
constexpr size_t WS_RMAP = 11 * MiB;
constexpr size_t WS_WMIX = 12 * MiB;
constexpr size_t W_IN = WS_WMIX, W_QUP = W_IN + (size_t)NZ * 1024 * 2, W_KVUP = W_QUP + 768 * 384 * 2, W_BRM = W_KVUP + 1024 * 256 * 2, W_BRD = W_BRM + 1024 * 512 * 2, W_OUT = W_BRD + 1024 * 1024 * 2;
constexpr size_t WS_WFF = 30 * MiB;
constexpr size_t W2_ESTRIDE8 = (size_t)1024 * 2816;
constexpr size_t W13_ESTRIDE8 = (size_t)5632 * 1024;
constexpr size_t W13_ESTRIDE = (size_t)5632 * 1024 * 2, W2_ESTRIDE = (size_t)1024 * 2816 * 2, W2_BASE = WS_WFF + 8 * W13_ESTRIDE;
constexpr size_t WS_ACT = 162 * MiB;
constexpr size_t WS_H = WS_ACT;
constexpr size_t WS_LAT = WS_H + 64 * MiB;
constexpr size_t WS_ZB = WS_LAT + 48 * MiB;
constexpr size_t WS_QM = WS_ZB + 320 * MiB;
constexpr size_t WS_KM = WS_QM + 48 * MiB;
constexpr size_t WS_VM = WS_KM + 48 * MiB;
constexpr size_t WS_OM = WS_VM + 32 * MiB;
constexpr size_t WS_END = WS_OM + 32 * MiB;
constexpr size_t WS_PRE = WS_QM;
constexpr size_t WS_PART = WS_QM;
constexpr size_t WS_T1 = WS_ZB + 64 * MiB;
constexpr size_t WS_MB = WS_ZB + 128 * MiB;
constexpr size_t WS_DO8 = WS_ZB + 224 * MiB;
constexpr size_t WS_U = WS_LAT;
constexpr size_t WS_XB = WS_LAT;
constexpr size_t WS_Y = WS_LAT;
constexpr size_t WS_UM = WS_LAT + 132 * MiB;
static_assert(WS_UM + (size_t)67584 * 2816 * 2 <= WS_END + 64 * MiB, "ws map");
constexpr size_t WS_WIN8 = WS_END + 96 * MiB;
constexpr size_t WS_H8 = WS_OM;
constexpr size_t WS_XRES = WS_END + 16 * MiB;
constexpr size_t WS_NEED = WS_END + 104 * MiB;
constexpr int CW_BAR = 4096;
constexpr int CW_CNT = 8192;
constexpr int CW_CUR = 8192 + 256;
constexpr int CW_KMAX = 16384;

constexpr int RING_BYTES = 131072, LDSCTL_OFF = RING_BYTES, MISC_OFF = LDSCTL_OFF + 320, LDS_BYTES = 147456;
constexpr int NWAVES = 8;

#define XB_TMO      128
#define XB_XCNT(j)  (256  + 64 * (j))
#define XB_XSUB(j)  (1280 + 64 * (j))
#define XB_XGEN(j)  (2304 + 64 * (j))
#define XB_TOP      3328
#define XB_TOPGEN   3392
#define XCD_BAR_WORDS 3456
#define XB_SPIN_CAP (1u << 18)
__device__ __forceinline__ unsigned xb_ld(unsigned* p)              { return __hip_atomic_load(p, __ATOMIC_RELAXED, __HIP_MEMORY_SCOPE_AGENT); }
__device__ __forceinline__ unsigned xb_add(unsigned* p, unsigned v) { return __hip_atomic_fetch_add(p, v, __ATOMIC_RELAXED, __HIP_MEMORY_SCOPE_AGENT); }
__device__ __forceinline__ unsigned xb_xcc_id() { return (unsigned)__builtin_amdgcn_s_getreg((3 << 11) | 20) & 0xFu; }
#define XB_SPIN(cond, bar) do { unsigned _sp = 0; while (cond) { __builtin_amdgcn_s_sleep(1); \
    if ((++_sp & 255u) == 0u) { if (xb_ld(&(bar)[XB_TMO])) break; if (_sp > XB_SPIN_CAP) { atomicAdd(&(bar)[XB_TMO], 1u); break; } } } } while (0)
struct XcdBarrier { unsigned* bar; unsigned x; volatile LAS unsigned* st; };
__device__ __forceinline__ XcdBarrier xcd_barrier_post(unsigned* bar, volatile LAS unsigned* st, bool leader) {
    XcdBarrier b; b.bar = bar; b.x = xb_xcc_id(); b.st = st;
    if (leader) (void)xb_add(&bar[XB_XCNT(b.x)], 1u);
    return b;
}
__device__ __forceinline__ void xcd_barrier_complete(unsigned* bar, unsigned x, unsigned& nloc, unsigned& nx) {
    const unsigned G = gridDim.x * gridDim.y * gridDim.z;
    unsigned sum, cnt, mine, sp = 0u;
    for (;;) {
        sum = 0u; cnt = 0u; mine = 0u;
#pragma unroll
        for (unsigned j = 0; j < 16; ++j) { const unsigned c = xb_ld(&bar[XB_XCNT(j)]); sum += c; cnt += (c > 0u) ? 1u : 0u; mine = (j == x) ? c : mine; }
        if (sum == G) break;
        __builtin_amdgcn_s_sleep(1);
        if ((++sp & 255u) == 0u) { if (xb_ld(&bar[XB_TMO])) break; if (sp > XB_SPIN_CAP) { atomicAdd(&bar[XB_TMO], 1u); break; } }
    }
    nloc = mine > 0u ? mine : 1u; nx = cnt > 0u ? cnt : 1u;
}
__device__ __forceinline__ void xcd_barrier(const XcdBarrier& b, bool leader) {
    asm volatile("s_waitcnt vmcnt(0)" ::: "memory");
    __syncthreads();
    if (leader) {
        unsigned* bar = b.bar;
        __builtin_amdgcn_s_waitcnt(0);
        unsigned nloc = b.st[0], nx = b.st[1];
        if (nloc == 0u) { xcd_barrier_complete(bar, b.x, nloc, nx); b.st[0] = nloc; b.st[1] = nx; }
        const unsigned old = xb_add(&bar[XB_XSUB(b.x)], 1u);
        const unsigned gen = old / nloc;
        if (old + 1u == (gen + 1u) * nloc) {
            __builtin_amdgcn_fence(__ATOMIC_RELEASE, "agent");
            asm volatile("s_waitcnt vmcnt(0)" ::: "memory");
            const unsigned og = xb_add(&bar[XB_TOP], 1u);
            const unsigned tg = og / nx;
            if (og + 1u == (tg + 1u) * nx) xb_add(&bar[XB_TOPGEN], 1u);
            else XB_SPIN(xb_ld(&bar[XB_TOPGEN]) == tg, bar);
            __builtin_amdgcn_fence(__ATOMIC_ACQUIRE, "agent");
            xb_add(&bar[XB_XGEN(b.x)], 1u);
            asm volatile("s_waitcnt vmcnt(0)" ::: "memory");
        } else {
            XB_SPIN(xb_ld(&bar[XB_XGEN(b.x)]) == gen, bar);
            __builtin_amdgcn_fence(__ATOMIC_ACQUIRE, "agent");
            asm volatile("s_waitcnt vmcnt(0)" ::: "memory");
        }
    }
    __syncthreads();
}

__device__ __forceinline__ float wave_sum(float v) {
    v += swz_xor<1>(v); v += swz_xor<2>(v); v += swz_xor<4>(v); v += swz_xor<8>(v); v += swz_xor<16>(v);
    return sum_x32(v);
}
__device__ __forceinline__ unsigned f2bf(float f) { unsigned u = __builtin_bit_cast(unsigned, f); return (u + 0x7fffu + ((u >> 16) & 1u)) >> 16; }
__device__ __forceinline__ unsigned pk2(float lo, float hi) { return f2bf(lo) | (f2bf(hi) << 16); }

template <class MapF>
__device__ __forceinline__ void transpose_item(const float* W, int N, bf16_t* WT, int ldk, const float* gain, LAS float* scr, int kb, int nb, int lane, MapF map) {
    const int k0 = 64 * kb, n0 = 32 * nb;
    float tv[32];
#pragma unroll
    for (int i = 0; i < 32; ++i) { const int kk = 2 * i + (lane >> 5); tv[i] = W[(size_t)(k0 + kk) * N + n0 + (lane & 31)]; }
#pragma unroll
    for (int i = 0; i < 32; ++i) { const int kk = 2 * i + (lane >> 5); float v = tv[i]; if (gain) v *= gain[k0 + kk]; scr[kk * 33 + (lane & 31)] = v; }
    asm volatile("s_waitcnt lgkmcnt(0)" ::: "memory");
    const int c = lane & 7;
#pragma unroll
    for (int j = 0; j < 4; ++j) { const int n = (lane >> 3) + 8 * j; const LAS float* s = scr + (8 * c) * 33 + n;
        u32x4 o; o.x = pk2(s[0 * 33], s[1 * 33]); o.y = pk2(s[2 * 33], s[3 * 33]); o.z = pk2(s[4 * 33], s[5 * 33]); o.w = pk2(s[6 * 33], s[7 * 33]);
        const int dr = map(n0 + n);
        *(GAS u32x4*)(WT + (size_t)dr * ldk + k0 + 8 * c) = o; }
    asm volatile("s_waitcnt lgkmcnt(0)" ::: "memory");
}
template <class MapF>
__device__ __forceinline__ void transpose_item_fp8(const float* W, int N, unsigned char* WT8, int ldkb, float scale, LAS float* scr, int kb, int nb, int lane, MapF map) {
    const int k0 = 64 * kb, n0 = 32 * nb;
    float tv[32];
#pragma unroll
    for (int i = 0; i < 32; ++i) { const int kk = 2 * i + (lane >> 5); tv[i] = W[(size_t)(k0 + kk) * N + n0 + (lane & 31)]; }
#pragma unroll
    for (int i = 0; i < 32; ++i) { const int kk = 2 * i + (lane >> 5); scr[kk * 33 + (lane & 31)] = tv[i] * scale; }
    asm volatile("s_waitcnt lgkmcnt(0)" ::: "memory");
    const int c = lane & 7;
#pragma unroll
    for (int j = 0; j < 4; ++j) { const int n = (lane >> 3) + 8 * j; const LAS float* sp = scr + (8 * c) * 33 + n;
        u32x2 o; o.x = pack4_fp8(sp[0 * 33], sp[1 * 33], sp[2 * 33], sp[3 * 33]); o.y = pack4_fp8(sp[4 * 33], sp[5 * 33], sp[6 * 33], sp[7 * 33]);
        const int dr = map(n0 + n);
        *(GAS u32x2*)(WT8 + (size_t)dr * ldkb + k0 + 8 * c) = o; }
    asm volatile("s_waitcnt lgkmcnt(0)" ::: "memory");
}
__host__ __device__ __forceinline__ int rope_virt(int rho) { const int n = rho >> 4, fq = (rho & 15) >> 2, i = rho & 3; return 8 * fq + 4 * n + i; }
struct MapIn  { __device__ __forceinline__ int operator()(int n) const { if (n < 384) return n; if (n < 640) return n + 128; if (n < 672) return 384 + rope_virt(n - 640); return n + 96; } };
struct MapIn8 { __device__ __forceinline__ int operator()(int n) const { return n + 96 - 2816; } };
struct MapQup { __device__ __forceinline__ int operator()(int n) const { const int h = n / 96, w = n - h * 96; return w < 64 ? n : h * 96 + 64 + rope_virt(w - 64); } };
struct MapId  { __device__ __forceinline__ int operator()(int n) const { return n; } };
struct MapW13 { int half; __device__ __forceinline__ int operator()(int n) const { return 256 * (n >> 7) + 128 * half + (n & 127); } };

struct Args {
    const float* x; const float* c; const int* pos; const float* w_ada; const float* b_ada; const float* w_in; const float* q_norm_g; const float* w_q_up; const float* kv_norm_g; const float* w_kv_up;
    const float* lq1; const float* lk1; const float* lq2; const float* lk2; const float* diff_norm_g; const float* w_br_mla; const float* w_br_diff; const float* w_out;
    const float* ln1_g; const float* ln1_b; const float* ln2_g; const float* ln2_b; const float* ffn_w1; const float* ffn_w3; const float* ffn_w2; const float* router_w; const float* router_b;
    const float* moe_w1; const float* moe_w3; const float* moe_w2;
    float* out; unsigned char* ws; int ph_lo, ph_hi; float lam_init[4];
};

typedef const __attribute__((address_space(4))) Args* KArgP;
__device__ __forceinline__ KArgP kargs() { KArgP p = (KArgP)__builtin_amdgcn_kernarg_segment_ptr(); asm volatile("" : "+s"(p)); return p; }
struct Ctx { LAS unsigned char* lds; int tid, lane, wave, vcu, G; unsigned char* ws; };

__device__ __forceinline__ void cvt_mixer_weights(const Ctx& C, int l) {
    KArgP a = kargs();
    LAS float* scr = (LAS float*)(C.lds + C.wave * 8448);
    const int gw = C.vcu * NWAVES + C.wave, NGW = C.G * NWAVES;
    constexpr int I_IN = 16 * 181, I_QUP = 6 * 24, I_KVUP = 4 * 32, I_BRM = 8 * 32, I_BRD = 16 * 32, I_OUT = 16 * 32;
    constexpr int NIT = I_IN + I_QUP + I_KVUP + I_BRM + I_BRD + I_OUT;
    unsigned char* ws = C.ws;
    for (int it = gw; it < NIT; it += NGW) {
        int r = it;
        if (r < I_IN) { transpose_item_fp8(a->w_in + (size_t)l * 1024 * 5792, 5792, ws + WS_WIN8, 1024, W8_SCALE, scr, r / 181, r % 181, C.lane, MapIn{}); continue; } r -= I_IN;
        if (r < I_QUP) { transpose_item(a->w_q_up + (size_t)l * 384 * 768, 768, (bf16_t*)(ws + W_QUP), 384, a->q_norm_g + l * 384, scr, r / 24, r % 24, C.lane, MapQup{}); continue; } r -= I_QUP;
        if (r < I_KVUP) { transpose_item(a->w_kv_up + (size_t)l * 256 * 1024, 1024, (bf16_t*)(ws + W_KVUP), 256, a->kv_norm_g + l * 256, scr, r / 32, r % 32, C.lane, MapId{}); continue; } r -= I_KVUP;
        if (r < I_BRM) { transpose_item_fp8(a->w_br_mla + (size_t)l * 512 * 1024, 1024, ws + W_BRM, 512, W8_SCALE_BR, scr, r / 32, r % 32, C.lane, MapId{}); continue; } r -= I_BRM;
        if (r < I_BRD) { transpose_item_fp8(a->w_br_diff + (size_t)l * 1024 * 1024, 1024, ws + W_BRD, 1024, W8_SCALE_BR, scr, r / 32, r % 32, C.lane, MapId{}); continue; } r -= I_BRD;
        transpose_item_fp8(a->w_out + (size_t)l * 1024 * 1024, 1024, ws + W_OUT, 1024, W8_SCALE_BR, scr, r / 32, r % 32, C.lane, MapId{});
    }
}
__device__ __forceinline__ void cvt_ffn_weights(const Ctx& C, int l) {
    KArgP a = kargs();
    LAS float* scr = (LAS float*)(C.lds + C.wave * 8448);
    const int gw = C.vcu * NWAVES + C.wave, NGW = C.G * NWAVES;
    constexpr int I_W1 = 16 * 88, I_W2 = 44 * 32, I_E = 2 * I_W1 + I_W2;
    unsigned char* ws = C.ws;
    const bool moe = (l & 1) != 0; const int li = l >> 1;
    const int nE = moe ? NEXP : 1;
    const float* w1 = moe ? a->moe_w1 + (size_t)li * NEXP * 1024 * FF : a->ffn_w1 + (size_t)li * 1024 * FF;
    const float* w3 = moe ? a->moe_w3 + (size_t)li * NEXP * 1024 * FF : a->ffn_w3 + (size_t)li * 1024 * FF;
    const float* w2 = moe ? a->moe_w2 + (size_t)li * NEXP * 1024 * FF : a->ffn_w2 + (size_t)li * 1024 * FF;
    for (int it = gw; it < nE * I_E; it += NGW) {
        const int e = it / I_E; int r = it - e * I_E;
        bf16_t* d13 = (bf16_t*)(ws + WS_WFF + (size_t)e * W13_ESTRIDE);
        const size_t eo = (size_t)e * 1024 * FF;
        if (moe) {
            unsigned char* d8 = ws + WS_WFF + (size_t)e * W13_ESTRIDE8;
            if (r < I_W1) { transpose_item_fp8(w1 + eo, FF, d8, 1024, W8_SCALE, scr, r / 88, r % 88, C.lane, MapW13{0}); continue; } r -= I_W1;
            if (r < I_W1) { transpose_item_fp8(w3 + eo, FF, d8, 1024, W8_SCALE, scr, r / 88, r % 88, C.lane, MapW13{1}); continue; } r -= I_W1;
        } else {
        if (r < I_W1) { transpose_item(w1 + eo, FF, d13, 1024, nullptr, scr, r / 88, r % 88, C.lane, MapW13{0}); continue; } r -= I_W1;
        if (r < I_W1) { transpose_item(w3 + eo, FF, d13, 1024, nullptr, scr, r / 88, r % 88, C.lane, MapW13{1}); continue; } r -= I_W1;
        }
        transpose_item_fp8(w2 + eo, 1024, ws + W2_BASE + (size_t)e * W2_ESTRIDE8, FF, W8_SCALE_W2, scr, r / 32, r % 32, C.lane, MapId{});
    }
}

struct FIn {
    bf16_t* LAT; bf16_t* ZB; bf16_t* KM; float* RSQ; const float* COS; const float* SIN; int cboff; float insc;
    __device__ __forceinline__ float rowscale(int) const { return 1.f; }
    __device__ __forceinline__ void operator()(int row, float rs, int cb, int fq, f32x4 v0, f32x4 v1) const {
        cb += cboff; v0 = v0 * insc; v1 = v1 * insc;
        if (cb < 384 || (cb >= 512 && cb < 768)) {
            *(u32x4*)(LAT + (size_t)row * 768 + cb + 8 * fq) = pack8(v0, v1);
            float ss = (v0[0] * v0[0] + v0[1] * v0[1]) + (v0[2] * v0[2] + v0[3] * v0[3]) + (v1[0] * v1[0] + v1[1] * v1[1]) + (v1[2] * v1[2] + v1[3] * v1[3]);
            ss += swz_xor<16>(ss); ss = sum_x32(ss);
            const int slot = cb < 384 ? (cb >> 5) : 12 + ((cb - 512) >> 5);
            if (fq == 0) RSQ[(size_t)row * 24 + slot] = ss;
        } else if (cb < 416) {
            const f32x4 cs = *(const f32x4*)(COS + (size_t)row * 16 + 4 * fq), sn = *(const f32x4*)(SIN + (size_t)row * 16 + 4 * fq);
            const f32x4 o1 = v0 * cs - v1 * sn, o2 = v0 * sn + v1 * cs;
            const u32x4 w = pack8(o1, o2);
#pragma unroll
            for (int h = 0; h < 8; ++h) *(u32x4*)(KM + (size_t)row * 768 + h * 96 + 64 + 8 * fq) = w;
        } else if (cb >= 768) {
            const int g = (cb - 768) >> 10, c = (cb - 768) & 1023;
            if (g == 0) { v0 = v0 * CQ_DIFF; v1 = v1 * CQ_DIFF; }
            if (g >= 3) {
#pragma unroll
                for (int i = 0; i < 4; ++i) { v0[i] = sigmoidf_(v0[i]); v1[i] = sigmoidf_(v1[i]); }
                u32x2 w8; w8.x = pack4_fp8(v0[0], v0[1], v0[2], v0[3]); w8.y = pack4_fp8(v1[0], v1[1], v1[2], v1[3]);
                *(u32x2*)((unsigned char*)(ZB + (size_t)g * T * 1024) + (size_t)row * 1024 + c + 8 * fq) = w8;
            } else *(u32x4*)(ZB + (size_t)g * T * 1024 + (size_t)row * 1024 + c + 8 * fq) = pack8(v0, v1);
        }
    }
};
struct FQup {
    bf16_t* QM; const float* RSQ; const float* COS; const float* SIN;
    __device__ __forceinline__ float rowscale(int row) const {
        const f32x4 a = *(const f32x4*)(RSQ + (size_t)row * 24), b = *(const f32x4*)(RSQ + (size_t)row * 24 + 4), c = *(const f32x4*)(RSQ + (size_t)row * 24 + 8);
        const float ss = ((a[0] + a[1]) + (a[2] + a[3])) + ((b[0] + b[1]) + (b[2] + b[3])) + ((c[0] + c[1]) + (c[2] + c[3]));
        return CQ_MLA * __builtin_amdgcn_rsqf(ss * (1.0f / 384.0f) + RMS_EPS); }
    __device__ __forceinline__ void operator()(int row, float r, int cb, int fq, f32x4 v0, f32x4 v1) const {
        v0 = v0 * r; v1 = v1 * r;
        if ((cb % 96) == 64) {
            const f32x4 cs = *(const f32x4*)(COS + (size_t)row * 16 + 4 * fq), sn = *(const f32x4*)(SIN + (size_t)row * 16 + 4 * fq);
            const f32x4 o1 = v0 * cs - v1 * sn, o2 = v0 * sn + v1 * cs; v0 = o1; v1 = o2;
        }
        *(u32x4*)(QM + (size_t)row * 768 + cb + 8 * fq) = pack8(v0, v1);
    }
};
struct FKVup {
    bf16_t* KM; bf16_t* VM; const float* RSQ;
    __device__ __forceinline__ float rowscale(int row) const {
        const f32x4 a = *(const f32x4*)(RSQ + (size_t)row * 24 + 12), b = *(const f32x4*)(RSQ + (size_t)row * 24 + 16);
        const float ss = ((a[0] + a[1]) + (a[2] + a[3])) + ((b[0] + b[1]) + (b[2] + b[3]));
        return __builtin_amdgcn_rsqf(ss * (1.0f / 256.0f) + RMS_EPS); }
    __device__ __forceinline__ void operator()(int row, float r, int cb, int fq, f32x4 v0, f32x4 v1) const {
        v0 = v0 * r; v1 = v1 * r;
        const int h = cb >> 7, w = cb & 127;
        if (w < 64) *(u32x4*)(KM + (size_t)row * 768 + h * 96 + w + 8 * fq) = pack8(v0, v1);
        else *(u32x4*)(VM + (size_t)row * 512 + h * 64 + (w - 64) + 8 * fq) = pack8(v0, v1);
    }
};
struct FBr1 {
    bf16_t* T1; const bf16_t* SA;
    __device__ __forceinline__ float rowscale(int) const { return 1.f; }
    __device__ __forceinline__ void operator()(int row, float rs, int cb, int fq, f32x4 v0, f32x4 v1) const {
        const size_t o = (size_t)row * 1024 + cb + 8 * fq; f32x4 s0, s1; unpack8(*(const u32x4*)(SA + o), s0, s1);
        *(u32x4*)(T1 + o) = pack8(v0 * s0, v1 * s1);
    }
};
struct FBr2 {
    bf16_t* MB; const bf16_t* T1; const bf16_t* SB;
    __device__ __forceinline__ float rowscale(int) const { return 1.f; }
    __device__ __forceinline__ void operator()(int row, float rs, int cb, int fq, f32x4 v0, f32x4 v1) const {
        const size_t o = (size_t)row * 1024 + cb + 8 * fq; f32x4 s0, s1, t0, t1; unpack8(*(const u32x4*)(SB + o), s0, s1); unpack8(*(const u32x4*)(T1 + o), t0, t1);
        *(u32x4*)(MB + o) = pack8(t0 + v0 * s0, t1 + v1 * s1);
    }
};
struct FRes {
    float* PRE; const float* X; const float* gate;
    __device__ __forceinline__ float rowscale(int) const { return 1.f; }
    __device__ __forceinline__ void operator()(int row, float rs, int cb, int fq, f32x4 v0, f32x4 v1) const {
        const int b = row >> 11; const float* gp = gate + (size_t)b * 6144 + cb + 4 * fq;
        const size_t o = (size_t)row * 1024 + cb + 4 * fq;
        const f32x4 g0 = *(const f32x4*)gp, g1 = *(const f32x4*)(gp + 16), x0 = *(const f32x4*)(X + o), x1 = *(const f32x4*)(X + o + 16);
        *(f32x4*)(PRE + o) = x0 * ALPHA + g0 * v0; *(f32x4*)(PRE + o + 16) = x1 * ALPHA + g1 * v1;
    }
};
struct FMoeOut {
    bf16_t* Y; const int* RMAP;
    __device__ __forceinline__ float rowscale(int) const { return 1.f; }
    __device__ __forceinline__ void operator()(int row, float rs, int cb, int fq, f32x4 v0, f32x4 v1) const {
        const int s = RMAP[row];
        if (s >= 0) *(u32x4*)(Y + (size_t)s * 1024 + cb + 8 * fq) = pack8(v0, v1);
    }
};

template <int MODE, bool ROUTE>
__device__ __forceinline__ void ln_phase(const Ctx& C, unsigned char* H8, const bf16_t* XIN, const bf16_t* G, bf16_t* XB, float* OUT32, bf16_t* H, const float* lng, const float* lnb, const float* sc, const float* sh,
                                         const bf16_t* Y, const float* GATE, const float* g2, const float* rw, const float* rb, int* SEL, float* GOUT, unsigned* CNT) {
    int lane_ = C.lane; asm volatile("" : "+v"(lane_)); const int lane = lane_; const int wg = blockIdx.x; const int b = (wg * 128) >> 11;
    f32x4 vg[4], vb[4], vsc[4], vsh[4], vg2[4];
#pragma unroll
    for (int j = 0; j < 4; ++j) { const int c = 4 * lane + 256 * j; vg[j] = *(const f32x4*)(lng + c); vb[j] = *(const f32x4*)(lnb + c);
        if (sc) { vsc[j] = *(const f32x4*)(sc + (size_t)b * 6144 + c) + 1.0f; vsh[j] = *(const f32x4*)(sh + (size_t)b * 6144 + c); }
        vg2[j] = *(const f32x4*)(g2 + (size_t)b * 6144 + c); }
    LAS float* rwl = (LAS float*)C.lds;
    LAS unsigned* hist = (LAS unsigned*)(C.lds + 32768);
    if (ROUTE) { for (int i = C.tid; i < 8192; i += NWAVES * 64) rwl[(i & 7) * 1024 + (i >> 3)] = rw[i]; if (C.tid < 8) hist[C.tid] = 0u; __syncthreads(); }
    for (int rr = 0; rr < 8; ++rr) {
        u32x2 vv[2][4], rya[2][4], ryb[2][4]; float rga[2], rgb[2];
#pragma unroll
        for (int h2 = 0; h2 < 2; ++h2) { const int row = wg * 128 + C.wave * 16 + rr + 8 * h2;
            if (MODE == 0) {
#pragma unroll
                for (int j = 0; j < 4; ++j) { const int c = 4 * lane + 256 * j; vv[h2][j] = *(const u32x2*)(XIN + (size_t)row * 1024 + c); rya[h2][j] = *(const u32x2*)(G + (size_t)row * 1024 + c); }
            } else {
                rga[h2] = GATE[2 * row]; rgb[h2] = GATE[2 * row + 1];
#pragma unroll
                for (int j = 0; j < 4; ++j) { const int c = 4 * lane + 256 * j; vv[h2][j] = *(const u32x2*)(XB + (size_t)row * 1024 + c);
                    rya[h2][j] = *(const u32x2*)(Y + (size_t)(2 * row) * 1024 + c); ryb[h2][j] = *(const u32x2*)(Y + (size_t)(2 * row + 1) * 1024 + c); }
            } }
#pragma unroll
      for (int h2 = 0; h2 < 2; ++h2) { const int row = wg * 128 + C.wave * 16 + rr + 8 * h2;
        f32x4 v[4];
        if (MODE == 0) {
#pragma unroll
            for (int j = 0; j < 4; ++j) { const u32x2 ya = rya[h2][j], xw = vv[h2][j]; f32x4 fa, xv; fa[0] = __uint_as_float(ya.x << 16); fa[1] = __uint_as_float(ya.x & 0xffff0000u); fa[2] = __uint_as_float(ya.y << 16); fa[3] = __uint_as_float(ya.y & 0xffff0000u);
                xv[0] = __uint_as_float(xw.x << 16); xv[1] = __uint_as_float(xw.x & 0xffff0000u); xv[2] = __uint_as_float(xw.y << 16); xv[3] = __uint_as_float(xw.y & 0xffff0000u);
                v[j] = xv * ALPHA + vg2[j] * fa; }
        } else {
            const float ga = rga[h2], gb = rgb[h2];
#pragma unroll
            for (int j = 0; j < 4; ++j) { const u32x2 xw = vv[h2][j]; const u32x2 ya = rya[h2][j], yb = ryb[h2][j];
                f32x4 fa, fb, xv; xv[0] = __uint_as_float(xw.x << 16); xv[1] = __uint_as_float(xw.x & 0xffff0000u); xv[2] = __uint_as_float(xw.y << 16); xv[3] = __uint_as_float(xw.y & 0xffff0000u); fa[0] = __uint_as_float(ya.x << 16); fa[1] = __uint_as_float(ya.x & 0xffff0000u); fa[2] = __uint_as_float(ya.y << 16); fa[3] = __uint_as_float(ya.y & 0xffff0000u);
                fb[0] = __uint_as_float(yb.x << 16); fb[1] = __uint_as_float(yb.x & 0xffff0000u); fb[2] = __uint_as_float(yb.y << 16); fb[3] = __uint_as_float(yb.y & 0xffff0000u);
                v[j] = xv * ALPHA + vg2[j] * (fa * ga + fb * gb); }
        }
        float s = 0.f;
#pragma unroll
        for (int j = 0; j < 4; ++j) s += (v[j][0] + v[j][1]) + (v[j][2] + v[j][3]);
        const float mean = wave_sum(s) * (1.f / 1024.f); float s2 = 0.f;
#pragma unroll
        for (int j = 0; j < 4; ++j) { v[j] = v[j] - mean; s2 += (v[j][0] * v[j][0] + v[j][1] * v[j][1]) + (v[j][2] * v[j][2] + v[j][3] * v[j][3]); }
        const float rstd = 1.f / sqrtf(wave_sum(s2) * (1.f / 1024.f) + LN_EPS);
        float lg[8];
        if (ROUTE) {
#pragma unroll
            for (int e = 0; e < 8; ++e) lg[e] = 0.f; }
#pragma unroll
        for (int j = 0; j < 4; ++j) { const int c = 4 * lane + 256 * j; const f32x4 y = v[j] * rstd * vg[j] + vb[j];
            if (OUT32) *(f32x4*)(OUT32 + (size_t)row * 1024 + c) = y;
            else { u32x2 w; w.x = cvt_pk_bf16(y[0], y[1]); w.y = cvt_pk_bf16(y[2], y[3]); *(u32x2*)(XB + (size_t)row * 1024 + c) = w; }
            if (sc) { const f32x4 hh = y * vsc[j] + vsh[j];
                if (H) { u32x2 w; w.x = cvt_pk_bf16(hh[0], hh[1]); w.y = cvt_pk_bf16(hh[2], hh[3]); *(u32x2*)(H + (size_t)row * 1024 + c) = w; }
                if (H8) *(unsigned*)(H8 + (size_t)row * 1024 + c) = pack4_fp8(hh[0], hh[1], hh[2], hh[3]);
                if (ROUTE) {
#pragma unroll
                    for (int e = 0; e < 8; ++e) { const f32x4 w4 = *(const LAS f32x4*)(rwl + e * 1024 + c); lg[e] += (hh[0] * w4[0] + hh[1] * w4[1]) + (hh[2] * w4[2] + hh[3] * w4[3]); } } } }
        if (ROUTE) {
#pragma unroll
            for (int e = 0; e < 8; ++e) lg[e] = wave_sum(lg[e]) + rb[e];
            int i0 = 0; float m0 = lg[0];
#pragma unroll
            for (int e = 1; e < 8; ++e) if (lg[e] > m0) { m0 = lg[e]; i0 = e; }
            int i1 = -1; float m1 = -INFINITY;
#pragma unroll
            for (int e = 0; e < 8; ++e) if (e != i0 && lg[e] > m1) { m1 = lg[e]; i1 = e; }
            const float g0 = 1.0f / (1.0f + expf(m1 - m0));
            if (lane == 0) { SEL[row] = i0 | (i1 << 8); GOUT[2 * row] = g0; GOUT[2 * row + 1] = 1.0f - g0; atomicAdd((unsigned*)&hist[i0], 1u); atomicAdd((unsigned*)&hist[i1], 1u); }
        }
      }
    }
    if (ROUTE) { __syncthreads(); if (C.tid < 8) atomicAdd(CNT + C.tid, (unsigned)hist[C.tid]); }
}

constexpr int NPH_L = 10, NPHASE = 2 + DEPTH * NPH_L;
#ifndef LB2
#define LB2 2
#endif
#ifdef NVGPR
__attribute__((amdgpu_num_vgpr(NVGPR)))
#endif
__global__ void __launch_bounds__(NWAVES * 64, LB2) mk_fwd(Args args) {
    extern __shared__ __attribute__((aligned(16))) unsigned char lds[];
    const int wave0 = __builtin_amdgcn_readfirstlane((int)threadIdx.x >> 6);
    Ctx C; C.lds = (LAS unsigned char*)lds; C.wave = wave0; C.lane = (int)__builtin_amdgcn_mbcnt_hi(~0u, __builtin_amdgcn_mbcnt_lo(~0u, 0u)); C.tid = wave0 * 64 + C.lane;
    C.G = gridDim.x; { const int bx = blockIdx.x; C.vcu = (C.G % 8 == 0) ? (bx % 8) * (C.G / 8) + bx / 8 : bx; }
    KArgP ka0 = kargs();
    unsigned* const ctl0 = (unsigned*)(ka0->ws + WS_CTL);
    volatile LAS unsigned* MISC = (volatile LAS unsigned*)(C.lds + MISC_OFF);
    for (int u = C.tid; u < (LDS_BYTES - LDSCTL_OFF) / 4; u += NWAVES * 64) ((LAS unsigned*)(C.lds + LDSCTL_OFF))[u] = 0u;
    __syncthreads();
    if (PROBE == 30 && blockIdx.x == 0 && C.tid == 0) { const unsigned long long c0 = clock64(), t0 = __builtin_amdgcn_s_memrealtime();
        MISC[16] = (unsigned)c0; MISC[17] = (unsigned)(c0 >> 32); MISC[18] = (unsigned)t0; MISC[19] = (unsigned)(t0 >> 32); }
    XcdBarrier bar; bar.bar = ctl0 + CW_BAR; bar.x = 0; bar.st = nullptr;
    if (!MK_PER_PHASE) bar = xcd_barrier_post(ctl0 + CW_BAR, MISC + 8, C.tid == 0);
    const int lo = ka0->ph_lo, hi = ka0->ph_hi;
#define GEMM_RUN(call) do { call; if (PROBE == 1 || PROBE == 10 + PHK) { asm volatile("s_waitcnt vmcnt(0)" ::: "memory"); __syncthreads(); call; } } while (0)
#define FRESH() do { int l_; asm volatile("v_mbcnt_lo_u32_b32 %0, -1, 0\n\tv_mbcnt_hi_u32_b32 %0, -1, %0" : "=v"(l_)); C.lane = l_; C.wave = wave0; C.tid = wave0 * 64 + l_; } while (0)
#define IN(k) (lo <= (k) && (k) < hi)
#define SEAM(k) do { if (IN((k) + 1)) { FRESH(); XcdBarrier b2_ = bar; asm volatile("" : "+s"(b2_.bar)); xcd_barrier(b2_, C.tid == 0); if (PROBE == 6) xcd_barrier(b2_, C.tid == 0); } } while (0)
#define MOD ((float*)(ws + WS_MOD))
#define PART ((float*)(ws + WS_PART))
#define RSQ ((float*)(ws + WS_RSQ))
#define COS ((float*)(ws + WS_COS))
#define SIN ((float*)(ws + WS_SIN))
#define H ((bf16_t*)(ws + WS_H))
#define LAT ((bf16_t*)(ws + WS_LAT))
#define ZB ((bf16_t*)(ws + WS_ZB))
#define QM ((bf16_t*)(ws + WS_QM))
#define KM ((bf16_t*)(ws + WS_KM))
#define VM ((bf16_t*)(ws + WS_VM))
#define OM ((bf16_t*)(ws + WS_OM))
#define PRE ((float*)(ws + WS_PRE))
#define T1 ((bf16_t*)(ws + WS_T1))
#define MB ((bf16_t*)(ws + WS_MB))
#define DQ (ZB)
#define DK (ZB + (size_t)T * 1024)
#define DV (ZB + (size_t)2 * T * 1024)
#define SA (ZB + (size_t)3 * T * 1024)
#define SB (ZB + (size_t)4 * T * 1024)
#define XB ((bf16_t*)(ws + WS_XRES))
#define ctl ((unsigned*)(ws + WS_CTL))
#define gw (C.vcu * NWAVES + C.wave)
#define NGW (C.G * NWAVES)

    if (PHM(10) && IN(0)) { KArgP ka = kargs(); (void)ka; FRESH(); unsigned char* const ws = ka->ws; C.ws = ws;
        for (int rep = 0; rep < (PROBE == 4 ? 2 : 1); ++rep) { cvt_mixer_weights(C, 0); cvt_ffn_weights(C, 0); }
        LAS float* cond = (LAS float*)(C.lds + C.wave * 8448);
        for (int it = gw; it < 4 * 24 * 8; it += NGW) {
            const int kc = it & 7, jb = (it >> 3) % 24, l = it / (8 * 24);
            for (int i = C.lane; i < 2048; i += 64) { const int k = i >> 4, b = i & 15; const float cv = ka->c[b * 1024 + kc * 128 + k]; cond[k * 16 + b] = cv / (1.0f + expf(-cv)); }
            asm volatile("s_waitcnt lgkmcnt(0)" ::: "memory");
            f32x4 acc[16];
#pragma unroll
            for (int b = 0; b < 16; ++b) acc[b] = (f32x4){0.f, 0.f, 0.f, 0.f};
            const float* wp = ka->w_ada + ((size_t)l * 1024 + kc * 128) * 6144 + jb * 256 + 4 * C.lane;
#pragma unroll 4
            for (int k = 0; k < 128; ++k) { const f32x4 w = *(const f32x4*)(wp + (size_t)k * 6144);
                const f32x4 c0 = *(const LAS f32x4*)(cond + k * 16), c1 = *(const LAS f32x4*)(cond + k * 16 + 4), c2 = *(const LAS f32x4*)(cond + k * 16 + 8), c3 = *(const LAS f32x4*)(cond + k * 16 + 12);
#pragma unroll
                for (int b = 0; b < 4; ++b) { acc[b] += w * c0[b]; acc[4 + b] += w * c1[b]; acc[8 + b] += w * c2[b]; acc[12 + b] += w * c3[b]; } }
#pragma unroll
            for (int b = 0; b < 16; ++b) *(f32x4*)(PART + (((size_t)kc * 4 + l) * 16 + b) * 6144 + jb * 256 + 4 * C.lane) = acc[b];
            asm volatile("s_waitcnt lgkmcnt(0)" ::: "memory");
        }
        for (int i = blockIdx.x * (NWAVES * 64) + C.tid; i < T * 16; i += C.G * NWAVES * 64) {
            const int t = i >> 4, j = i & 15; const float inv = powf(10000.0f, -(float)j * (1.0f / 16.0f)); const float ang = (float)ka->pos[t] * inv;
            COS[i] = cosf(ang); SIN[i] = sinf(ang); }
        SEAM(0);
    }
    if (PHM(11) && IN(1)) { KArgP ka = kargs(); (void)ka; FRESH(); unsigned char* const ws = ka->ws; C.ws = ws;
        for (int i = blockIdx.x * (NWAVES * 64) + C.tid; i < 4 * 16 * 6144; i += C.G * NWAVES * 64) {
            const int j = i % 6144, l = i / (16 * 6144); float s = ka->b_ada[l * 6144 + j];
#pragma unroll
            for (int kc = 0; kc < 8; ++kc) s += PART[(size_t)kc * 4 * 16 * 6144 + i];
            MOD[i] = s; }
        { const int wg = blockIdx.x, b = (wg * 128) >> 11; f32x4 vsc[4], vsh[4];
#pragma unroll
          for (int j = 0; j < 4; ++j) { const int c = 4 * C.lane + 256 * j; f32x4 a = *(const f32x4*)(ka->b_ada + c), s = *(const f32x4*)(ka->b_ada + 1024 + c);
#pragma unroll
              for (int kc = 0; kc < 8; ++kc) { const float* p = PART + (((size_t)kc * 4 + 0) * 16 + b) * 6144; a += *(const f32x4*)(p + c); s += *(const f32x4*)(p + 1024 + c); }
              vsh[j] = a; vsc[j] = s + 1.0f; }
          for (int rr = 0; rr < 16; ++rr) { const int row = wg * 128 + C.wave * 16 + rr;
#pragma unroll
              for (int j = 0; j < 4; ++j) { const int c = 4 * C.lane + 256 * j; const f32x4 xv = *(const f32x4*)(ka->x + (size_t)row * 1024 + c); const f32x4 hh = xv * vsc[j] + vsh[j];
                  *(unsigned*)(ws + WS_H8 + (size_t)row * 1024 + c) = pack4_fp8(hh[0], hh[1], hh[2], hh[3]);
                  { u32x2 w; w.x = cvt_pk_bf16(xv[0], xv[1]); w.y = cvt_pk_bf16(xv[2], xv[3]); *(u32x2*)(XB + (size_t)row * 1024 + c) = w; } } } }
        SEAM(1);
    }

    for (int l = 0; l < DEPTH; ++l) {
        const int P = 2 + l * NPH_L;
        const bool moe = (l & 1) != 0; const int li = l >> 1;
        if (PHM(0) && IN(P + 0)) { KArgP ka = kargs(); (void)ka; FRESH(); unsigned char* const ws = ka->ws; C.ws = ws; constexpr int PHK = 0;
            pg8::Gemm g{(const bf16_t*)(ws + WS_H8), (const bf16_t*)(ws + WS_WIN8), T, NZ, 512, 512}; pg8::StaticOrder S; S.init(T, NZ, C.G, (int)blockIdx.x);
            pg8::EpiRow<FIn, true, true> E{FIn{LAT, ZB, KM, RSQ, COS, SIN, 0, 1.0f / W8_SCALE}};
            GEMM_RUN((pg8::gemm_phase<STG_IN, true>(C.lds, C.tid, g, S, E)));
            SEAM(P + 0);
        }
        if (PHM(1) && IN(P + 1)) { KArgP ka = kargs(); (void)ka; FRESH(); unsigned char* const ws = ka->ws; C.ws = ws; constexpr int PHK = 1;
            { pg8::Gemm g{LAT, (const bf16_t*)(ws + W_QUP), T, 768, 384, 768}; pg8::StaticOrder S; S.init(T, 768, C.G, (int)blockIdx.x);
              pg8::EpiRow<FQup, true, true> E{FQup{QM, RSQ, COS, SIN}}; GEMM_RUN(pg8::gemm_phase(C.lds, C.tid, g, S, E)); }
            { pg8::Gemm g{LAT + 512, (const bf16_t*)(ws + W_KVUP), T, 1024, 256, 768}; pg8::StaticOrder S; S.init(T, 1024, C.G, (int)blockIdx.x);
              pg8::EpiRow<FKVup, true, true> E{FKVup{KM, VM, RSQ}}; GEMM_RUN(pg8::gemm_phase(C.lds, C.tid, g, S, E)); }
            for (int rb = gw * 16; rb < T; rb += NGW * 16) { float mx = 0.f;
#pragma unroll 4
                for (int r = 0; r < 16; ++r) { const u32x4* p = (const u32x4*)(DK + (size_t)(rb + r) * 1024) + C.lane * 2; f32x4 a0, a1, b0, b1; unpack8(p[0], a0, a1); unpack8(p[1], b0, b1);
                    float sq = (a0[0] * a0[0] + a0[1] * a0[1]) + (a0[2] * a0[2] + a0[3] * a0[3]) + (a1[0] * a1[0] + a1[1] * a1[1]) + (a1[2] * a1[2] + a1[3] * a1[3])
                             + (b0[0] * b0[0] + b0[1] * b0[1]) + (b0[2] * b0[2] + b0[3] * b0[3]) + (b1[0] * b1[0] + b1[1] * b1[1]) + (b1[2] * b1[2] + b1[3] * b1[3]);
                    sq += swz_xor<1>(sq); sq += swz_xor<2>(sq); mx = fmaxf(mx, sq); }
                if ((C.lane & 3) == 0) atomicMax(ctl + CW_KMAX + l * 256 + (rb >> 11) * 16 + (C.lane >> 2), __float_as_uint(mx)); }
            SEAM(P + 1);
        }
        if (PHM(2) && IN(P + 2)) { KArgP ka = kargs(); (void)ka; FRESH(); unsigned char* const ws = ka->ws; C.ws = ws;
            float lam;
            { float s1 = 0.f, s2 = 0.f;
              for (int i = 0; i < 64; ++i) { s1 += ka->lq1[l * 64 + i] * ka->lk1[l * 64 + i]; s2 += ka->lq2[l * 64 + i] * ka->lk2[l * 64 + i]; }
              lam = expf(s1) - expf(s2) + ka->lam_init[l]; }
            const int xcd = C.vcu >> 5, jj = C.vcu & 31; const bool g256 = (C.G == 256);
            for (int rep = 0; rep < (PROBE == 2 ? 2 : 1); ++rep)
            for (int i = 0; ; ++i) {
                int u; if (g256) { if (i >= 4) break; u = xcd * 128 + i * 32 + jj; } else { u = i * C.G + C.vcu; if (u >= 1024) break; }
                const int bh = u >> 3, qb = u & 7, b = bh >> 3, h = bh & 7; const size_t r0 = (size_t)b * SEQ;
                att::DiffArgs da{nullptr, 0.f, 0.f, 0.f, nullptr, 0.f};
                att::attn_unit<false>(QM + (r0 + qb * 256) * 768 + h * 96, KM + r0 * 768 + h * 96, VM + r0 * 512 + h * 64, (unsigned char*)OM + (r0 + qb * 256) * 512 + h * 64, qb * 256, da, (char*)lds, C.lds, C.tid);
            }
            int bprev = -1;
            for (int rep = 0; rep < (PROBE == 3 ? 2 : 1); ++rep)
            for (int i = 0; ; ++i) {
                int b, h, qb;
                if (g256) { if (i >= 8) break; h = i; b = xcd * 2 + (jj >> 4); qb = ((jj & 15) + 2 * i) & 15; }
                const size_t r0 = (size_t)b * SEQ;
                if (b != bprev) { __syncthreads(); att::diff_pos_setup(ka->pos + r0, (char*)lds, C.tid); bprev = b; }
                const unsigned* km = ctl + CW_KMAX + l * 256 + (b * 8 + h) * 2;
                att::DiffArgs da{ka->pos + r0, exp2f(-(float)(h + 1)) * LOG2E, lam, 1.0f - ka->lam_init[l], ka->diff_norm_g + l * 1024 + h * 128, fmaxf(__uint_as_float(km[0]), __uint_as_float(km[1]))};
                att::attn_unit<true>(DQ + (r0 + qb * 128) * 1024 + h * 128, DK + r0 * 1024 + h * 128, DV + r0 * 1024 + h * 128,
                                     (ws + WS_DO8) + (r0 + qb * 128) * 1024 + h * 128, qb * 128, da, (char*)lds, C.lds, C.tid);
            }
            SEAM(P + 2);
        }
        if (PHM(3) && IN(P + 3)) { KArgP ka = kargs(); (void)ka; FRESH(); unsigned char* const ws = ka->ws; C.ws = ws; constexpr int PHK = 3;
            { pg8::Gemm g{OM, (const bf16_t*)(ws + W_BRM), T, 1024, 256, 256}; pg8::StaticOrder S; S.init(T, 1024, C.G, (int)blockIdx.x);
              pg8::EpiBr<1> E{T1, nullptr, nullptr, nullptr, 1.0f / (O8_SCALE * W8_SCALE_BR)}; GEMM_RUN((pg8::gemm_phase<STG_BR, true>(C.lds, C.tid, g, S, E))); }
            asm volatile("s_waitcnt vmcnt(0)" ::: "memory"); __syncthreads();
            { pg8::Gemm g{(const bf16_t*)(ws + WS_DO8), (const bf16_t*)(ws + W_BRD), T, 1024, 512, 512}; pg8::StaticOrder S; S.init(T, 1024, C.G, (int)blockIdx.x);
              pg8::EpiBr<2> E{MB, (const unsigned char*)SA, (const unsigned char*)SB, (const unsigned char*)T1, 1.0f / (O8_SCALE * W8_SCALE_BR)}; GEMM_RUN((pg8::gemm_phase<0, true>(C.lds, C.tid, g, S, E))); }
            SEAM(P + 3);
        }
        if (PHM(4) && IN(P + 4)) { KArgP ka = kargs(); (void)ka; FRESH(); unsigned char* const ws = ka->ws; C.ws = ws; constexpr int PHK = 4;
            pg8::Gemm g{MB, (const bf16_t*)(ws + W_OUT), T, 1024, 512, 512}; pg8::StaticOrder S; S.init(T, 1024, C.G, (int)blockIdx.x);
            pg8::EpiGate E{(bf16_t*)(ws + WS_PRE), 1.0f / (pg8::MB8_SCALE * W8_SCALE_BR)}; GEMM_RUN((pg8::gemm_phase<STG_OUT, true>(C.lds, C.tid, g, S, E)));
            SEAM(P + 4);
        }
        if (PHM(5) && IN(P + 5)) { KArgP ka = kargs(); (void)ka; FRESH(); unsigned char* const ws = ka->ws; C.ws = ws;
            if (moe) ln_phase<0, true>(C, ws + WS_H, XB, (const bf16_t*)(ws + WS_PRE), XB, (float*)nullptr, (bf16_t*)nullptr, ka->ln1_g + l * 1024, ka->ln1_b + l * 1024, (MOD + (size_t)l * 16 * 6144) + 4096, (MOD + (size_t)l * 16 * 6144) + 3072, nullptr, nullptr, (MOD + (size_t)l * 16 * 6144) + 2048,
                                       ka->router_w + (size_t)li * 8192, ka->router_b + li * 8, (int*)(ws + WS_SEL), (float*)(ws + WS_GATE), ctl + CW_CNT + 64 * li);
            else ln_phase<0, false>(C, nullptr, XB, (const bf16_t*)(ws + WS_PRE), XB, (float*)nullptr, H, ka->ln1_g + l * 1024, ka->ln1_b + l * 1024, (MOD + (size_t)l * 16 * 6144) + 4096, (MOD + (size_t)l * 16 * 6144) + 3072, nullptr, nullptr, (MOD + (size_t)l * 16 * 6144) + 2048, nullptr, nullptr, nullptr, nullptr, nullptr);
            SEAM(P + 5);
        }
        int ts[9];
#pragma unroll
        for (int e = 0; e < 9; ++e) ts[e] = 0;
        if (moe && (IN(P + 6) || IN(P + 7) || IN(P + 8))) { KArgP ka = kargs(); unsigned char* const ws = ka->ws;
            int accp = 0;
#pragma unroll
            for (int e = 0; e < 8; ++e) { ts[e] = accp; const int cnt = (int)__hip_atomic_load(ctl + CW_CNT + 64 * li + e, __ATOMIC_RELAXED, __HIP_MEMORY_SCOPE_AGENT); accp += (cnt + 255) >> 8; }
            ts[8] = accp;
        }
        if (PHM(6) && IN(P + 6)) { KArgP ka = kargs(); (void)ka; FRESH(); unsigned char* const ws = ka->ws; C.ws = ws;
            if (moe) {
                const int* SEL = (const int*)(ws + WS_SEL); int* RMAP = (int*)(ws + WS_RMAP);
                unsigned* CUR = ctl + CW_CUR + 64 * li; const unsigned* CNT = ctl + CW_CNT + 64 * li;
                if (blockIdx.x == 0) {
                    _Pragma("unroll") for (int e = 0; e < 8; ++e) { const int c = (int)CNT[e], beg = ts[e] * 256 + c, end = ts[e + 1] * 256; for (int p = beg + C.tid; p < end; p += NWAVES * 64) RMAP[p] = -1; } }
                for (int s0 = gw * 64; s0 < 2 * T; s0 += NGW * 64) {
                    const int s = s0 + C.lane, t = s >> 1, k = s & 1; const int sel = SEL[t]; const int e = k ? (sel >> 8) : (sel & 255);
                    int pos = 0;
#pragma unroll
                    for (int ee = 0; ee < 8; ++ee) { const unsigned long long m = __ballot(e == ee); const int n = __popcll(m);
                        if (n) { unsigned base = 0; if (C.lane == 0) base = atomicAdd(CUR + ee, (unsigned)n); base = __builtin_amdgcn_readfirstlane(base);
                            if (e == ee) pos = ts[ee] * 256 + (int)base + (int)__builtin_amdgcn_mbcnt_hi((unsigned)(m >> 32), __builtin_amdgcn_mbcnt_lo((unsigned)m, 0u)); } }
                    RMAP[pos] = s;
                    { unsigned char* XB8 = ws + WS_XB; const unsigned char* H8 = (const unsigned char*)H;
                      for (int q = 0; q < 64; q += 16) {
                        u32x4 r0[8];
#pragma unroll
                        for (int u = 0; u < 8; ++u) { const int tq = (s0 + q + 2 * u) >> 1; r0[u] = ((const u32x4*)(H8 + (size_t)tq * 1024))[C.lane]; }
#pragma unroll
                        for (int u = 0; u < 8; ++u) {
#pragma unroll
                            for (int k2 = 0; k2 < 2; ++k2) { const int pq = __builtin_amdgcn_readlane(pos, q + 2 * u + k2); ((u32x4*)(XB8 + (size_t)pq * 1024))[C.lane] = r0[u]; } }
                      } }
                }
            }
            if (moe) SEAM(P + 6);
        }
        if (PHM(7) && IN(P + 7)) { KArgP ka = kargs(); (void)ka; FRESH(); unsigned char* const ws = ka->ws; C.ws = ws; constexpr int PHK = 7;
            if (!moe) { pg8::Gemm g{H, (const bf16_t*)(ws + WS_WFF), T, 5632, 1024, 1024}; pg8::StaticOrder S; S.init(T, 5632, C.G, (int)blockIdx.x);
                pg8::EpiSwiglu E{(bf16_t*)(ws + WS_U), FF, 1.0f, true}; GEMM_RUN(pg8::gemm_phase(C.lds, C.tid, g, S, E)); }
            else { pg8::Gemm g{(const bf16_t*)(ws + WS_XB), (const bf16_t*)(ws + WS_WFF), ts[8] * 256, 5632, 512, 512};
                pg8::MoeOrderT<false> S; S.rmap = nullptr; S.so.init(ts[8] * 256, 5632, C.G, (int)blockIdx.x); S.ts1 = ts[1]; S.ts2 = ts[2]; S.ts3 = ts[3]; S.ts4 = ts[4]; S.ts5 = ts[5]; S.ts6 = ts[6]; S.ts7 = ts[7]; S.estride = W13_ESTRIDE8;
                pg8::EpiSwiglu E{(bf16_t*)(ws + WS_UM), FF, 1.0f / W8_SCALE, true}; GEMM_RUN((pg8::gemm_phase<0, true>(C.lds, C.tid, g, S, E))); }
            SEAM(P + 7);
        }
        if (PHM(8) && IN(P + 8)) { KArgP ka = kargs(); (void)ka; FRESH(); unsigned char* const ws = ka->ws; C.ws = ws; constexpr int PHK = 8;
            if (!moe) { pg8::Gemm g{(const bf16_t*)(ws + WS_U), (const bf16_t*)(ws + W2_BASE), T, 1024, FF / 2, FF / 2}; pg8::StaticOrder S; S.init(T, 1024, C.G, (int)blockIdx.x);
                pg8::EpiGate E{(bf16_t*)(ws + WS_PRE), 1.0f / W8_SCALE_W2}; GEMM_RUN((pg8::gemm_phase<0, true>(C.lds, C.tid, g, S, E))); }
            else { pg8::Gemm g{(const bf16_t*)(ws + WS_UM), (const bf16_t*)(ws + W2_BASE), ts[8] * 256, 1024, FF / 2, FF / 2};
                pg8::MoeOrderT<false> S; S.rmap = nullptr; S.so.init(ts[8] * 256, 1024, C.G, (int)blockIdx.x); S.ts1 = ts[1]; S.ts2 = ts[2]; S.ts3 = ts[3]; S.ts4 = ts[4]; S.ts5 = ts[5]; S.ts6 = ts[6]; S.ts7 = ts[7]; S.estride = W2_ESTRIDE8;
                pg8::EpiMoeOut E{(bf16_t*)(ws + WS_Y), (const int*)(ws + WS_RMAP), 1.0f / W8_SCALE_W2}; GEMM_RUN((pg8::gemm_phase<0, true>(C.lds, C.tid, g, S, E))); }
            SEAM(P + 8);
        }
        if (PHM(9) && IN(P + 9)) { KArgP ka = kargs(); (void)ka; FRESH(); unsigned char* const ws = ka->ws; C.ws = ws;
            const float* nsc = (l + 1 < DEPTH) ? MOD + (size_t)(l + 1) * 16 * 6144 + 1024 : nullptr; const float* nsh = (l + 1 < DEPTH) ? MOD + (size_t)(l + 1) * 16 * 6144 : nullptr;
            if (moe) ln_phase<1, false>(C, (l + 1 < DEPTH) ? ws + WS_H8 : nullptr, nullptr, nullptr, XB, (l + 1 < DEPTH) ? (float*)nullptr : ka->out, (bf16_t*)nullptr, ka->ln2_g + l * 1024, ka->ln2_b + l * 1024, nsc, nsh, (const bf16_t*)(ws + WS_Y), (const float*)(ws + WS_GATE), (MOD + (size_t)l * 16 * 6144) + 5120, nullptr, nullptr, nullptr, nullptr, nullptr);
            else ln_phase<0, false>(C, (l + 1 < DEPTH) ? ws + WS_H8 : nullptr, XB, (const bf16_t*)(ws + WS_PRE), XB, (l + 1 < DEPTH) ? (float*)nullptr : ka->out, (bf16_t*)nullptr, ka->ln2_g + l * 1024, ka->ln2_b + l * 1024, nsc, nsh, nullptr, nullptr, (MOD + (size_t)l * 16 * 6144) + 5120, nullptr, nullptr, nullptr, nullptr, nullptr);
            if (l + 1 < DEPTH) for (int rep = 0; rep < (PROBE == 4 ? 2 : 1); ++rep) { __syncthreads(); cvt_mixer_weights(C, l + 1); cvt_ffn_weights(C, l + 1); }
            if (l + 1 < DEPTH) SEAM(P + 9);
        }
    }
    if (PROBE == 30 && blockIdx.x == 0 && C.tid == 0) {
        const unsigned long long c1 = clock64(), t1 = __builtin_amdgcn_s_memrealtime();
        const unsigned long long c0 = ((unsigned long long)MISC[17] << 32) | MISC[16], t0 = ((unsigned long long)MISC[19] << 32) | MISC[18];
        const unsigned long long mhz = (c1 - c0) * 100ull / (t1 - t0);
        while (__builtin_amdgcn_s_memrealtime() - t1 < mhz * 100ull) __builtin_amdgcn_s_sleep(16); }
#undef IN
#undef SEAM
#undef MOD
#undef PART
#undef RSQ
#undef COS
#undef SIN
#undef H
#undef LAT
#undef ZB
#undef QM
#undef KM
#undef VM
#undef OM
#undef PRE
#undef T1
#undef MB
#undef DQ
#undef DK
#undef DV
#undef SA
#undef SB
#undef XB
#undef ctl
#undef gw
#undef NGW
}

extern "C" void kernel_launch(void* const* d_in, const int* in_sizes, int n_in, void* d_out, int out_size, void* d_ws, size_t ws_size, hipStream_t stream) {
    static int grid = 0;
    if (grid == 0) {
        if (n_in != 30 || in_sizes[0] != T * D || out_size != T * D || ws_size < WS_NEED) { fprintf(stderr, "kernel_launch: unexpected shapes (n_in %d, in0 %d, out %d, ws %zu, need %zu)\n", n_in, n_in > 0 ? in_sizes[0] : -1, out_size, ws_size, (size_t)WS_NEED); grid = -1; return; }
        if (hipFuncSetAttribute((const void*)mk_fwd, hipFuncAttributeMaxDynamicSharedMemorySize, LDS_BYTES) != hipSuccess) { fprintf(stderr, "kernel_launch: hipFuncSetAttribute failed\n"); grid = -1; return; }
        int per_cu = 0;
        if (hipOccupancyMaxActiveBlocksPerMultiprocessor(&per_cu, (const void*)mk_fwd, NWAVES * 64, LDS_BYTES) != hipSuccess || per_cu < 1) fprintf(stderr, "kernel_launch: occupancy query reports %d\n", per_cu);
        (void)hipGetLastError();
        grid = 256;
    }
    if (grid < 0) return;
    if (hipMemsetAsync((char*)d_ws + WS_CTL, 0, CTL_ZERO_BYTES, stream) != hipSuccess) { fprintf(stderr, "kernel_launch: memset failed\n"); return; }
    Args a{};
    const float** fp = (const float**)&a.x;
    a.x = (const float*)d_in[0]; a.c = (const float*)d_in[1]; a.pos = (const int*)d_in[2]; a.w_ada = (const float*)d_in[3]; a.b_ada = (const float*)d_in[4]; a.w_in = (const float*)d_in[5];
    a.q_norm_g = (const float*)d_in[6]; a.w_q_up = (const float*)d_in[7]; a.kv_norm_g = (const float*)d_in[8]; a.w_kv_up = (const float*)d_in[9];
    a.lq1 = (const float*)d_in[10]; a.lk1 = (const float*)d_in[11]; a.lq2 = (const float*)d_in[12]; a.lk2 = (const float*)d_in[13]; a.diff_norm_g = (const float*)d_in[14];
    a.w_br_mla = (const float*)d_in[15]; a.w_br_diff = (const float*)d_in[16]; a.w_out = (const float*)d_in[17];
    a.ln1_g = (const float*)d_in[18]; a.ln1_b = (const float*)d_in[19]; a.ln2_g = (const float*)d_in[20]; a.ln2_b = (const float*)d_in[21];
    a.ffn_w1 = (const float*)d_in[22]; a.ffn_w3 = (const float*)d_in[23]; a.ffn_w2 = (const float*)d_in[24]; a.router_w = (const float*)d_in[25]; a.router_b = (const float*)d_in[26];
    a.moe_w1 = (const float*)d_in[27]; a.moe_w3 = (const float*)d_in[28]; a.moe_w2 = (const float*)d_in[29];
    (void)fp;
    a.out = (float*)d_out; a.ws = (unsigned char*)d_ws;
    for (int l = 0; l < 4; ++l) a.lam_init[l] = (float)(0.8 - 0.6 * exp(-0.3 * (double)l));
#if MK_PER_PHASE
    for (int p = 0; p < NPHASE; ++p) {
        const int k = (p - 2) % NPH_L, l = (p - 2) / NPH_L;
        if (p >= 2 && k == 6 && (l & 1) == 0) continue;
        a.ph_lo = p; a.ph_hi = p + 1;
        hipLaunchKernelGGL(mk_fwd, dim3(grid), dim3(NWAVES * 64), LDS_BYTES, stream, a);
    }
#else
    a.ph_lo = 0; a.ph_hi = NPHASE;
    hipLaunchKernelGGL(mk_fwd, dim3(grid), dim3(NWAVES * 64), LDS_BYTES, stream, a);
#endif
    const hipError_t le = hipPeekAtLastError();
    if (le != hipSuccess) fprintf(stderr, "kernel_launch: launch failed: %s\n", hipGetErrorName(le));
}
```

```cpp
#include <hip/hip_runtime.h>
#include <hip/hip_bf16.h>
#include <cstdio>
#include <cstdint>
#include <cmath>

#ifndef MK_PER_PHASE
#define MK_PER_PHASE 0
#endif
#ifndef PH_MASK
#define PH_MASK 0xFFFF
#endif
#define PHM(k) (((PH_MASK) >> (k)) & 1)
#ifndef STG_IN
#define STG_IN 0
#endif
#ifndef STG_BR
#define STG_BR 0
#endif
#ifndef STG_OUT
#define STG_OUT 0
#endif
#ifndef PROBE
#define PROBE 0
#endif

constexpr int D = 1024, BATCH = 16, SEQ = 2048, DEPTH = 4, T = BATCH * SEQ;
constexpr int NZ = 5888;
constexpr int FF = 2816, NEXP = 8;
constexpr float ALPHA = 1.681792830507429f;
constexpr float LN_EPS = 1e-5f, RMS_EPS = 1e-6f;
constexpr float LOG2E = 1.4426950408889634f;
constexpr float CQ_MLA = 0.10206207261596575f * LOG2E;
constexpr float CQ_DIFF = 0.125f * LOG2E;

#define LAS __attribute__((address_space(3)))
#define GAS __attribute__((address_space(1)))
typedef unsigned short bf16_t;
typedef short bf16x8 __attribute__((ext_vector_type(8)));
typedef short s16x4 __attribute__((ext_vector_type(4)));
typedef float f32x4 __attribute__((ext_vector_type(4)));
typedef float f32x2 __attribute__((ext_vector_type(2)));
typedef float f32x16 __attribute__((ext_vector_type(16)));
typedef unsigned u32x4 __attribute__((ext_vector_type(4)));
typedef unsigned u32x2 __attribute__((ext_vector_type(2)));

typedef __bf16 bf16x2_t __attribute__((ext_vector_type(2)));
__device__ __forceinline__ unsigned cvt_pk_bf16(float lo, float hi) { const f32x2 v = {lo, hi}; return __builtin_bit_cast(unsigned, __builtin_convertvector(v, bf16x2_t)); }
__device__ __forceinline__ u32x4 pack8(f32x4 a, f32x4 b) { u32x4 w; w.x = cvt_pk_bf16(a[0], a[1]); w.y = cvt_pk_bf16(a[2], a[3]); w.z = cvt_pk_bf16(b[0], b[1]); w.w = cvt_pk_bf16(b[2], b[3]); return w; }
__device__ __forceinline__ void unpack8(u32x4 w, f32x4& a, f32x4& b) {
    a[0] = __uint_as_float(w.x << 16); a[1] = __uint_as_float(w.x & 0xffff0000u); a[2] = __uint_as_float(w.y << 16); a[3] = __uint_as_float(w.y & 0xffff0000u);
    b[0] = __uint_as_float(w.z << 16); b[1] = __uint_as_float(w.z & 0xffff0000u); b[2] = __uint_as_float(w.w << 16); b[3] = __uint_as_float(w.w & 0xffff0000u); }
__device__ __forceinline__ unsigned pack4_fp8(float a, float b, float c, float d) {
    a = fminf(fmaxf(a, -448.f), 448.f); b = fminf(fmaxf(b, -448.f), 448.f); c = fminf(fmaxf(c, -448.f), 448.f); d = fminf(fmaxf(d, -448.f), 448.f);
    int w = 0; w = __builtin_amdgcn_cvt_pk_fp8_f32(a, b, w, false); w = __builtin_amdgcn_cvt_pk_fp8_f32(c, d, w, true); return (unsigned)w; }
constexpr float W8_SCALE_W2 = 128.0f;
constexpr float W8_SCALE = 32.0f;
__device__ __forceinline__ float bf2f(bf16_t v) { return __uint_as_float(((unsigned)v) << 16); }
template <int X> __device__ __forceinline__ float swz_xor(float v) { return __int_as_float(__builtin_amdgcn_ds_swizzle(__float_as_int(v), (X << 10) | 0x1f)); }
__device__ __forceinline__ float sum_x32(float v) { auto rr = __builtin_amdgcn_permlane32_swap(__float_as_uint(v), __float_as_uint(v), false, false); return __uint_as_float(rr[0]) + __uint_as_float(rr[1]); }
constexpr float O8_SCALE = 16.0f, W8_SCALE_BR = 64.0f;
__device__ __forceinline__ float sigmoidf_(float x) { return __builtin_amdgcn_rcpf(1.0f + __builtin_amdgcn_exp2f(-x * LOG2E)); }

namespace pg8 {
constexpr int BM = 256, BK = 64, HALF = 128, HTB = HALF * BK * 2, STAGE_BYTES = 8 * HTB, NXCD = 8, WGM = 8;
__host__ __device__ __forceinline__ int lds_byte(int r, int c) { const int st = (r >> 4) * 2 + (c >> 5), rr = r & 15, cc = c & 31, ob = rr * 64 + cc * 2; return st * 1024 + (ob ^ (((ob >> 9) & 1) << 5)); }
__host__ __device__ __forceinline__ void stage_rc(int b, int& R, int& C) { const int st = b / 1024, sb = b % 1024, swz = sb ^ (((sb >> 9) & 1) << 5); R = (st >> 1) * 16 + swz / 64; C = (st & 1) * 32 + (swz % 64) / 2; }
__host__ __device__ __forceinline__ int perm32(int rho) { const int n = rho >> 4, i = rho & 15; return 8 * (i >> 2) + 4 * n + (i & 3); }

struct Unit { int pm, pn; };
struct Gemm { const bf16_t* A; const bf16_t* Bt; int M, N, K, lda; };

struct StaticOrder {
    int nM, nN, nwg, G, c;
    __host__ __device__ void init(int M, int N, int G_, int c_) { nM = M / BM; nN = N / BM; nwg = nM * nN; G = G_; c = c_; }
    static constexpr bool GATHER = false; const int* rmap = nullptr;
    __host__ __device__ bool next(int i, Unit& u) const {
        const long L = (long)i * G + c; if (L >= nwg) return false;
        int wgid = (int)L; { const int q = nwg / NXCD, r = nwg % NXCD, xcd = wgid % NXCD, off = wgid / NXCD; wgid = (xcd < r ? xcd * (q + 1) : r * (q + 1) + (xcd - r) * q) + off; }
        const int nig = WGM * nN, gid = wgid / nig, fm = gid * WGM, gsz = (nM - fm) < WGM ? (nM - fm) : WGM;
        u.pm = fm + ((wgid % nig) % gsz); u.pn = (wgid % nig) / gsz; return true;
    }
    __device__ __forceinline__ size_t bofs(const Unit&) const { return 0; }
};
template <bool GATHER_> struct MoeOrderT {
    static constexpr bool GATHER = GATHER_;
    StaticOrder so; int ts1, ts2, ts3, ts4, ts5, ts6, ts7; size_t estride; const int* rmap;
    __device__ __forceinline__ bool next(int i, Unit& u) const { return so.next(i, u); }
    __device__ __forceinline__ size_t bofs(const Unit& u) const {
        const int e = (u.pm >= ts1) + (u.pm >= ts2) + (u.pm >= ts3) + (u.pm >= ts4) + (u.pm >= ts5) + (u.pm >= ts6) + (u.pm >= ts7);
        return (size_t)e * estride; }
};

template <class F, bool PERM_, bool WIDE_ = false> struct EpiRow {
    static constexpr bool PERM = PERM_, WIDE = WIDE_; F f;
    __device__ __forceinline__ void operator()(const f32x4 (&acc)[2][2][4][2], const Unit& u, int wr, int wc, int fr, int fq) const {
#pragma unroll
        for (int ai = 0; ai < 2; ++ai) {
            float rs[4];
#pragma unroll
            for (int m = 0; m < 4; ++m) rs[m] = f.rowscale(u.pm * BM + ai * HALF + wr * 64 + m * 16 + fr);
#pragma unroll
            for (int m = 0; m < 4; ++m) { const int row = u.pm * BM + ai * HALF + wr * 64 + m * 16 + fr;
#pragma unroll
                for (int bj = 0; bj < 2; ++bj) f(row, rs[m], u.pn * BM + (WIDE ? wc * 64 + bj * 32 : bj * HALF + wc * 32), fq, acc[ai][bj][m][0], acc[ai][bj][m][1]);
                if constexpr (F::HAS_PAIR && WIDE) f.pair(row, u.pn * BM + wc * 64, fq, acc[ai][0][m][0], acc[ai][0][m][1], acc[ai][1][m][0], acc[ai][1][m][1]);
                asm volatile("" ::: "memory"); __builtin_amdgcn_sched_barrier(0); }
        }
    }
};
struct EpiGate {
    static constexpr bool PERM = true, WIDE = true; bf16_t* G; float inscale;
    __device__ __forceinline__ void operator()(const f32x4 (&acc)[2][2][4][2], const Unit& u, int wr, int wc, int fr, int fq) const {
        const int col0 = u.pn * BM + wc * 64 + 8 * fq;
#pragma unroll
        for (int ai = 0; ai < 2; ++ai)
#pragma unroll
            for (int m = 0; m < 4; ++m) { const size_t o = (size_t)(u.pm * BM + ai * HALF + wr * 64 + m * 16 + fr) * 1024 + col0;
#pragma unroll
                for (int bj = 0; bj < 2; ++bj) *(u32x4*)(G + o + bj * 32) = pack8(acc[ai][bj][m][0] * inscale, acc[ai][bj][m][1] * inscale);
                __builtin_amdgcn_sched_barrier(0); }
    }
};
__device__ __forceinline__ void unpack8_fp8(u32x2 w, f32x4& a, f32x4& b) {
    const f32x2 a0 = __builtin_amdgcn_cvt_pk_f32_fp8((int)w.x, false), a1 = __builtin_amdgcn_cvt_pk_f32_fp8((int)w.x, true);
    const f32x2 b0 = __builtin_amdgcn_cvt_pk_f32_fp8((int)w.y, false), b1 = __builtin_amdgcn_cvt_pk_f32_fp8((int)w.y, true);
    a[0] = a0[0]; a[1] = a0[1]; a[2] = a1[0]; a[3] = a1[1]; b[0] = b0[0]; b[1] = b0[1]; b[2] = b1[0]; b[3] = b1[1]; }
constexpr float Y8_SCALE = 16.0f, MB8_SCALE = 32.0f;
template <int MODE> struct EpiBr {
    static constexpr bool PERM = true, WIDE = true; void* O; const unsigned char* SA8; const unsigned char* SB8; const unsigned char* Y8; float inscale;
    __device__ __forceinline__ void operator()(const f32x4 (&acc)[2][2][4][2], const Unit& u, int wr, int wc, int fr, int fq) const {
        const int col0 = u.pn * BM + wc * 64 + 8 * fq;
#pragma unroll
        for (int ai = 0; ai < 2; ++ai) {
            if (MODE == 1) {
#pragma unroll
                for (int m = 0; m < 4; ++m) { const size_t o = (size_t)(u.pm * BM + ai * HALF + wr * 64 + m * 16 + fr) * 1024 + col0;
#pragma unroll
                    for (int bj = 0; bj < 2; ++bj) { const f32x4 r0 = acc[ai][bj][m][0] * (Y8_SCALE * inscale), r1 = acc[ai][bj][m][1] * (Y8_SCALE * inscale);
                        u32x2 w8; w8.x = pack4_fp8(r0[0], r0[1], r0[2], r0[3]); w8.y = pack4_fp8(r1[0], r1[1], r1[2], r1[3]);
                        *(u32x2*)((unsigned char*)O + o + bj * 32) = w8; }
                    __builtin_amdgcn_sched_barrier(0); }
            } else {
                u32x2 av[4][2], bv[4][2], yv[4][2];
#pragma unroll
                for (int m = 0; m < 4; ++m) { const size_t o = (size_t)(u.pm * BM + ai * HALF + wr * 64 + m * 16 + fr) * 1024 + col0;
#pragma unroll
                    for (int bj = 0; bj < 2; ++bj) { av[m][bj] = *(const u32x2*)(SA8 + o + bj * 32); bv[m][bj] = *(const u32x2*)(SB8 + o + bj * 32); yv[m][bj] = *(const u32x2*)(Y8 + o + bj * 32); } }
#pragma unroll
                for (int m = 0; m < 4; ++m) { const size_t o = (size_t)(u.pm * BM + ai * HALF + wr * 64 + m * 16 + fr) * 1024 + col0;
#pragma unroll
                    for (int bj = 0; bj < 2; ++bj) { f32x4 a0, a1, b0, b1, y0, y1; unpack8_fp8(av[m][bj], a0, a1); unpack8_fp8(bv[m][bj], b0, b1); unpack8_fp8(yv[m][bj], y0, y1);
                        const f32x4 r0 = acc[ai][bj][m][0] * b0 * (MB8_SCALE * inscale) + a0 * y0 * (MB8_SCALE / Y8_SCALE), r1 = acc[ai][bj][m][1] * b1 * (MB8_SCALE * inscale) + a1 * y1 * (MB8_SCALE / Y8_SCALE);
                        u32x2 w8; w8.x = pack4_fp8(r0[0], r0[1], r0[2], r0[3]); w8.y = pack4_fp8(r1[0], r1[1], r1[2], r1[3]);
                        *(u32x2*)((unsigned char*)O + o + bj * 32) = w8; } }
                asm volatile("" ::: "memory"); __builtin_amdgcn_sched_barrier(0);
            }
        }
    }
};
struct EpiMoeOut {
    static constexpr bool PERM = true, WIDE = true; bf16_t* Y; const int* RMAP; float inscale;
    __device__ __forceinline__ void operator()(const f32x4 (&acc)[2][2][4][2], const Unit& u, int wr, int wc, int fr, int fq) const {
        const int col0 = u.pn * BM + wc * 64 + 8 * fq; int sl[2][4];
#pragma unroll
        for (int ai = 0; ai < 2; ++ai)
#pragma unroll
            for (int m = 0; m < 4; ++m) sl[ai][m] = RMAP[u.pm * BM + ai * HALF + wr * 64 + m * 16 + fr];
#pragma unroll
        for (int ai = 0; ai < 2; ++ai)
#pragma unroll
            for (int m = 0; m < 4; ++m) { if (sl[ai][m] >= 0) {
#pragma unroll
                for (int bj = 0; bj < 2; ++bj) *(u32x4*)(Y + (size_t)sl[ai][m] * 1024 + col0 + bj * 32) = pack8(acc[ai][bj][m][0] * inscale, acc[ai][bj][m][1] * inscale); }
                __builtin_amdgcn_sched_barrier(0); }
    }
};
struct EpiSwiglu {
    static constexpr bool PERM = true, WIDE = false; bf16_t* U; int ldu; float inscale; bool out8;
    __device__ __forceinline__ void operator()(const f32x4 (&acc)[2][2][4][2], const Unit& u, int wr, int wc, int fr, int fq) const {
#pragma unroll
        for (int ai = 0; ai < 2; ++ai)
#pragma unroll
            for (int m = 0; m < 4; ++m) { const int row = u.pm * BM + ai * HALF + wr * 64 + m * 16 + fr;
                f32x4 o[2];
#pragma unroll
                for (int n = 0; n < 2; ++n) { const f32x4 a = acc[ai][0][m][n] * inscale, b = acc[ai][1][m][n] * inscale;
#pragma unroll
                    for (int i = 0; i < 4; ++i) o[n][i] = a[i] * sigmoidf_(a[i]) * b[i]; }
                if (out8) { u32x2 w8; w8.x = pack4_fp8(o[0][0], o[0][1], o[0][2], o[0][3]); w8.y = pack4_fp8(o[1][0], o[1][1], o[1][2], o[1][3]);
                    *(u32x2*)((unsigned char*)U + (size_t)row * ldu + u.pn * HALF + wc * 32 + 8 * fq) = w8; }
                else *(u32x4*)(U + (size_t)row * ldu + u.pn * HALF + wc * 32 + 8 * fq) = pack8(o[0], o[1]);
                __builtin_amdgcn_sched_barrier(0); }
    }
};

template <int STG_US = 0, bool FP8 = false, class Epi, class Sched, bool ALIGN_EPI = true>
__device__ __forceinline__ void gemm_phase(LAS unsigned char* lds, int tid_in, const Gemm g, const Sched& S, const Epi& E) {
    int tid_ = tid_in; asm volatile("" : "+v"(tid_));
    const int tid = tid_, wid = __builtin_amdgcn_readfirstlane(tid >> 6), lane = tid & 63, wr = wid >> 2, wc = wid & 3, fr = lane & 15, fq = lane >> 4;
    const int K = g.K, nt = K / BK, lda = g.lda;
    unsigned voffA[2], voffB[2];
#pragma unroll
    for (int i = 0; i < 2; ++i) { int R, C; stage_rc(tid * 16 + i * 8192, R, C);
        const int Rb = Epi::WIDE ? (64 * (R >> 5) + perm32(R & 31)) : (Epi::PERM ? ((R & ~31) + perm32(R & 31)) : R);
        voffA[i] = (unsigned)(R * lda + C) * 2u; voffB[i] = (unsigned)(Rb * K + C) * 2u; }
    const size_t kstep = (size_t)(BK * 2);
    constexpr bool GATHER = Sched::GATHER;
    unsigned oc[2], on[2], cb2[2];
    const size_t hstepA = (size_t)HALF * lda * 2, hstepB = Epi::WIDE ? (size_t)32 * K * 2 : (size_t)HALF * K * 2;
    const size_t tstepA = 2 * hstepA, tstepB = (size_t)BM * K * 2;
    const unsigned ldsw = (unsigned)wid * 1024u;
    const int aoff = lds_byte(wr * 64 + fr, FP8 ? fq * 16 : fq * 8), boff = lds_byte(wc * 32 + fr, FP8 ? fq * 16 : fq * 8);
#define PG8_SA(b, h) (((b) * 2 + (h)) * HTB)
#define PG8_SB(b, h) ((4 + (b) * 2 + (h)) * HTB)
#define PG8_STAGE(bufoff, gbase, voff) do { _Pragma("unroll") for (int _i = 0; _i < 2; ++_i) \
        __builtin_amdgcn_global_load_lds((const unsigned*)((const char*)(gbase) + (voff)[_i]), (LAS unsigned*)(lds + (bufoff) + ldsw + _i * 8192), 16, 0, 0); } while (0)
#define PG8_GOFF(dst, u) do { if constexpr (GATHER) { _Pragma("unroll") for (int h_ = 0; h_ < 2; ++h_) { unsigned pk_ = 0u; _Pragma("unroll") for (int i_ = 0; i_ < 2; ++i_) { int R_, C_; stage_rc(tid * 16 + i_ * 8192, R_, C_); \
        const int sl_ = S.rmap[(u).pm * BM + h_ * HALF + R_]; pk_ |= (unsigned)((sl_ < 0 ? 0 : sl_) >> 1) << (16 * i_); } dst[h_] = pk_; } } } while (0)
#define PG8_STAGE_A(bufoff, gptr, h, NXT) do { if constexpr (GATHER) { const unsigned pk_ = ((NXT) && last_) ? on[h] : oc[h]; \
        unsigned go_[2]; go_[0] = (pk_ & 0xffffu) * (unsigned)(lda * 2) + cb2[0]; go_[1] = (pk_ >> 16) * (unsigned)(lda * 2) + cb2[1]; PG8_STAGE(bufoff, gptr, go_); } \
        else PG8_STAGE(bufoff, (gptr) + (h) * hstepA, voffA); } while (0)
#define PG8_LDA(dst, b, h) do { if constexpr (FP8) { _Pragma("unroll") for (int m = 0; m < 4; ++m) { const i32x4_ lo_ = *(const LAS i32x4_*)(lds + PG8_SA(b, h) + aoff + m * 2048), hi_ = *(const LAS i32x4_*)(lds + PG8_SA(b, h) + aoff + m * 2048 + 16); \
        dst##8[m] = __builtin_shufflevector(lo_, hi_, 0, 1, 2, 3, 4, 5, 6, 7); } } \
    else { _Pragma("unroll") for (int m = 0; m < 4; ++m) _Pragma("unroll") for (int k = 0; k < 2; ++k) dst[m][k] = *(const LAS bf16x8*)(lds + PG8_SA(b, h) + aoff + m * 2048 + k * 1024); } } while (0)
#define PG8_LDB(dst, b, h) do { if constexpr (FP8) { _Pragma("unroll") for (int n = 0; n < 2; ++n) { const i32x4_ lo_ = *(const LAS i32x4_*)(lds + PG8_SB(b, h) + boff + n * 2048), hi_ = *(const LAS i32x4_*)(lds + PG8_SB(b, h) + boff + n * 2048 + 16); \
        dst##8[n] = __builtin_shufflevector(lo_, hi_, 0, 1, 2, 3, 4, 5, 6, 7); } } \
    else { _Pragma("unroll") for (int n = 0; n < 2; ++n) _Pragma("unroll") for (int k = 0; k < 2; ++k) dst[n][k] = *(const LAS bf16x8*)(lds + PG8_SB(b, h) + boff + n * 2048 + k * 1024); } } while (0)
#define PG8_MMA(ai, bj, At, Bt) do { __builtin_amdgcn_s_setprio(1); if constexpr (FP8) { _Pragma("unroll") for (int m = 0; m < 4; ++m) _Pragma("unroll") for (int n = 0; n < 2; ++n) \
        asm volatile("v_mfma_scale_f32_16x16x128_f8f6f4 %0, %1, %2, %0, %3, %3 op_sel_hi:[0,0,0]" : "+v"(acc[ai][bj][m][n]) : "v"(Bt##8[n]), "v"(At##8[m]), "v"(scl8)); } \
      else { _Pragma("unroll") for (int m = 0; m < 4; ++m) _Pragma("unroll") for (int n = 0; n < 2; ++n) _Pragma("unroll") for (int k = 0; k < 2; ++k) \
        acc[ai][bj][m][n] = __builtin_amdgcn_mfma_f32_16x16x32_bf16(Bt[n][k], At[m][k], acc[ai][bj][m][n], 0, 0, 0); } __builtin_amdgcn_s_setprio(0); } while (0)
#define PG8_WAIT_V(n) asm volatile("s_waitcnt vmcnt(" #n ")" ::: "memory")
#define PG8_WAIT_L(n) asm volatile("s_waitcnt lgkmcnt(" #n ")" ::: "memory")
#define PG8_BAR __builtin_amdgcn_s_barrier()
#define PG8_SCHED __builtin_amdgcn_sched_barrier(0)
    Unit cur, nxt; int ui = 0;
    if (!S.next(0, cur)) return;
    if (STG_US > 0 && blockIdx.x >= 128) { const unsigned long long t0_ = __builtin_amdgcn_s_memrealtime(); while (__builtin_amdgcn_s_memrealtime() - t0_ < (unsigned long long)(STG_US * 100)) __builtin_amdgcn_s_sleep(8); }
    f32x4 acc[2][2][4][2];
#pragma unroll
    for (int a = 0; a < 2; ++a)
#pragma unroll
        for (int b = 0; b < 2; ++b)
#pragma unroll
            for (int m = 0; m < 4; ++m)
#pragma unroll
                for (int n = 0; n < 2; ++n) acc[a][b][m][n] = (f32x4){0.f, 0.f, 0.f, 0.f};
    typedef int i32x4_ __attribute__((ext_vector_type(4))); typedef int i32x8_ __attribute__((ext_vector_type(8)));
    int scl8 = 0x7f7f7f7f; asm volatile("" : "+v"(scl8));
    bf16x8 At[4][2], B0[2][2], B1[2][2]; i32x8_ At8[4], B08[2], B18[2];
    const char* cA = (const char*)g.A + (GATHER ? (size_t)0 : (size_t)cur.pm * tstepA); const char* cB = (const char*)g.Bt + S.bofs(cur) + (size_t)cur.pn * tstepB;
    if constexpr (GATHER) { _Pragma("unroll") for (int i_ = 0; i_ < 2; ++i_) { int R_, C_; stage_rc(tid * 16 + i_ * 8192, R_, C_); cb2[i_] = (unsigned)C_ * 2u; } }
    PG8_GOFF(oc, cur); bool last_ = false;
    PG8_STAGE(PG8_SB(0, 0), cB, voffB); PG8_STAGE(PG8_SB(0, 1), cB + hstepB, voffB); PG8_STAGE_A(PG8_SA(0, 0), cA, 0, false); PG8_STAGE_A(PG8_SA(0, 1), cA, 1, false);
    if (wr == 1) PG8_BAR;
    PG8_WAIT_V(2); PG8_BAR;
    PG8_STAGE(PG8_SB(1, 0), cB + kstep, voffB); PG8_STAGE_A(PG8_SA(1, 0), cA + kstep, 0, false); PG8_STAGE(PG8_SB(1, 1), cB + hstepB + kstep, voffB);
    PG8_WAIT_V(6); PG8_BAR;
    for (;;) {
        const bool has_next = S.next(ui + 1, nxt);
        if (has_next) PG8_GOFF(on, nxt); else { if constexpr (GATHER) { on[0] = oc[0]; on[1] = oc[1]; } }
        const char* nA = (has_next && !GATHER) ? (const char*)g.A + (size_t)nxt.pm * tstepA : cA; const char* nB = has_next ? (const char*)g.Bt + S.bofs(nxt) + (size_t)nxt.pn * tstepB : cB;
        const int nte = (PROBE == 20) ? 2 * nt : nt;
#define PG8_KT(x) (((x) >= nt) ? (x) - nt : (x))
#pragma unroll 1
        for (int t = 0; t < nte; t += 2) {
            const bool last = (t == nte - 2); last_ = last;
            asm volatile("" : "+v"(voffA[0]), "+v"(voffA[1]), "+v"(voffB[0]), "+v"(voffB[1]));
            const char* a1 = cA + (size_t)PG8_KT(t + 1) * kstep;
            const char* a2 = last ? nA : cA + (size_t)PG8_KT(t + 2) * kstep; const char* b2 = last ? nB : cB + (size_t)PG8_KT(t + 2) * kstep;
            const char* a3 = a2 + kstep; const char* b3 = b2 + kstep;
            PG8_LDB(B0, 0, 0); PG8_LDB(B1, 0, 1); PG8_SCHED; PG8_LDA(At, 0, 0); PG8_STAGE_A(PG8_SA(1, 1), a1, 1, false);
            PG8_WAIT_V(8); PG8_WAIT_L(0); PG8_BAR; PG8_MMA(0, 0, At, B0); PG8_MMA(0, 1, At, B1); PG8_BAR; PG8_SCHED;
            PG8_LDA(At, 0, 1); PG8_STAGE(PG8_SB(0, 0), b2, voffB); PG8_STAGE(PG8_SB(0, 1), b2 + hstepB, voffB); PG8_STAGE_A(PG8_SA(0, 0), a2, 0, true);
            PG8_WAIT_V(8); PG8_WAIT_L(0); PG8_BAR; PG8_MMA(1, 0, At, B0); PG8_MMA(1, 1, At, B1); PG8_BAR; PG8_SCHED;
            PG8_LDB(B0, 1, 0); PG8_LDB(B1, 1, 1); PG8_SCHED; PG8_LDA(At, 1, 0); PG8_STAGE_A(PG8_SA(0, 1), a2, 1, true);
            PG8_WAIT_V(8); PG8_WAIT_L(0); PG8_BAR; PG8_MMA(0, 0, At, B0); PG8_MMA(0, 1, At, B1); PG8_BAR; PG8_SCHED;
            PG8_LDA(At, 1, 1); PG8_STAGE(PG8_SB(1, 0), b3, voffB); PG8_STAGE(PG8_SB(1, 1), b3 + hstepB, voffB); PG8_STAGE_A(PG8_SA(1, 0), a3, 0, true);
            PG8_WAIT_V(8); PG8_WAIT_L(0); PG8_BAR; PG8_MMA(1, 0, At, B0); PG8_MMA(1, 1, At, B1); PG8_BAR; PG8_SCHED;
        }
        if constexpr (FP8) asm volatile("s_nop 15\n\ts_nop 15" ::: "memory");
        if constexpr (ALIGN_EPI) { if (wr == 0) PG8_BAR; }
        if (PROBE == 20) {
#pragma unroll
            for (int a = 0; a < 2; ++a)
#pragma unroll
                for (int b = 0; b < 2; ++b)
#pragma unroll
                    for (int m = 0; m < 4; ++m)
#pragma unroll
                        for (int n = 0; n < 2; ++n) acc[a][b][m][n] = acc[a][b][m][n] * 0.5f; }
        _Pragma("unroll 1") for (int rep_ = 0; rep_ < (PROBE == 21 ? 2 : 1); ++rep_) { E(acc, cur, wr, wc, fr, fq); if (PROBE == 21) asm volatile("" ::: "memory"); }
        if (!has_next) break;
#pragma unroll
        for (int a = 0; a < 2; ++a)
#pragma unroll
            for (int b = 0; b < 2; ++b)
#pragma unroll
                for (int m = 0; m < 4; ++m)
#pragma unroll
                    for (int n = 0; n < 2; ++n) acc[a][b][m][n] = (f32x4){0.f, 0.f, 0.f, 0.f};
        cur = nxt; cA = nA; cB = nB; ++ui;
        if constexpr (GATHER) { oc[0] = on[0]; oc[1] = on[1]; }
        if constexpr (ALIGN_EPI) { if (wr == 1) PG8_BAR; }
    }
    PG8_WAIT_V(0);
    if constexpr (!ALIGN_EPI) { if (wr == 0) PG8_BAR; }
    PG8_BAR;
#undef PG8_KT
#undef PG8_GOFF
#undef PG8_STAGE_A
#undef PG8_SA
#undef PG8_SB
#undef PG8_STAGE
#undef PG8_LDA
#undef PG8_LDB
#undef PG8_MMA
#undef PG8_WAIT_V
#undef PG8_WAIT_L
#undef PG8_BAR
#undef PG8_SCHED
}
}

namespace att {
constexpr int NW = 8, QBLK = 32, KVBLK = 64;
constexpr float THR = 11.5f;
constexpr size_t SHM_V = 16384, SHM_K = 16384;
constexpr size_t OFF_RAW = 101120, OFF_R32 = OFF_RAW + 2048 * 4;
constexpr size_t OFF_V = 0, OFF_K = 3 * SHM_V, OFF_WS = OFF_K + 2 * SHM_K, OFF_POS = OFF_WS + NW * 64 * 4, OFF_NCL = OFF_POS + SEQ * 4, OFF_ZER = OFF_NCL + SEQ * 4, OFF_EXT = OFF_ZER + 256, ATT_LDS = OFF_EXT + 512;
static_assert(ATT_LDS == 101120, "attention LDS layout");
#define KSWZ(row, colB) ((row) * 256 + ((colB) ^ (((row) & 15) << 4)))
#define SBAR() __builtin_amdgcn_sched_barrier(0)
__device__ __forceinline__ int crow(int r, int hi) { return (r & 3) + 8 * (r >> 2) + 4 * hi; }
__device__ __forceinline__ unsigned cvtpk(float lo, float hi) { return cvt_pk_bf16(lo, hi); }
__device__ __forceinline__ unsigned char cvt_fp8_1(float v) { v = __builtin_amdgcn_fmed3f(v, -448.0f, 448.0f); return (unsigned char)(__builtin_amdgcn_cvt_pk_fp8_f32(v, v, 0, false) & 0xff); }

__device__ __forceinline__ void partialSM(f32x16& p0, f32x16& p1, float& m_reg, float& mn, float& alpha) {
  float pmax = p0[0];
#pragma unroll
  for (int r = 1; r < 16; ++r) pmax = fmaxf(pmax, p0[r]);
#pragma unroll
  for (int r = 0; r < 16; ++r) pmax = fmaxf(pmax, p1[r]);
  { auto rr = __builtin_amdgcn_permlane32_swap(__float_as_uint(pmax), __float_as_uint(pmax), false, false);
    pmax = fmaxf(__uint_as_float(rr[0]), __uint_as_float(rr[1])); }
  if (__builtin_expect(__all(pmax - m_reg <= THR), 1)) { mn = m_reg; alpha = 1.f; }
  else { mn = fmaxf(m_reg, pmax); alpha = __builtin_amdgcn_exp2f(m_reg - mn); m_reg = mn; }
#pragma unroll
  for (int r = 0; r < 16; ++r) p0[r] = p0[r] - mn;
#pragma unroll
  for (int r = 0; r < 16; ++r) p1[r] = p1[r] - mn;
#pragma unroll
  for (int r = 0; r < 16; ++r) p0[r] = __builtin_amdgcn_exp2f(p0[r]);
}
__device__ __forceinline__ bool partialSM_adj(f32x16& p0, f32x16& p1, float& m_reg, float& mn, float& alpha, float radj, float skip_th) {
  float pmax = p0[0];
#pragma unroll
  for (int r = 1; r < 16; ++r) pmax = fmaxf(pmax, p0[r]);
#pragma unroll
  for (int r = 0; r < 16; ++r) pmax = fmaxf(pmax, p1[r]);
  { auto rr = __builtin_amdgcn_permlane32_swap(__float_as_uint(pmax), __float_as_uint(pmax), false, false);
    pmax = fmaxf(__uint_as_float(rr[0]), __uint_as_float(rr[1])); }
  pmax += radj;
  if (__all(pmax < m_reg - skip_th)) { mn = m_reg; alpha = 1.f; return true; }
  if (__builtin_expect(__all(pmax - m_reg <= THR), 1)) { mn = m_reg; alpha = 1.f; }
  else { mn = fmaxf(m_reg, pmax); alpha = __builtin_amdgcn_exp2f(m_reg - mn); m_reg = mn; }
  const float off = mn - radj;
#pragma unroll
  for (int r = 0; r < 16; ++r) p0[r] = p0[r] - off;
#pragma unroll
  for (int r = 0; r < 16; ++r) p1[r] = p1[r] - off;
#pragma unroll
  for (int r = 0; r < 16; ++r) p0[r] = __builtin_amdgcn_exp2f(p0[r]);
  return false;
}
__device__ __forceinline__ void partialSM_rel(f32x16& p0, f32x16& p1, float& m_reg, f32x16& negm, float& alpha, bool first) {
  float pmax = p0[0];
#pragma unroll
  for (int r = 1; r < 16; ++r) pmax = fmaxf(pmax, p0[r]);
#pragma unroll
  for (int r = 0; r < 16; ++r) pmax = fmaxf(pmax, p1[r]);
  { auto rr = __builtin_amdgcn_permlane32_swap(__float_as_uint(pmax), __float_as_uint(pmax), false, false);
    pmax = fmaxf(__uint_as_float(rr[0]), __uint_as_float(rr[1])); }
  if (__builtin_expect(!first && __all(pmax <= THR), 1)) { alpha = 1.f; }
  else { const float dl = first ? pmax : fmaxf(pmax, 0.f); m_reg += dl; alpha = first ? 0.f : __builtin_amdgcn_exp2f(-dl);
#pragma unroll
    for (int r = 0; r < 16; ++r) { p0[r] -= dl; p1[r] -= dl; }
#pragma unroll
    for (int r = 0; r < 16; ++r) negm[r] = -m_reg;
    asm volatile("" : "+v"(negm)); }
#pragma unroll
  for (int r = 0; r < 16; ++r) p0[r] = __builtin_amdgcn_exp2f(p0[r]);
}
__device__ __forceinline__ void finishSM(f32x16& p0, f32x16& p1, float alpha, float& l_reg, bf16x8& pa0, bf16x8& pa1, bf16x8& pa2, bf16x8& pa3) {
#pragma unroll
  for (int r = 0; r < 16; ++r) p1[r] = __builtin_amdgcn_exp2f(p1[r]);
  float ps = 0;
#pragma unroll
  for (int r = 0; r < 16; ++r) ps += p0[r];
#pragma unroll
  for (int r = 0; r < 16; ++r) ps += p1[r];
  { auto rr = __builtin_amdgcn_permlane32_swap(__float_as_uint(ps), __float_as_uint(ps), false, false);
    ps = __uint_as_float(rr[0]) + __uint_as_float(rr[1]); }
  l_reg = l_reg * alpha + ps;
#define PK4(P, BASE, OUT) do { unsigned a0 = cvtpk(P[BASE + 0], P[BASE + 1]), a1 = cvtpk(P[BASE + 2], P[BASE + 3]);   \
    unsigned b0 = cvtpk(P[BASE + 4], P[BASE + 5]), b1 = cvtpk(P[BASE + 6], P[BASE + 7]);                              \
    auto r0 = __builtin_amdgcn_permlane32_swap(a0, b0, false, false); auto r1 = __builtin_amdgcn_permlane32_swap(a1, b1, false, false); \
    u32x4 w = {r0[0], r1[0], r0[1], r1[1]}; OUT = *reinterpret_cast<bf16x8*>(&w); } while (0)
  PK4(p0, 0, pa0); PK4(p0, 8, pa1); PK4(p1, 0, pa2); PK4(p1, 8, pa3);
#undef PK4
}
template <int NQK> __device__ __forceinline__ void qkt(f32x16& p0, f32x16& p1, const char* Ks, const bf16x8* qr, int r32, int hi, int colb0) {
#pragma unroll
  for (int d0 = 0; d0 < NQK; ++d0) { const int cb = colb0 + (d0 * 16 + hi * 8) * 2;
    bf16x8 b0 = *reinterpret_cast<const bf16x8*>(Ks + KSWZ(r32, cb));
    bf16x8 b1 = *reinterpret_cast<const bf16x8*>(Ks + KSWZ(32 + r32, cb));
    p0 = __builtin_amdgcn_mfma_f32_32x32x16_bf16(b0, qr[d0], p0, 0, 0, 0);
    p1 = __builtin_amdgcn_mfma_f32_32x32x16_bf16(b1, qr[d0], p1, 0, 0, 0); }
}
template <int NCB> __device__ __forceinline__ int v_st(int k, int c) { const int kk = (k & ~0xC) | ((k & 4) << 1) | ((k & 8) >> 1); return ((kk >> 3) * NCB + (c >> 5)) * 512 + ((kk & 7) * 32 + (c & 31)) * 2; }
__device__ __forceinline__ int v_rd_base(int lane) { return ((lane & 3) << 3) | (((lane >> 2) & 3) << 6) | (((lane >> 4) & 1) << 5) | (((lane >> 5) & 1) << 8); }
template <int NCB> constexpr int v_rd_off(int d0, int ks, int half) { return d0 * 512 + (2 * ks + half) * NCB * 512; }
template <int OFF> __device__ __forceinline__ s16x4 tr_read(int vb) { s16x4 r; asm volatile("ds_read_b64_tr_b16 %0, %1 offset:%2" : "=&v"(r) : "v"(vb), "i"(OFF) : "memory"); return r; }
template <int NCB, int D0> __device__ __forceinline__ void pv_one(f32x16& od, int vb, bf16x8 pa0, bf16x8 pa1, bf16x8 pa2, bf16x8 pa3) {
  const s16x4 l0 = tr_read<v_rd_off<NCB>(D0, 0, 0)>(vb), h0 = tr_read<v_rd_off<NCB>(D0, 0, 1)>(vb), l1 = tr_read<v_rd_off<NCB>(D0, 1, 0)>(vb), h1 = tr_read<v_rd_off<NCB>(D0, 1, 1)>(vb);
  const s16x4 l2 = tr_read<v_rd_off<NCB>(D0, 2, 0)>(vb), h2 = tr_read<v_rd_off<NCB>(D0, 2, 1)>(vb), l3 = tr_read<v_rd_off<NCB>(D0, 3, 0)>(vb), h3 = tr_read<v_rd_off<NCB>(D0, 3, 1)>(vb);
  asm volatile("s_waitcnt lgkmcnt(0)" ::: "memory"); SBAR();
#define PK(L, H) (bf16x8){L[0], L[1], L[2], L[3], H[0], H[1], H[2], H[3]}
  od = __builtin_amdgcn_mfma_f32_32x32x16_bf16(pa0, PK(l0, h0), od, 0, 0, 0);
  od = __builtin_amdgcn_mfma_f32_32x32x16_bf16(pa1, PK(l1, h1), od, 0, 0, 0);
  od = __builtin_amdgcn_mfma_f32_32x32x16_bf16(pa2, PK(l2, h2), od, 0, 0, 0);
  od = __builtin_amdgcn_mfma_f32_32x32x16_bf16(pa3, PK(l3, h3), od, 0, 0, 0);
#undef PK
}
template <int NCB> __device__ __forceinline__ void pv_all(f32x16* o, int vb, bf16x8 pa0, bf16x8 pa1, bf16x8 pa2, bf16x8 pa3) {
  pv_one<NCB, 0>(o[0], vb, pa0, pa1, pa2, pa3); pv_one<NCB, 1>(o[1], vb, pa0, pa1, pa2, pa3);
  if constexpr (NCB == 4) { pv_one<NCB, 2>(o[2], vb, pa0, pa1, pa2, pa3); pv_one<NCB, 3>(o[3], vb, pa0, pa1, pa2, pa3); }
}
__device__ __forceinline__ void alibi(f32x16& p0, f32x16& p1, const float* cl, int k0, int hi, float rl) {
  const float* pk = cl + k0 + 4 * hi;
#pragma unroll
  for (int g = 0; g < 4; ++g) { const f32x4 a = *(const f32x4*)(pk + 8 * g), b = *(const f32x4*)(pk + 32 + 8 * g);
#pragma unroll
    for (int i = 0; i < 4; ++i) { p0[4 * g + i] -= fabsf(rl - a[i]); p1[4 * g + i] -= fabsf(rl - b[i]); } }
}
__device__ __forceinline__ void load_c(f32x16& p0, f32x16& p1, const float* cp, int hi) {
  const float* pk = cp + 4 * hi;
#pragma unroll
  for (int g = 0; g < 4; ++g) { const f32x4 a = *(const f32x4*)(pk + 8 * g), b = *(const f32x4*)(pk + 32 + 8 * g);
#pragma unroll
    for (int i = 0; i < 4; ++i) { p0[4 * g + i] = a[i]; p1[4 * g + i] = b[i]; } }
}

__device__ __forceinline__ float wmin64(float v) { v = fminf(v, swz_xor<1>(v)); v = fminf(v, swz_xor<2>(v)); v = fminf(v, swz_xor<4>(v)); v = fminf(v, swz_xor<8>(v)); v = fminf(v, swz_xor<16>(v));
  auto rr = __builtin_amdgcn_permlane32_swap(__float_as_uint(v), __float_as_uint(v), false, false); return fminf(__uint_as_float(rr[0]), __uint_as_float(rr[1])); }
__device__ __forceinline__ float wmax64(float v) { v = fmaxf(v, swz_xor<1>(v)); v = fmaxf(v, swz_xor<2>(v)); v = fmaxf(v, swz_xor<4>(v)); v = fmaxf(v, swz_xor<8>(v)); v = fmaxf(v, swz_xor<16>(v));
  auto rr = __builtin_amdgcn_permlane32_swap(__float_as_uint(v), __float_as_uint(v), false, false); return fmaxf(__uint_as_float(rr[0]), __uint_as_float(rr[1])); }
constexpr float SKIP_TH = 20.f;
struct DiffArgs { const int* pos; float sl; float lam; float oscale; const float* ng; float kmax2; };

__device__ __forceinline__ void diff_pos_setup(const int* __restrict__ pos, char* lds, int tid) {
  float* rawp = (float*)(lds + OFF_RAW); float* r32t = (float*)(lds + OFF_R32);
  const int p0 = pos[0];
  for (int i = tid; i < SEQ; i += NW * 64) { const float v = (float)(pos[i] - p0); rawp[i] = v;
    float mn = v, mx = v;
    mn = fminf(mn, swz_xor<1>(mn)); mn = fminf(mn, swz_xor<2>(mn)); mn = fminf(mn, swz_xor<4>(mn)); mn = fminf(mn, swz_xor<8>(mn)); mn = fminf(mn, swz_xor<16>(mn));
    mx = fmaxf(mx, swz_xor<1>(mx)); mx = fmaxf(mx, swz_xor<2>(mx)); mx = fmaxf(mx, swz_xor<4>(mx)); mx = fmaxf(mx, swz_xor<8>(mx)); mx = fmaxf(mx, swz_xor<16>(mx));
    if ((tid & 31) == 0) { r32t[i >> 5] = mn; r32t[64 + (i >> 5)] = mx; } }
  __syncthreads();
}
template <bool DIFF>
__device__ __forceinline__ void attn_unit(const bf16_t* __restrict__ Qb, const bf16_t* __restrict__ Kh, const bf16_t* __restrict__ Vh, unsigned char* __restrict__ Ob, int q0, const DiffArgs da, char* lds, LAS unsigned char* ldsl, int tid_in) {
  constexpr int LDQ = DIFF ? 1024 : 768, LDK = DIFF ? 1024 : 768, LDV = DIFF ? 1024 : 512, LDO = DIFF ? 1024 : 512;
  constexpr int NQK = DIFF ? 4 : 6, NDV = DIFF ? 4 : 2, KCH = DIFF ? 16 : 12, NVP = DIFF ? 2 : 1;
  int tid_ = tid_in; asm volatile("" : "+v"(tid_));
  const int tid = tid_, wid = __builtin_amdgcn_readfirstlane(tid >> 6), lane = tid & 63, r32 = lane & 31, hi = lane >> 5;
  const int mp = DIFF ? (wid >> 2) : 0, wrow = DIFF ? (wid & 3) * QBLK : wid * QBLK;
  char* V_lds = lds + OFF_V; char* K_lds = lds + OFF_K;
  float* ws = (float*)(lds + OFF_WS) + wid * 64; float* li_l = ws; float* al_l = ws + 32;
  float* posl = (float*)(lds + OFF_POS);
  float* ncl = (float*)(lds + OFF_NCL); float* zer = (float*)(lds + OFF_ZER);
  float m_reg = DIFF ? -1e30f : 0.f, l_reg = 0; bool first = true; f32x16 o[NDV]; bf16x8 qr[NQK];
#pragma unroll
  for (int d = 0; d < NDV; ++d) o[d] = f32x16{};
  unsigned koff[2]; bool kact[2]; unsigned voff[NVP];
#pragma unroll
  for (int i = 0; i < 2; ++i) { const int piece = wid + 8 * i, row = 4 * piece + (lane >> 4), pos = lane & 15, chunk = pos ^ (row & 15); kact[i] = chunk < KCH; koff[i] = (unsigned)(row * LDK + chunk * 8); }
#pragma unroll
  for (int i = 0; i < NVP; ++i) { const int q = (wid + 8 * i) * 64 + lane, st = q >> 5, kkhi = st / NDV, cblk = st % NDV, kk = kkhi * 8 + ((q & 31) >> 2), cc = q & 3;
    const int key = (kk & ~0xC) | ((kk & 4) << 1) | ((kk & 8) >> 1); voff[i] = (unsigned)(key * LDV + cblk * 32 + cc * 8); }
  const int vb0 = (int)(uintptr_t)V_lds + v_rd_base(lane);
  const int kcol0 = mp * 128;
  LAS unsigned char* Kl = ldsl + OFF_K + wid * 1024; LAS unsigned char* Vl = ldsl + OFF_V + wid * 1024;
#define DMA_K(buf, k0) do { _Pragma("unroll") for (int i_ = 0; i_ < 2; ++i_) if (kact[i_]) \
    __builtin_amdgcn_global_load_lds((const unsigned*)(Kh + (size_t)(k0) * LDK + koff[i_]), (LAS unsigned*)(Kl + (buf) * SHM_K + i_ * 8192), 16, 0, 0); } while (0)
#define DMA_V(bufoff, k0) do { _Pragma("unroll") for (int i_ = 0; i_ < NVP; ++i_) \
    __builtin_amdgcn_global_load_lds((const unsigned*)(Vh + (size_t)(k0) * LDV + voff[i_]), (LAS unsigned*)(Vl + (bufoff) + i_ * 8192), 16, 0, 0); } while (0)
#define TILE_BAR() do { asm volatile("s_waitcnt vmcnt(0) lgkmcnt(0)" ::: "memory"); __builtin_amdgcn_s_barrier(); asm volatile("" ::: "memory"); } while (0)
  const bf16_t* Qw = Qb + (long)(wrow + r32) * LDQ + mp * 64 + hi * 8;
#pragma unroll
  for (int d0 = 0; d0 < NQK; ++d0) qr[d0] = *reinterpret_cast<const bf16x8*>(Qw + d0 * 16);
  if constexpr (DIFF) {
    __syncthreads();
    DMA_K(0, ((q0 >> 6) + 0) * KVBLK); DMA_V(0, ((q0 >> 6) + 0) * KVBLK); DMA_K(1, ((q0 >> 6) + 1) * KVBLK); DMA_V((int)SHM_V, ((q0 >> 6) + 1) * KVBLK);
  }
  float pq = 0.f;
  float* ext = (float*)(lds + OFF_EXT);
  float wqmin = 0.f, wqmax = 0.f;
  if constexpr (DIFF) {
    const float* rawp = (const float*)(lds + OFF_RAW); const float* r32t = (const float*)(lds + OFF_R32);
    const float bp = rawp[q0];
    for (int i = tid; i < SEQ; i += NW * 64) { const float c = da.sl * (rawp[i] - bp); posl[i] = c; ncl[i] = -c; }
    if (tid < 64) zer[tid] = 0.f;
    pq = da.sl * (rawp[q0 + wrow + r32] - bp);
    if (wid == 0) { const int t = lane & 31; const float v = (lane < 32) ? fminf(r32t[2 * t], r32t[2 * t + 1]) : fmaxf(r32t[64 + 2 * t], r32t[64 + 2 * t + 1]); ext[lane] = da.sl * (v - bp); }
    { const int g = (q0 + wrow) >> 5; wqmin = da.sl * (r32t[g] - bp); wqmax = da.sl * (r32t[64 + g] - bp); }
    { float qs = 0.f;
#pragma unroll
      for (int d0 = 0; d0 < NQK; ++d0)
#pragma unroll
        for (int e = 0; e < 8; ++e) { const float f = bf2f((bf16_t)qr[d0][e]); qs += f * f; }
      qs = sum_x32(qs); qs = wmax64(qs); if (lane == 0) ext[64 + wid] = qs; }
  }
#define RESC(a) do { if (__any((a) < 1.f)) { if (hi == 0) al_l[r32] = (a); asm volatile("s_waitcnt lgkmcnt(0)" ::: "memory"); \
    _Pragma("unroll") for (int d = 0; d < NDV; ++d) _Pragma("unroll") for (int r = 0; r < 16; ++r) o[d][r] *= al_l[crow(r, hi)]; } } while (0)
  f32x16 negm;
#pragma unroll
  for (int r = 0; r < 16; ++r) negm[r] = 0.f;
#define QK(P0, P1, RADJ, MODE, KBUF, k0) do { \
    if constexpr (DIFF) { const int t_ = (k0) >> 6; const float tmn_ = ext[t_], tmx_ = ext[32 + t_]; \
      const int mode_ = __builtin_amdgcn_readfirstlane((tmx_ <= wqmin) ? 1 : ((tmn_ >= wqmax) ? 2 : 0)); \
      const float* cp_ = mode_ == 0 ? zer : (mode_ == 1 ? posl + (k0) : ncl + (k0)); \
      load_c(P0, P1, cp_, hi); RADJ = mode_ == 1 ? -pq : (mode_ == 2 ? pq : 0.f); MODE = mode_; \
      qkt<NQK>(P0, P1, KBUF, qr, r32, hi, kcol0); \
    } else { P0 = negm; P1 = negm; qkt<NQK>(P0, P1, KBUF, qr, r32, hi, kcol0); } } while (0)
#define PSM(P0, P1, MN, AL, RADJ, MODE, K0, SK) do { if constexpr (DIFF) { if (MODE == 0) alibi(P0, P1, posl, (K0), hi, pq); SK = partialSM_adj(P0, P1, m_reg, MN, AL, RADJ, SKIP_TH); } else { partialSM_rel(P0, P1, m_reg, negm, AL, first); first = false; } } while (0)
  f32x16 pA0, pA1, pB0, pB1; float mnA = 0.f, mnB = 0.f, alA, alB, raA = 0.f, raB = 0.f; int mdA = 0, mdB = 0; bf16x8 pa0, pa1, pa2, pa3; constexpr int NTALL = SEQ / KVBLK;
  int td0 = 0, lo = 0, hiT = NTALL; float Bq = 0.f, qpmin = 0.f, qpmax = 0.f;
  if constexpr (DIFF) {
    __syncthreads();
    td0 = q0 >> 6; qpmin = fminf(ext[td0], ext[td0 + 1]); qpmax = fmaxf(ext[32 + td0], ext[32 + td0 + 1]);
    float q2 = ext[64];
#pragma unroll
    for (int w = 1; w < 8; ++w) q2 = fmaxf(q2, ext[64 + w]);
    Bq = sqrtf(q2 * da.kmax2); td0 = q0 >> 6;
  }
  for (int rg = 0; rg < (DIFF ? 2 : 1); ++rg) {
  int t0 = 0, NT = NTALL;
  if constexpr (DIFF) {
    if (rg == 0) { t0 = td0; NT = 2; }
    else {
      const float mm = wmin64(m_reg); if (lane == 0) ext[72 + wid] = mm; __syncthreads();
      float mmin = ext[72];
#pragma unroll
      for (int w = 1; w < 8; ++w) mmin = fminf(mmin, ext[72 + w]);
      const float thr = Bq - mmin + SKIP_TH;
      { const int t = lane & 31; const float dmin = fmaxf(0.f, fmaxf(ext[t] - qpmax, qpmin - ext[32 + t]));
        const unsigned keep = (unsigned)__ballot(dmin <= thr) | (3u << td0);
        lo = __builtin_ctz(keep); hiT = 32 - __builtin_clz(keep); }
      lo = __builtin_amdgcn_readfirstlane(lo & ~1); hiT = __builtin_amdgcn_readfirstlane((hiT + 1) & ~1);
      t0 = lo; NT = hiT - lo - 2;
    }
    if (NT <= 0) continue;
  }
#define TK(j) ((DIFF && rg == 1 && t0 + (j) >= td0 ? t0 + (j) + 2 : t0 + (j)) * KVBLK)
  int vprev = 0, vcur = (int)SHM_V, vnext = 2 * (int)SHM_V;
  if (!DIFF || rg == 1) {
    __syncthreads();
    DMA_K(0, TK(0)); DMA_V(0, TK(0)); DMA_K(1, TK(1)); DMA_V((int)SHM_V, TK(1)); }
  TILE_BAR();
  bool skA = false, skB = false;
  QK(pA0, pA1, raA, mdA, K_lds, TK(0)); PSM(pA0, pA1, mnA, alA, raA, mdA, TK(0), skA);
  TILE_BAR();
#define ROT() do { const int t_ = vprev; vprev = vcur; vcur = vnext; vnext = t_; } while (0)
  for (int j = 1; j + 1 < NT; j += 2) {
    DMA_K(0, TK(j + 1)); DMA_V(vnext, TK(j + 1));
    SBAR(); QK(pB0, pB1, raB, mdB, K_lds + SHM_K, TK(j));
    if (!skA) { finishSM(pA0, pA1, alA, l_reg, pa0, pa1, pa2, pa3); SBAR();
                pv_all<NDV>(o, vb0 + vprev, pa0, pa1, pa2, pa3); }
    PSM(pB0, pB1, mnB, alB, raB, mdB, TK(j), skB);
    RESC(alB); TILE_BAR(); ROT();
    if (j + 2 < NT) { DMA_K(1, TK(j + 2)); DMA_V(vnext, TK(j + 2)); }
    SBAR(); QK(pA0, pA1, raA, mdA, K_lds, TK(j + 1));
    if (!skB) { finishSM(pB0, pB1, alB, l_reg, pa0, pa1, pa2, pa3); SBAR();
                pv_all<NDV>(o, vb0 + vprev, pa0, pa1, pa2, pa3); }
    PSM(pA0, pA1, mnA, alA, raA, mdA, TK(j + 1), skA);
    RESC(alA); TILE_BAR(); ROT();
  }
  SBAR(); QK(pB0, pB1, raB, mdB, K_lds + SHM_K, TK(NT - 1));
  if (!skA) { finishSM(pA0, pA1, alA, l_reg, pa0, pa1, pa2, pa3); SBAR();
              pv_all<NDV>(o, vb0 + vprev, pa0, pa1, pa2, pa3); }
  PSM(pB0, pB1, mnB, alB, raB, mdB, TK(NT - 1), skB);
  RESC(alB);
  if (!skB) { finishSM(pB0, pB1, alB, l_reg, pa0, pa1, pa2, pa3); SBAR();
              pv_all<NDV>(o, vb0 + vcur, pa0, pa1, pa2, pa3); }
#undef TK
#undef ROT
  }
  if (hi == 0) li_l[r32] = l_reg; asm volatile("s_waitcnt lgkmcnt(0)" ::: "memory");
  float rli[16];
#pragma unroll
  for (int r = 0; r < 16; ++r) rli[r] = __builtin_amdgcn_rcpf(li_l[crow(r, hi)]);
  if constexpr (!DIFF) {
    __syncthreads();
    LAS float* blk = (LAS float*)(ldsl + wid * 9216);
#pragma unroll
    for (int r = 0; r < 16; ++r) { const int orow = crow(r, hi);
#pragma unroll
      for (int d0 = 0; d0 < NDV; ++d0) blk[orow * 72 + d0 * 36 + r32] = o[d0][r] * (rli[r] * O8_SCALE); }
    asm volatile("s_waitcnt lgkmcnt(0)" ::: "memory");
    const int row = lane >> 1, half = lane & 1; const LAS float* rp = blk + row * 72 + half * 36;
    unsigned char* Op = Ob + (long)(wrow + row) * LDO + half * 32;
#pragma unroll
    for (int j4 = 0; j4 < 2; ++j4) { u32x4 w;
#pragma unroll
      for (int k = 0; k < 4; ++k) { const f32x4 y = *(const LAS f32x4*)(rp + 4 * (4 * j4 + k)); w[k] = pack4_fp8(y[0], y[1], y[2], y[3]); }
      *(u32x4*)(Op + 16 * j4) = w; }
  } else {
    __syncthreads();
    LAS float* blk = (LAS float*)(ldsl + (wid & 3) * 17408);
#define BIDX(orow, d0) ((orow) * 136 + ((d0) >> 1) * 68 + ((d0) & 1) * 32 + r32)
    if (mp == 1) {
#pragma unroll
      for (int r = 0; r < 16; ++r) { const int orow = crow(r, hi);
#pragma unroll
        for (int d0 = 0; d0 < 4; ++d0) blk[BIDX(orow, d0)] = o[d0][r] * rli[r]; }
    }
    __syncthreads();
    if (mp == 0) {
#pragma unroll
      for (int r = 0; r < 16; ++r) { const int orow = crow(r, hi);
#pragma unroll
        for (int d0 = 0; d0 < 4; ++d0) { LAS float* p = blk + BIDX(orow, d0); *p = o[d0][r] * rli[r] - da.lam * *p; } }
      asm volatile("s_waitcnt lgkmcnt(0)" ::: "memory");
      const int row = lane >> 1, half = lane & 1; const LAS float* rp = blk + row * 136 + half * 68;
      f32x4 v[16]; float s = 0.f;
#pragma unroll
      for (int j = 0; j < 16; ++j) { v[j] = *(const LAS f32x4*)(rp + 4 * j); s += (v[j][0] * v[j][0] + v[j][1] * v[j][1]) + (v[j][2] * v[j][2] + v[j][3] * v[j][3]); }
      s += swz_xor<1>(s);
      const float sc = da.oscale * O8_SCALE * __builtin_amdgcn_rsqf(s * (1.0f / 128.0f) + RMS_EPS);
      unsigned char* Op = Ob + (long)(wrow + row) * LDO + half * 64;
#pragma unroll
      for (int j4 = 0; j4 < 4; ++j4) { u32x4 w;
#pragma unroll
        for (int k = 0; k < 4; ++k) { const int j = 4 * j4 + k; const f32x4 g = *(const f32x4*)(da.ng + half * 64 + 4 * j); const f32x4 y = v[j] * sc * g; w[k] = pack4_fp8(y[0], y[1], y[2], y[3]); }
        *(u32x4*)(Op + 16 * j4) = w; }
    }
#undef BIDX
  }
#undef DMA_K
#undef DMA_V
#undef TILE_BAR
#undef RESC
#undef QK
#undef PSM
}
#undef KSWZ
#undef SBAR
}

constexpr size_t MiB = 1u << 20;
constexpr size_t WS_CTL = 0, CTL_ZERO_BYTES = 1 * MiB;
constexpr size_t WS_MOD = 1 * MiB;
constexpr size_t WS_RSQ = 3 * MiB;
constexpr size_t WS_COS = 6 * MiB;
constexpr size_t WS_SIN = 8 * MiB;
constexpr size_t WS_SEL = 10 * MiB;
constexpr size_t WS_GATE = 10 * MiB + 256 * 1024;
constexpr size_t WS_RMAP = 11 * MiB;
constexpr size_t WS_WMIX = 12 * MiB;
constexpr size_t W_IN = WS_WMIX, W_QUP = W_IN + (size_t)NZ * 1024 * 2, W_KVUP = W_QUP + 768 * 384 * 2, W_BRM = W_KVUP + 1024 * 256 * 2, W_BRD = W_BRM + 1024 * 512 * 2, W_OUT = W_BRD + 1024 * 1024 * 2;
constexpr size_t WS_WFF = 30 * MiB;
constexpr size_t W2_ESTRIDE8 = (size_t)1024 * 2816;
constexpr size_t W13_ESTRIDE8 = (size_t)5632 * 1024;
constexpr size_t W13_ESTRIDE = (size_t)5632 * 1024 * 2, W2_ESTRIDE = (size_t)1024 * 2816 * 2, W2_BASE = WS_WFF + 8 * W13_ESTRIDE;
constexpr size_t WS_ACT = 162 * MiB;
constexpr size_t WS_H = WS_ACT;
constexpr size_t WS_LAT = WS_H + 64 * MiB;
constexpr size_t WS_ZB = WS_LAT + 48 * MiB;
constexpr size_t WS_QM = WS_ZB + 320 * MiB;
constexpr size_t WS_KM = WS_QM + 48 * MiB;
constexpr size_t WS_VM = WS_KM + 48 * MiB;
constexpr size_t WS_OM = WS_VM + 32 * MiB;
constexpr size_t WS_END = WS_OM + 32 * MiB;
constexpr size_t WS_PRE = WS_QM;
constexpr size_t WS_PART = WS_QM;
constexpr size_t WS_T1 = WS_ZB + 64 * MiB;
constexpr size_t WS_MB = WS_ZB + 128 * MiB;
constexpr size_t WS_DO8 = WS_ZB + 224 * MiB;
constexpr size_t WS_U = WS_LAT;
constexpr size_t WS_XB = WS_LAT;
constexpr size_t WS_Y = WS_LAT;
constexpr size_t WS_UM = WS_LAT + 132 * MiB;
static_assert(WS_UM + (size_t)67584 * 2816 * 2 <= WS_END + 64 * MiB, "ws map");
constexpr size_t WS_WIN8 = WS_END + 96 * MiB;
constexpr size_t WS_H8 = WS_OM;
constexpr size_t WS_XRES = WS_END + 16 * MiB;
constexpr size_t WS_NEED = WS_END + 104 * MiB;
constexpr int CW_BAR = 4096;
constexpr int CW_CNT = 8192;
constexpr int CW_CUR = 8192 + 256;
constexpr int CW_KMAX = 16384;

constexpr int RING_BYTES = 131072, LDSCTL_OFF = RING_BYTES, MISC_OFF = LDSCTL_OFF + 320, LDS_BYTES = 147456;
constexpr int NWAVES = 8;

#define XB_TMO      128
#define XB_XCNT(j)  (256  + 64 * (j))
#define XB_XSUB(j)  (1280 + 64 * (j))
#define XB_XGEN(j)  (2304 + 64 * (j))
#define XB_TOP      3328
#define XB_TOPGEN   3392
#define XCD_BAR_WORDS 3456
#define XB_SPIN_CAP (1u << 18)
__device__ __forceinline__ unsigned xb_ld(unsigned* p)              { return __hip_atomic_load(p, __ATOMIC_RELAXED, __HIP_MEMORY_SCOPE_AGENT); }
__device__ __forceinline__ unsigned xb_add(unsigned* p, unsigned v) { return __hip_atomic_fetch_add(p, v, __ATOMIC_RELAXED, __HIP_MEMORY_SCOPE_AGENT); }
__device__ __forceinline__ unsigned xb_xcc_id() { return (unsigned)__builtin_amdgcn_s_getreg((3 << 11) | 20) & 0xFu; }
#define XB_SPIN(cond, bar) do { unsigned _sp = 0; while (cond) { __builtin_amdgcn_s_sleep(1); \
    if ((++_sp & 255u) == 0u) { if (xb_ld(&(bar)[XB_TMO])) break; if (_sp > XB_SPIN_CAP) { atomicAdd(&(bar)[XB_TMO], 1u); break; } } } } while (0)
struct XcdBarrier { unsigned* bar; unsigned x; volatile LAS unsigned* st; };
__device__ __forceinline__ XcdBarrier xcd_barrier_post(unsigned* bar, volatile LAS unsigned* st, bool leader) {
    XcdBarrier b; b.bar = bar; b.x = xb_xcc_id(); b.st = st;
    if (leader) (void)xb_add(&bar[XB_XCNT(b.x)], 1u);
    return b;
}
__device__ __forceinline__ void xcd_barrier_complete(unsigned* bar, unsigned x, unsigned& nloc, unsigned& nx) {
    const unsigned G = gridDim.x * gridDim.y * gridDim.z;
    unsigned sum, cnt, mine, sp = 0u;
    for (;;) {
        sum = 0u; cnt = 0u; mine = 0u;
#pragma unroll
        for (unsigned j = 0; j < 16; ++j) { const unsigned c = xb_ld(&bar[XB_XCNT(j)]); sum += c; cnt += (c > 0u) ? 1u : 0u; mine = (j == x) ? c : mine; }
        if (sum == G) break;
        __builtin_amdgcn_s_sleep(1);
        if ((++sp & 255u) == 0u) { if (xb_ld(&bar[XB_TMO])) break; if (sp > XB_SPIN_CAP) { atomicAdd(&bar[XB_TMO], 1u); break; } }
    }
    nloc = mine > 0u ? mine : 1u; nx = cnt > 0u ? cnt : 1u;
}
__device__ __forceinline__ void xcd_barrier(const XcdBarrier& b, bool leader) {
    asm volatile("s_waitcnt vmcnt(0)" ::: "memory");
    __syncthreads();
    if (leader) {
        unsigned* bar = b.bar;
        __builtin_amdgcn_s_waitcnt(0);
        unsigned nloc = b.st[0], nx = b.st[1];
        if (nloc == 0u) { xcd_barrier_complete(bar, b.x, nloc, nx); b.st[0] = nloc; b.st[1] = nx; }
        const unsigned old = xb_add(&bar[XB_XSUB(b.x)], 1u);
        const unsigned gen = old / nloc;
        if (old + 1u == (gen + 1u) * nloc) {
            __builtin_amdgcn_fence(__ATOMIC_RELEASE, "agent");
            asm volatile("s_waitcnt vmcnt(0)" ::: "memory");
            const unsigned og = xb_add(&bar[XB_TOP], 1u);
            const unsigned tg = og / nx;
            if (og + 1u == (tg + 1u) * nx) xb_add(&bar[XB_TOPGEN], 1u);
            else XB_SPIN(xb_ld(&bar[XB_TOPGEN]) == tg, bar);
            __builtin_amdgcn_fence(__ATOMIC_ACQUIRE, "agent");
            xb_add(&bar[XB_XGEN(b.x)], 1u);
            asm volatile("s_waitcnt vmcnt(0)" ::: "memory");
        } else {
            XB_SPIN(xb_ld(&bar[XB_XGEN(b.x)]) == gen, bar);
            __builtin_amdgcn_fence(__ATOMIC_ACQUIRE, "agent");
            asm volatile("s_waitcnt vmcnt(0)" ::: "memory");
        }
    }
    __syncthreads();
}

__device__ __forceinline__ float wave_sum(float v) {
    v += swz_xor<1>(v); v += swz_xor<2>(v); v += swz_xor<4>(v); v += swz_xor<8>(v); v += swz_xor<16>(v);
    return sum_x32(v);
}
__device__ __forceinline__ unsigned f2bf(float f) { unsigned u = __builtin_bit_cast(unsigned, f); return (u + 0x7fffu + ((u >> 16) & 1u)) >> 16; }
__device__ __forceinline__ unsigned pk2(float lo, float hi) { return f2bf(lo) | (f2bf(hi) << 16); }

template <class MapF>
__device__ __forceinline__ void transpose_item(const float* W, int N, bf16_t* WT, int ldk, const float* gain, LAS float* scr, int kb, int nb, int lane, MapF map) {
    const int k0 = 64 * kb, n0 = 32 * nb;
    float tv[32];
#pragma unroll
    for (int i = 0; i < 32; ++i) { const int kk = 2 * i + (lane >> 5); tv[i] = W[(size_t)(k0 + kk) * N + n0 + (lane & 31)]; }
#pragma unroll
    for (int i = 0; i < 32; ++i) { const int kk = 2 * i + (lane >> 5); float v = tv[i]; if (gain) v *= gain[k0 + kk]; scr[kk * 33 + (lane & 31)] = v; }
    asm volatile("s_waitcnt lgkmcnt(0)" ::: "memory");
    const int c = lane & 7;
#pragma unroll
    for (int j = 0; j < 4; ++j) { const int n = (lane >> 3) + 8 * j; const LAS float* s = scr + (8 * c) * 33 + n;
        u32x4 o; o.x = pk2(s[0 * 33], s[1 * 33]); o.y = pk2(s[2 * 33], s[3 * 33]); o.z = pk2(s[4 * 33], s[5 * 33]); o.w = pk2(s[6 * 33], s[7 * 33]);
        const int dr = map(n0 + n);
        *(GAS u32x4*)(WT + (size_t)dr * ldk + k0 + 8 * c) = o; }
    asm volatile("s_waitcnt lgkmcnt(0)" ::: "memory");
}
template <class MapF>
__device__ __forceinline__ void transpose_item_fp8(const float* W, int N, unsigned char* WT8, int ldkb, float scale, LAS float* scr, int kb, int nb, int lane, MapF map) {
    const int k0 = 64 * kb, n0 = 32 * nb;
    float tv[32];
#pragma unroll
    for (int i = 0; i < 32; ++i) { const int kk = 2 * i + (lane >> 5); tv[i] = W[(size_t)(k0 + kk) * N + n0 + (lane & 31)]; }
#pragma unroll
    for (int i = 0; i < 32; ++i) { const int kk = 2 * i + (lane >> 5); scr[kk * 33 + (lane & 31)] = tv[i] * scale; }
    asm volatile("s_waitcnt lgkmcnt(0)" ::: "memory");
    const int c = lane & 7;
#pragma unroll
    for (int j = 0; j < 4; ++j) { const int n = (lane >> 3) + 8 * j; const LAS float* sp = scr + (8 * c) * 33 + n;
        u32x2 o; o.x = pack4_fp8(sp[0 * 33], sp[1 * 33], sp[2 * 33], sp[3 * 33]); o.y = pack4_fp8(sp[4 * 33], sp[5 * 33], sp[6 * 33], sp[7 * 33]);
        const int dr = map(n0 + n);
        *(GAS u32x2*)(WT8 + (size_t)dr * ldkb + k0 + 8 * c) = o; }
    asm volatile("s_waitcnt lgkmcnt(0)" ::: "memory");
}
__host__ __device__ __forceinline__ int rope_virt(int rho) { const int n = rho >> 4, fq = (rho & 15) >> 2, i = rho & 3; return 8 * fq + 4 * n + i; }
struct MapIn  { __device__ __forceinline__ int operator()(int n) const { if (n < 384) return n; if (n < 640) return n + 128; if (n < 672) return 384 + rope_virt(n - 640); return n + 96; } };
struct MapIn8 { __device__ __forceinline__ int operator()(int n) const { return n + 96 - 2816; } };
struct MapQup { __device__ __forceinline__ int operator()(int n) const { const int h = n / 96, w = n - h * 96; return w < 64 ? n : h * 96 + 64 + rope_virt(w - 64); } };
struct MapId  { __device__ __forceinline__ int operator()(int n) const { return n; } };
struct MapW13 { int half; __device__ __forceinline__ int operator()(int n) const { return 256 * (n >> 7) + 128 * half + (n & 127); } };

struct Args {
    const float* x; const float* c; const int* pos; const float* w_ada; const float* b_ada; const float* w_in; const float* q_norm_g; const float* w_q_up; const float* kv_norm_g; const float* w_kv_up;
    const float* lq1; const float* lk1; const float* lq2; const float* lk2; const float* diff_norm_g; const float* w_br_mla; const float* w_br_diff; const float* w_out;
    const float* ln1_g; const float* ln1_b; const float* ln2_g; const float* ln2_b; const float* ffn_w1; const float* ffn_w3; const float* ffn_w2; const float* router_w; const float* router_b;
    const float* moe_w1; const float* moe_w3; const float* moe_w2;
    float* out; unsigned char* ws; int ph_lo, ph_hi; float lam_init[4];
};

typedef const __attribute__((address_space(4))) Args* KArgP;
__device__ __forceinline__ KArgP kargs() { KArgP p = (KArgP)__builtin_amdgcn_kernarg_segment_ptr(); asm volatile("" : "+s"(p)); return p; }
struct Ctx { LAS unsigned char* lds; int tid, lane, wave, vcu, G; unsigned char* ws; };

__device__ __forceinline__ void cvt_mixer_weights(const Ctx& C, int l) {
    KArgP a = kargs();
    LAS float* scr = (LAS float*)(C.lds + C.wave * 8448);
    const int gw = C.vcu * NWAVES + C.wave, NGW = C.G * NWAVES;
    constexpr int I_IN = 16 * 181, I_QUP = 6 * 24, I_KVUP = 4 * 32, I_BRM = 8 * 32, I_BRD = 16 * 32, I_OUT = 16 * 32;
    constexpr int NIT = I_IN + I_QUP + I_KVUP + I_BRM + I_BRD + I_OUT;
    unsigned char* ws = C.ws;
    for (int it = gw; it < NIT; it += NGW) {
        int r = it;
        if (r < I_IN) { transpose_item_fp8(a->w_in + (size_t)l * 1024 * 5792, 5792, ws + WS_WIN8, 1024, W8_SCALE, scr, r / 181, r % 181, C.lane, MapIn{}); continue; } r -= I_IN;
        if (r < I_QUP) { transpose_item(a->w_q_up + (size_t)l * 384 * 768, 768, (bf16_t*)(ws + W_QUP), 384, a->q_norm_g + l * 384, scr, r / 24, r % 24, C.lane, MapQup{}); continue; } r -= I_QUP;
        if (r < I_KVUP) { transpose_item(a->w_kv_up + (size_t)l * 256 * 1024, 1024, (bf16_t*)(ws + W_KVUP), 256, a->kv_norm_g + l * 256, scr, r / 32, r % 32, C.lane, MapId{}); continue; } r -= I_KVUP;
        if (r < I_BRM) { transpose_item_fp8(a->w_br_mla + (size_t)l * 512 * 1024, 1024, ws + W_BRM, 512, W8_SCALE_BR, scr, r / 32, r % 32, C.lane, MapId{}); continue; } r -= I_BRM;
        if (r < I_BRD) { transpose_item_fp8(a->w_br_diff + (size_t)l * 1024 * 1024, 1024, ws + W_BRD, 1024, W8_SCALE_BR, scr, r / 32, r % 32, C.lane, MapId{}); continue; } r -= I_BRD;
        transpose_item_fp8(a->w_out + (size_t)l * 1024 * 1024, 1024, ws + W_OUT, 1024, W8_SCALE_BR, scr, r / 32, r % 32, C.lane, MapId{});
    }
}
__device__ __forceinline__ void cvt_ffn_weights(const Ctx& C, int l) {
    KArgP a = kargs();
    LAS float* scr = (LAS float*)(C.lds + C.wave * 8448);
    const int gw = C.vcu * NWAVES + C.wave, NGW = C.G * NWAVES;
    constexpr int I_W1 = 16 * 88, I_W2 = 44 * 32, I_E = 2 * I_W1 + I_W2;
    unsigned char* ws = C.ws;
    const bool moe = (l & 1) != 0; const int li = l >> 1;
    const int nE = moe ? NEXP : 1;
    const float* w1 = moe ? a->moe_w1 + (size_t)li * NEXP * 1024 * FF : a->ffn_w1 + (size_t)li * 1024 * FF;
    const float* w3 = moe ? a->moe_w3 + (size_t)li * NEXP * 1024 * FF : a->ffn_w3 + (size_t)li * 1024 * FF;
    const float* w2 = moe ? a->moe_w2 + (size_t)li * NEXP * 1024 * FF : a->ffn_w2 + (size_t)li * 1024 * FF;
    for (int it = gw; it < nE * I_E; it += NGW) {
        const int e = it / I_E; int r = it - e * I_E;
        bf16_t* d13 = (bf16_t*)(ws + WS_WFF + (size_t)e * W13_ESTRIDE);
        const size_t eo = (size_t)e * 1024 * FF;
        if (moe) {
            unsigned char* d8 = ws + WS_WFF + (size_t)e * W13_ESTRIDE8;
            if (r < I_W1) { transpose_item_fp8(w1 + eo, FF, d8, 1024, W8_SCALE, scr, r / 88, r % 88, C.lane, MapW13{0}); continue; } r -= I_W1;
            if (r < I_W1) { transpose_item_fp8(w3 + eo, FF, d8, 1024, W8_SCALE, scr, r / 88, r % 88, C.lane, MapW13{1}); continue; } r -= I_W1;
        } else {
        if (r < I_W1) { transpose_item(w1 + eo, FF, d13, 1024, nullptr, scr, r / 88, r % 88, C.lane, MapW13{0}); continue; } r -= I_W1;
        if (r < I_W1) { transpose_item(w3 + eo, FF, d13, 1024, nullptr, scr, r / 88, r % 88, C.lane, MapW13{1}); continue; } r -= I_W1;
        }
        transpose_item_fp8(w2 + eo, 1024, ws + W2_BASE + (size_t)e * W2_ESTRIDE8, FF, W8_SCALE_W2, scr, r / 32, r % 32, C.lane, MapId{});
    }
}

struct FIn {
    static constexpr bool HAS_PAIR = true;
    bf16_t* LAT; bf16_t* ZB; bf16_t* KM; float* RSQ; const float* COS; const float* SIN; int cboff; float insc; unsigned* KMX;
    __device__ __forceinline__ void pair(int row, int cb, int fq, f32x4 a0, f32x4 a1, f32x4 b0, f32x4 b1) const {
        cb += cboff; if (cb < 1792 || cb >= 2816) return;
        float ss = ((a0[0] * a0[0] + a0[1] * a0[1]) + (a0[2] * a0[2] + a0[3] * a0[3])) + ((a1[0] * a1[0] + a1[1] * a1[1]) + (a1[2] * a1[2] + a1[3] * a1[3]))
                 + ((b0[0] * b0[0] + b0[1] * b0[1]) + (b0[2] * b0[2] + b0[3] * b0[3])) + ((b1[0] * b1[0] + b1[1] * b1[1]) + (b1[2] * b1[2] + b1[3] * b1[3]));
        ss += swz_xor<16>(ss); ss = sum_x32(ss);
        ss = fmaxf(ss, swz_xor<1>(ss)); ss = fmaxf(ss, swz_xor<2>(ss)); ss = fmaxf(ss, swz_xor<4>(ss)); ss = fmaxf(ss, swz_xor<8>(ss));
        if (fq == 0 && (row & 15) == 0) atomicMax(KMX + (row >> 11) * 16 + ((cb - 1792) >> 6), __float_as_uint(ss * (insc * insc)));
    }
    __device__ __forceinline__ float rowscale(int) const { return 1.f; }
    __device__ __forceinline__ void operator()(int row, float rs, int cb, int fq, f32x4 v0, f32x4 v1) const {
        cb += cboff; v0 = v0 * insc; v1 = v1 * insc;
        if (cb < 384 || (cb >= 512 && cb < 768)) {
            *(u32x4*)(LAT + (size_t)row * 768 + cb + 8 * fq) = pack8(v0, v1);
            float ss = (v0[0] * v0[0] + v0[1] * v0[1]) + (v0[2] * v0[2] + v0[3] * v0[3]) + (v1[0] * v1[0] + v1[1] * v1[1]) + (v1[2] * v1[2] + v1[3] * v1[3]);
            ss += swz_xor<16>(ss); ss = sum_x32(ss);
            const int slot = cb < 384 ? (cb >> 5) : 12 + ((cb - 512) >> 5);
            if (fq == 0) RSQ[(size_t)row * 24 + slot] = ss;
        } else if (cb < 416) {
            const f32x4 cs = *(const f32x4*)(COS + (size_t)row * 16 + 4 * fq), sn = *(const f32x4*)(SIN + (size_t)row * 16 + 4 * fq);
            const f32x4 o1 = v0 * cs - v1 * sn, o2 = v0 * sn + v1 * cs;
            const u32x4 w = pack8(o1, o2);
#pragma unroll
            for (int h = 0; h < 8; ++h) *(u32x4*)(KM + (size_t)row * 768 + h * 96 + 64 + 8 * fq) = w;
        } else if (cb >= 768) {
            const int g = (cb - 768) >> 10, c = (cb - 768) & 1023;
            if (g == 0) { v0 = v0 * CQ_DIFF; v1 = v1 * CQ_DIFF; }
            if (g >= 3) {
#pragma unroll
                for (int i = 0; i < 4; ++i) { v0[i] = sigmoidf_(v0[i]); v1[i] = sigmoidf_(v1[i]); }
                u32x2 w8; w8.x = pack4_fp8(v0[0], v0[1], v0[2], v0[3]); w8.y = pack4_fp8(v1[0], v1[1], v1[2], v1[3]);
                *(u32x2*)((unsigned char*)(ZB + (size_t)g * T * 1024) + (size_t)row * 1024 + c + 8 * fq) = w8;
            } else *(u32x4*)(ZB + (size_t)g * T * 1024 + (size_t)row * 1024 + c + 8 * fq) = pack8(v0, v1);
        }
    }
};
struct FQup {   static constexpr bool HAS_PAIR = false;
    bf16_t* QM; const float* RSQ; const float* COS; const float* SIN;
    __device__ __forceinline__ float rowscale(int row) const {
        const f32x4 a = *(const f32x4*)(RSQ + (size_t)row * 24), b = *(const f32x4*)(RSQ + (size_t)row * 24 + 4), c = *(const f32x4*)(RSQ + (size_t)row * 24 + 8);
        const float ss = ((a[0] + a[1]) + (a[2] + a[3])) + ((b[0] + b[1]) + (b[2] + b[3])) + ((c[0] + c[1]) + (c[2] + c[3]));
        return CQ_MLA * __builtin_amdgcn_rsqf(ss * (1.0f / 384.0f) + RMS_EPS); }
    __device__ __forceinline__ void operator()(int row, float r, int cb, int fq, f32x4 v0, f32x4 v1) const {
        v0 = v0 * r; v1 = v1 * r;
        if ((cb % 96) == 64) {
            const f32x4 cs = *(const f32x4*)(COS + (size_t)row * 16 + 4 * fq), sn = *(const f32x4*)(SIN + (size_t)row * 16 + 4 * fq);
            const f32x4 o1 = v0 * cs - v1 * sn, o2 = v0 * sn + v1 * cs; v0 = o1; v1 = o2;
        }
        *(u32x4*)(QM + (size_t)row * 768 + cb + 8 * fq) = pack8(v0, v1);
    }
};
struct FKVup {  static constexpr bool HAS_PAIR = false;
    bf16_t* KM; bf16_t* VM; const float* RSQ;
    __device__ __forceinline__ float rowscale(int row) const {
        const f32x4 a = *(const f32x4*)(RSQ + (size_t)row * 24 + 12), b = *(const f32x4*)(RSQ + (size_t)row * 24 + 16);
        const float ss = ((a[0] + a[1]) + (a[2] + a[3])) + ((b[0] + b[1]) + (b[2] + b[3]));
        return __builtin_amdgcn_rsqf(ss * (1.0f / 256.0f) + RMS_EPS); }
    __device__ __forceinline__ void operator()(int row, float r, int cb, int fq, f32x4 v0, f32x4 v1) const {
        v0 = v0 * r; v1 = v1 * r;
        const int h = cb >> 7, w = cb & 127;
        if (w < 64) *(u32x4*)(KM + (size_t)row * 768 + h * 96 + w + 8 * fq) = pack8(v0, v1);
        else *(u32x4*)(VM + (size_t)row * 512 + h * 64 + (w - 64) + 8 * fq) = pack8(v0, v1);
    }
};
struct FBr1 {   static constexpr bool HAS_PAIR = false;
    bf16_t* T1; const bf16_t* SA;
    __device__ __forceinline__ float rowscale(int) const { return 1.f; }
    __device__ __forceinline__ void operator()(int row, float rs, int cb, int fq, f32x4 v0, f32x4 v1) const {
        const size_t o = (size_t)row * 1024 + cb + 8 * fq; f32x4 s0, s1; unpack8(*(const u32x4*)(SA + o), s0, s1);
        *(u32x4*)(T1 + o) = pack8(v0 * s0, v1 * s1);
    }
};
struct FBr2 {   static constexpr bool HAS_PAIR = false;
    bf16_t* MB; const bf16_t* T1; const bf16_t* SB;
    __device__ __forceinline__ float rowscale(int) const { return 1.f; }
    __device__ __forceinline__ void operator()(int row, float rs, int cb, int fq, f32x4 v0, f32x4 v1) const {
        const size_t o = (size_t)row * 1024 + cb + 8 * fq; f32x4 s0, s1, t0, t1; unpack8(*(const u32x4*)(SB + o), s0, s1); unpack8(*(const u32x4*)(T1 + o), t0, t1);
        *(u32x4*)(MB + o) = pack8(t0 + v0 * s0, t1 + v1 * s1);
    }
};
struct FRes {   static constexpr bool HAS_PAIR = false;
    float* PRE; const float* X; const float* gate;
    __device__ __forceinline__ float rowscale(int) const { return 1.f; }
    __device__ __forceinline__ void operator()(int row, float rs, int cb, int fq, f32x4 v0, f32x4 v1) const {
        const int b = row >> 11; const float* gp = gate + (size_t)b * 6144 + cb + 4 * fq;
        const size_t o = (size_t)row * 1024 + cb + 4 * fq;
        const f32x4 g0 = *(const f32x4*)gp, g1 = *(const f32x4*)(gp + 16), x0 = *(const f32x4*)(X + o), x1 = *(const f32x4*)(X + o + 16);
        *(f32x4*)(PRE + o) = x0 * ALPHA + g0 * v0; *(f32x4*)(PRE + o + 16) = x1 * ALPHA + g1 * v1;
    }
};
struct FMoeOut {
    bf16_t* Y; const int* RMAP;
    __device__ __forceinline__ float rowscale(int) const { return 1.f; }
    __device__ __forceinline__ void operator()(int row, float rs, int cb, int fq, f32x4 v0, f32x4 v1) const {
        const int s = RMAP[row];
        if (s >= 0) *(u32x4*)(Y + (size_t)s * 1024 + cb + 8 * fq) = pack8(v0, v1);
    }
};

template <int MODE, bool ROUTE>
__device__ __forceinline__ void ln_phase(const Ctx& C, unsigned char* H8, const bf16_t* XIN, const bf16_t* G, bf16_t* XB, float* OUT32, bf16_t* H, const float* lng, const float* lnb, const float* sc, const float* sh,
                                         const bf16_t* Y, const float* GATE, const float* g2, const float* rw, const float* rb, int* SEL, float* GOUT, unsigned* CNT) {
    int lane_ = C.lane; asm volatile("" : "+v"(lane_)); const int lane = lane_; const int wg = blockIdx.x; const int b = (wg * 128) >> 11;
    f32x4 vg[4], vb[4], vsc[4], vsh[4], vg2[4];
#pragma unroll
    for (int j = 0; j < 4; ++j) { const int c = 4 * lane + 256 * j; vg[j] = *(const f32x4*)(lng + c); vb[j] = *(const f32x4*)(lnb + c);
        if (sc) { vsc[j] = *(const f32x4*)(sc + (size_t)b * 6144 + c) + 1.0f; vsh[j] = *(const f32x4*)(sh + (size_t)b * 6144 + c); }
        vg2[j] = *(const f32x4*)(g2 + (size_t)b * 6144 + c); }
    LAS float* rwl = (LAS float*)C.lds;
    LAS unsigned* hist = (LAS unsigned*)(C.lds + 32768);
    if (ROUTE) { for (int i = C.tid; i < 8192; i += NWAVES * 64) rwl[(i & 7) * 1024 + (i >> 3)] = rw[i]; if (C.tid < 8) hist[C.tid] = 0u; __syncthreads(); }
    for (int rr = 0; rr < 8; ++rr) {
        u32x2 vv[2][4], rya[2][4], ryb[2][4]; float rga[2], rgb[2];
#pragma unroll
        for (int h2 = 0; h2 < 2; ++h2) { const int row = wg * 128 + C.wave * 16 + rr + 8 * h2;
            if (MODE == 0) {
#pragma unroll
                for (int j = 0; j < 4; ++j) { const int c = 4 * lane + 256 * j; vv[h2][j] = *(const u32x2*)(XIN + (size_t)row * 1024 + c); rya[h2][j] = *(const u32x2*)(G + (size_t)row * 1024 + c); }
            } else {
                rga[h2] = GATE[2 * row]; rgb[h2] = GATE[2 * row + 1];
#pragma unroll
                for (int j = 0; j < 4; ++j) { const int c = 4 * lane + 256 * j; vv[h2][j] = *(const u32x2*)(XB + (size_t)row * 1024 + c);
                    rya[h2][j] = *(const u32x2*)(Y + (size_t)(2 * row) * 1024 + c); ryb[h2][j] = *(const u32x2*)(Y + (size_t)(2 * row + 1) * 1024 + c); }
            } }
#pragma unroll
      for (int h2 = 0; h2 < 2; ++h2) { const int row = wg * 128 + C.wave * 16 + rr + 8 * h2;
        f32x4 v[4];
        if (MODE == 0) {
#pragma unroll
            for (int j = 0; j < 4; ++j) { const u32x2 ya = rya[h2][j], xw = vv[h2][j]; f32x4 fa, xv; fa[0] = __uint_as_float(ya.x << 16); fa[1] = __uint_as_float(ya.x & 0xffff0000u); fa[2] = __uint_as_float(ya.y << 16); fa[3] = __uint_as_float(ya.y & 0xffff0000u);
                xv[0] = __uint_as_float(xw.x << 16); xv[1] = __uint_as_float(xw.x & 0xffff0000u); xv[2] = __uint_as_float(xw.y << 16); xv[3] = __uint_as_float(xw.y & 0xffff0000u);
                v[j] = xv * ALPHA + vg2[j] * fa; }
        } else {
            const float ga = rga[h2], gb = rgb[h2];
#pragma unroll
            for (int j = 0; j < 4; ++j) { const u32x2 xw = vv[h2][j]; const u32x2 ya = rya[h2][j], yb = ryb[h2][j];
                f32x4 fa, fb, xv; xv[0] = __uint_as_float(xw.x << 16); xv[1] = __uint_as_float(xw.x & 0xffff0000u); xv[2] = __uint_as_float(xw.y << 16); xv[3] = __uint_as_float(xw.y & 0xffff0000u); fa[0] = __uint_as_float(ya.x << 16); fa[1] = __uint_as_float(ya.x & 0xffff0000u); fa[2] = __uint_as_float(ya.y << 16); fa[3] = __uint_as_float(ya.y & 0xffff0000u);
                fb[0] = __uint_as_float(yb.x << 16); fb[1] = __uint_as_float(yb.x & 0xffff0000u); fb[2] = __uint_as_float(yb.y << 16); fb[3] = __uint_as_float(yb.y & 0xffff0000u);
                v[j] = xv * ALPHA + vg2[j] * (fa * ga + fb * gb); }
        }
        float s = 0.f;
#pragma unroll
        for (int j = 0; j < 4; ++j) s += (v[j][0] + v[j][1]) + (v[j][2] + v[j][3]);
        const float mean = wave_sum(s) * (1.f / 1024.f); float s2 = 0.f;
#pragma unroll
        for (int j = 0; j < 4; ++j) { v[j] = v[j] - mean; s2 += (v[j][0] * v[j][0] + v[j][1] * v[j][1]) + (v[j][2] * v[j][2] + v[j][3] * v[j][3]); }
        const float rstd = 1.f / sqrtf(wave_sum(s2) * (1.f / 1024.f) + LN_EPS);
        float lg[8];
        if (ROUTE) {
#pragma unroll
            for (int e = 0; e < 8; ++e) lg[e] = 0.f; }
#pragma unroll
        for (int j = 0; j < 4; ++j) { const int c = 4 * lane + 256 * j; const f32x4 y = v[j] * rstd * vg[j] + vb[j];
            if (OUT32) *(f32x4*)(OUT32 + (size_t)row * 1024 + c) = y;
            else { u32x2 w; w.x = cvt_pk_bf16(y[0], y[1]); w.y = cvt_pk_bf16(y[2], y[3]); *(u32x2*)(XB + (size_t)row * 1024 + c) = w; }
            if (sc) { const f32x4 hh = y * vsc[j] + vsh[j];
                if (H) { u32x2 w; w.x = cvt_pk_bf16(hh[0], hh[1]); w.y = cvt_pk_bf16(hh[2], hh[3]); *(u32x2*)(H + (size_t)row * 1024 + c) = w; }
                if (H8) *(unsigned*)(H8 + (size_t)row * 1024 + c) = pack4_fp8(hh[0], hh[1], hh[2], hh[3]);
                if (ROUTE) {
#pragma unroll
                    for (int e = 0; e < 8; ++e) { const f32x4 w4 = *(const LAS f32x4*)(rwl + e * 1024 + c); lg[e] += (hh[0] * w4[0] + hh[1] * w4[1]) + (hh[2] * w4[2] + hh[3] * w4[3]); } } } }
        if (ROUTE) {
#pragma unroll
            for (int e = 0; e < 8; ++e) lg[e] = wave_sum(lg[e]) + rb[e];
            int i0 = 0; float m0 = lg[0];
#pragma unroll
            for (int e = 1; e < 8; ++e) if (lg[e] > m0) { m0 = lg[e]; i0 = e; }
            int i1 = -1; float m1 = -INFINITY;
#pragma unroll
            for (int e = 0; e < 8; ++e) if (e != i0 && lg[e] > m1) { m1 = lg[e]; i1 = e; }
            const float g0 = 1.0f / (1.0f + expf(m1 - m0));
            if (lane == 0) { SEL[row] = i0 | (i1 << 8); GOUT[2 * row] = g0; GOUT[2 * row + 1] = 1.0f - g0; atomicAdd((unsigned*)&hist[i0], 1u); atomicAdd((unsigned*)&hist[i1], 1u); }
        }
      }
    }
    if (ROUTE) { __syncthreads(); if (C.tid < 8) atomicAdd(CNT + C.tid, (unsigned)hist[C.tid]); }
}

constexpr int NPH_L = 10, NPHASE = 2 + DEPTH * NPH_L;
#ifndef LB2
#define LB2 2
#endif
#ifdef NVGPR
__attribute__((amdgpu_num_vgpr(NVGPR)))
#endif
__global__ void __launch_bounds__(NWAVES * 64, LB2) mk_fwd(Args args) {
    extern __shared__ __attribute__((aligned(16))) unsigned char lds[];
    const int wave0 = __builtin_amdgcn_readfirstlane((int)threadIdx.x >> 6);
    Ctx C; C.lds = (LAS unsigned char*)lds; C.wave = wave0; C.lane = (int)__builtin_amdgcn_mbcnt_hi(~0u, __builtin_amdgcn_mbcnt_lo(~0u, 0u)); C.tid = wave0 * 64 + C.lane;
    C.G = gridDim.x; { const int bx = blockIdx.x; C.vcu = (C.G % 8 == 0) ? (bx % 8) * (C.G / 8) + bx / 8 : bx; }
    KArgP ka0 = kargs();
    unsigned* const ctl0 = (unsigned*)(ka0->ws + WS_CTL);
    volatile LAS unsigned* MISC = (volatile LAS unsigned*)(C.lds + MISC_OFF);
    for (int u = C.tid; u < (LDS_BYTES - LDSCTL_OFF) / 4; u += NWAVES * 64) ((LAS unsigned*)(C.lds + LDSCTL_OFF))[u] = 0u;
    __syncthreads();
    if (PROBE == 30 && blockIdx.x == 0 && C.tid == 0) { const unsigned long long c0 = clock64(), t0 = __builtin_amdgcn_s_memrealtime();
        MISC[16] = (unsigned)c0; MISC[17] = (unsigned)(c0 >> 32); MISC[18] = (unsigned)t0; MISC[19] = (unsigned)(t0 >> 32); }
    XcdBarrier bar; bar.bar = ctl0 + CW_BAR; bar.x = 0; bar.st = nullptr;
    if (!MK_PER_PHASE) bar = xcd_barrier_post(ctl0 + CW_BAR, MISC + 8, C.tid == 0);
    const int lo = ka0->ph_lo, hi = ka0->ph_hi;
#define GEMM_RUN(call) do { call; if (PROBE == 1 || PROBE == 10 + PHK) { asm volatile("s_waitcnt vmcnt(0)" ::: "memory"); __syncthreads(); call; } } while (0)
#define FRESH() do { int l_; asm volatile("v_mbcnt_lo_u32_b32 %0, -1, 0\n\tv_mbcnt_hi_u32_b32 %0, -1, %0" : "=v"(l_)); C.lane = l_; C.wave = wave0; C.tid = wave0 * 64 + l_; } while (0)
#define IN(k) (lo <= (k) && (k) < hi)
#define SEAM(k) do { if (IN((k) + 1)) { FRESH(); XcdBarrier b2_ = bar; asm volatile("" : "+s"(b2_.bar)); xcd_barrier(b2_, C.tid == 0); if (PROBE == 6) xcd_barrier(b2_, C.tid == 0); } } while (0)
#define MOD ((float*)(ws + WS_MOD))
#define PART ((float*)(ws + WS_PART))
#define RSQ ((float*)(ws + WS_RSQ))
#define COS ((float*)(ws + WS_COS))
#define SIN ((float*)(ws + WS_SIN))
#define H ((bf16_t*)(ws + WS_H))
#define LAT ((bf16_t*)(ws + WS_LAT))
#define ZB ((bf16_t*)(ws + WS_ZB))
#define QM ((bf16_t*)(ws + WS_QM))
#define KM ((bf16_t*)(ws + WS_KM))
#define VM ((bf16_t*)(ws + WS_VM))
#define OM ((bf16_t*)(ws + WS_OM))
#define PRE ((float*)(ws + WS_PRE))
#define T1 ((bf16_t*)(ws + WS_T1))
#define MB ((bf16_t*)(ws + WS_MB))
#define DQ (ZB)
#define DK (ZB + (size_t)T * 1024)
#define DV (ZB + (size_t)2 * T * 1024)
#define SA (ZB + (size_t)3 * T * 1024)
#define SB (ZB + (size_t)4 * T * 1024)
#define XB ((bf16_t*)(ws + WS_XRES))
#define ctl ((unsigned*)(ws + WS_CTL))
#define gw (C.vcu * NWAVES + C.wave)
#define NGW (C.G * NWAVES)

    if (PHM(10) && IN(0)) { KArgP ka = kargs(); (void)ka; FRESH(); unsigned char* const ws = ka->ws; C.ws = ws;
        for (int rep = 0; rep < (PROBE == 4 ? 2 : 1); ++rep) { cvt_mixer_weights(C, 0); cvt_ffn_weights(C, 0); }
        LAS float* cond = (LAS float*)(C.lds + C.wave * 8448);
        for (int it = gw; it < 4 * 24 * 8; it += NGW) {
            const int kc = it & 7, jb = (it >> 3) % 24, l = it / (8 * 24);
            for (int i = C.lane; i < 2048; i += 64) { const int k = i >> 4, b = i & 15; const float cv = ka->c[b * 1024 + kc * 128 + k]; cond[k * 16 + b] = cv / (1.0f + expf(-cv)); }
            asm volatile("s_waitcnt lgkmcnt(0)" ::: "memory");
            f32x4 acc[16];
#pragma unroll
            for (int b = 0; b < 16; ++b) acc[b] = (f32x4){0.f, 0.f, 0.f, 0.f};
            const float* wp = ka->w_ada + ((size_t)l * 1024 + kc * 128) * 6144 + jb * 256 + 4 * C.lane;
#pragma unroll 4
            for (int k = 0; k < 128; ++k) { const f32x4 w = *(const f32x4*)(wp + (size_t)k * 6144);
                const f32x4 c0 = *(const LAS f32x4*)(cond + k * 16), c1 = *(const LAS f32x4*)(cond + k * 16 + 4), c2 = *(const LAS f32x4*)(cond + k * 16 + 8), c3 = *(const LAS f32x4*)(cond + k * 16 + 12);
#pragma unroll
                for (int b = 0; b < 4; ++b) { acc[b] += w * c0[b]; acc[4 + b] += w * c1[b]; acc[8 + b] += w * c2[b]; acc[12 + b] += w * c3[b]; } }
#pragma unroll
            for (int b = 0; b < 16; ++b) *(f32x4*)(PART + (((size_t)kc * 4 + l) * 16 + b) * 6144 + jb * 256 + 4 * C.lane) = acc[b];
            asm volatile("s_waitcnt lgkmcnt(0)" ::: "memory");
        }
        for (int i = blockIdx.x * (NWAVES * 64) + C.tid; i < T * 16; i += C.G * NWAVES * 64) {
            const int t = i >> 4, j = i & 15; const float inv = powf(10000.0f, -(float)j * (1.0f / 16.0f)); const float ang = (float)ka->pos[t] * inv;
            COS[i] = cosf(ang); SIN[i] = sinf(ang); }
        SEAM(0);
    }
    if (PHM(11) && IN(1)) { KArgP ka = kargs(); (void)ka; FRESH(); unsigned char* const ws = ka->ws; C.ws = ws;
        for (int i = blockIdx.x * (NWAVES * 64) + C.tid; i < 4 * 16 * 6144; i += C.G * NWAVES * 64) {
            const int j = i % 6144, l = i / (16 * 6144); float s = ka->b_ada[l * 6144 + j];
#pragma unroll
            for (int kc = 0; kc < 8; ++kc) s += PART[(size_t)kc * 4 * 16 * 6144 + i];
            MOD[i] = s; }
        { const int wg = blockIdx.x, b = (wg * 128) >> 11; f32x4 vsc[4], vsh[4];
#pragma unroll
          for (int j = 0; j < 4; ++j) { const int c = 4 * C.lane + 256 * j; f32x4 a = *(const f32x4*)(ka->b_ada + c), s = *(const f32x4*)(ka->b_ada + 1024 + c);
#pragma unroll
              for (int kc = 0; kc < 8; ++kc) { const float* p = PART + (((size_t)kc * 4 + 0) * 16 + b) * 6144; a += *(const f32x4*)(p + c); s += *(const f32x4*)(p + 1024 + c); }
              vsh[j] = a; vsc[j] = s + 1.0f; }
          for (int rr = 0; rr < 16; ++rr) { const int row = wg * 128 + C.wave * 16 + rr;
#pragma unroll
              for (int j = 0; j < 4; ++j) { const int c = 4 * C.lane + 256 * j; const f32x4 xv = *(const f32x4*)(ka->x + (size_t)row * 1024 + c); const f32x4 hh = xv * vsc[j] + vsh[j];
                  *(unsigned*)(ws + WS_H8 + (size_t)row * 1024 + c) = pack4_fp8(hh[0], hh[1], hh[2], hh[3]);
                  { u32x2 w; w.x = cvt_pk_bf16(xv[0], xv[1]); w.y = cvt_pk_bf16(xv[2], xv[3]); *(u32x2*)(XB + (size_t)row * 1024 + c) = w; } } } }
        SEAM(1);
    }

    for (int l = 0; l < DEPTH; ++l) {
        const int P = 2 + l * NPH_L;
        const bool moe = (l & 1) != 0; const int li = l >> 1;
        if (PHM(0) && IN(P + 0)) { KArgP ka = kargs(); (void)ka; FRESH(); unsigned char* const ws = ka->ws; C.ws = ws; constexpr int PHK = 0;
            pg8::Gemm g{(const bf16_t*)(ws + WS_H8), (const bf16_t*)(ws + WS_WIN8), T, NZ, 512, 512}; pg8::StaticOrder S; S.init(T, NZ, C.G, (int)blockIdx.x);
            pg8::EpiRow<FIn, true, true> E{FIn{LAT, ZB, KM, RSQ, COS, SIN, 0, 1.0f / W8_SCALE, ctl + CW_KMAX + l * 256}};
            GEMM_RUN((pg8::gemm_phase<STG_IN, true>(C.lds, C.tid, g, S, E)));
            SEAM(P + 0);
        }
        if (PHM(1) && IN(P + 1)) { KArgP ka = kargs(); (void)ka; FRESH(); unsigned char* const ws = ka->ws; C.ws = ws; constexpr int PHK = 1;
            { pg8::Gemm g{LAT, (const bf16_t*)(ws + W_QUP), T, 768, 384, 768}; pg8::StaticOrder S; S.init(T, 768, C.G, (int)blockIdx.x);
              pg8::EpiRow<FQup, true, true> E{FQup{QM, RSQ, COS, SIN}}; GEMM_RUN(pg8::gemm_phase(C.lds, C.tid, g, S, E)); }
            { pg8::Gemm g{LAT + 512, (const bf16_t*)(ws + W_KVUP), T, 1024, 256, 768}; pg8::StaticOrder S; S.init(T, 1024, C.G, (int)blockIdx.x);
              pg8::EpiRow<FKVup, true, true> E{FKVup{KM, VM, RSQ}}; GEMM_RUN(pg8::gemm_phase(C.lds, C.tid, g, S, E)); }
            SEAM(P + 1);
        }
        if (PHM(2) && IN(P + 2)) { KArgP ka = kargs(); (void)ka; FRESH(); unsigned char* const ws = ka->ws; C.ws = ws;
            float lam;
            { float s1 = 0.f, s2 = 0.f;
              for (int i = 0; i < 64; ++i) { s1 += ka->lq1[l * 64 + i] * ka->lk1[l * 64 + i]; s2 += ka->lq2[l * 64 + i] * ka->lk2[l * 64 + i]; }
              lam = expf(s1) - expf(s2) + ka->lam_init[l]; }
            const int xcd = C.vcu >> 5, jj = C.vcu & 31; const bool g256 = (C.G == 256);
            for (int rep = 0; rep < (PROBE == 2 ? 2 : 1); ++rep)
            for (int i = 0; ; ++i) {
                int u; if (g256) { if (i >= 4) break; u = xcd * 128 + i * 32 + jj; } else { u = i * C.G + C.vcu; if (u >= 1024) break; }
                const int bh = u >> 3, qb = u & 7, b = bh >> 3, h = bh & 7; const size_t r0 = (size_t)b * SEQ;
                att::DiffArgs da{nullptr, 0.f, 0.f, 0.f, nullptr, 0.f};
                att::attn_unit<false>(QM + (r0 + qb * 256) * 768 + h * 96, KM + r0 * 768 + h * 96, VM + r0 * 512 + h * 64, (unsigned char*)OM + (r0 + qb * 256) * 512 + h * 64, qb * 256, da, (char*)lds, C.lds, C.tid);
            }
            int bprev = -1;
            for (int rep = 0; rep < (PROBE == 3 ? 2 : 1); ++rep)
            for (int i = 0; ; ++i) {
                int b, h, qb;
                if (g256) { if (i >= 8) break; h = i; b = xcd * 2 + (jj >> 4); qb = ((jj & 15) + 2 * i) & 15; }
                const size_t r0 = (size_t)b * SEQ;
                if (b != bprev) { __syncthreads(); att::diff_pos_setup(ka->pos + r0, (char*)lds, C.tid); bprev = b; }
                const unsigned* km = ctl + CW_KMAX + l * 256 + (b * 8 + h) * 2;
                att::DiffArgs da{ka->pos + r0, exp2f(-(float)(h + 1)) * LOG2E, lam, 1.0f - ka->lam_init[l], ka->diff_norm_g + l * 1024 + h * 128, 1.01f * fmaxf(__uint_as_float(km[0]), __uint_as_float(km[1]))};
                att::attn_unit<true>(DQ + (r0 + qb * 128) * 1024 + h * 128, DK + r0 * 1024 + h * 128, DV + r0 * 1024 + h * 128,
                                     (ws + WS_DO8) + (r0 + qb * 128) * 1024 + h * 128, qb * 128, da, (char*)lds, C.lds, C.tid);
            }
            SEAM(P + 2);
        }
        if (PHM(3) && IN(P + 3)) { KArgP ka = kargs(); (void)ka; FRESH(); unsigned char* const ws = ka->ws; C.ws = ws; constexpr int PHK = 3;
            { pg8::Gemm g{OM, (const bf16_t*)(ws + W_BRM), T, 1024, 256, 256}; pg8::StaticOrder S; S.init(T, 1024, C.G, (int)blockIdx.x);
              pg8::EpiBr<1> E{T1, nullptr, nullptr, nullptr, 1.0f / (O8_SCALE * W8_SCALE_BR)}; GEMM_RUN((pg8::gemm_phase<STG_BR, true>(C.lds, C.tid, g, S, E))); }
            asm volatile("s_waitcnt vmcnt(0)" ::: "memory"); __syncthreads();
            { pg8::Gemm g{(const bf16_t*)(ws + WS_DO8), (const bf16_t*)(ws + W_BRD), T, 1024, 512, 512}; pg8::StaticOrder S; S.init(T, 1024, C.G, (int)blockIdx.x);
              pg8::EpiBr<2> E{MB, (const unsigned char*)SA, (const unsigned char*)SB, (const unsigned char*)T1, 1.0f / (O8_SCALE * W8_SCALE_BR)}; GEMM_RUN((pg8::gemm_phase<0, true>(C.lds, C.tid, g, S, E))); }
            SEAM(P + 3);
        }
        if (PHM(4) && IN(P + 4)) { KArgP ka = kargs(); (void)ka; FRESH(); unsigned char* const ws = ka->ws; C.ws = ws; constexpr int PHK = 4;
            pg8::Gemm g{MB, (const bf16_t*)(ws + W_OUT), T, 1024, 512, 512}; pg8::StaticOrder S; S.init(T, 1024, C.G, (int)blockIdx.x);
            pg8::EpiGate E{(bf16_t*)(ws + WS_PRE), 1.0f / (pg8::MB8_SCALE * W8_SCALE_BR)}; GEMM_RUN((pg8::gemm_phase<STG_OUT, true>(C.lds, C.tid, g, S, E)));
            SEAM(P + 4);
        }
        if (PHM(5) && IN(P + 5)) { KArgP ka = kargs(); (void)ka; FRESH(); unsigned char* const ws = ka->ws; C.ws = ws;
            if (moe) ln_phase<0, true>(C, ws + WS_H, XB, (const bf16_t*)(ws + WS_PRE), XB, (float*)nullptr, (bf16_t*)nullptr, ka->ln1_g + l * 1024, ka->ln1_b + l * 1024, (MOD + (size_t)l * 16 * 6144) + 4096, (MOD + (size_t)l * 16 * 6144) + 3072, nullptr, nullptr, (MOD + (size_t)l * 16 * 6144) + 2048,
                                       ka->router_w + (size_t)li * 8192, ka->router_b + li * 8, (int*)(ws + WS_SEL), (float*)(ws + WS_GATE), ctl + CW_CNT + 64 * li);
            else ln_phase<0, false>(C, nullptr, XB, (const bf16_t*)(ws + WS_PRE), XB, (float*)nullptr, H, ka->ln1_g + l * 1024, ka->ln1_b + l * 1024, (MOD + (size_t)l * 16 * 6144) + 4096, (MOD + (size_t)l * 16 * 6144) + 3072, nullptr, nullptr, (MOD + (size_t)l * 16 * 6144) + 2048, nullptr, nullptr, nullptr, nullptr, nullptr);
            SEAM(P + 5);
        }
        int ts[9];
#pragma unroll
        for (int e = 0; e < 9; ++e) ts[e] = 0;
        if (moe && (IN(P + 6) || IN(P + 7) || IN(P + 8))) { KArgP ka = kargs(); unsigned char* const ws = ka->ws;
            int accp = 0;
#pragma unroll
            for (int e = 0; e < 8; ++e) { ts[e] = accp; const int cnt = (int)__hip_atomic_load(ctl + CW_CNT + 64 * li + e, __ATOMIC_RELAXED, __HIP_MEMORY_SCOPE_AGENT); accp += (cnt + 255) >> 8; }
            ts[8] = accp;
        }
        if (PHM(6) && IN(P + 6)) { KArgP ka = kargs(); (void)ka; FRESH(); unsigned char* const ws = ka->ws; C.ws = ws;
            if (moe) {
                const int* SEL = (const int*)(ws + WS_SEL); int* RMAP = (int*)(ws + WS_RMAP);
                unsigned* CUR = ctl + CW_CUR + 64 * li; const unsigned* CNT = ctl + CW_CNT + 64 * li;
                if (blockIdx.x == 0) {
                    _Pragma("unroll") for (int e = 0; e < 8; ++e) { const int c = (int)CNT[e], beg = ts[e] * 256 + c, end = ts[e + 1] * 256; for (int p = beg + C.tid; p < end; p += NWAVES * 64) RMAP[p] = -1; } }
                for (int s0 = gw * 64; s0 < 2 * T; s0 += NGW * 64) {
                    const int s = s0 + C.lane, t = s >> 1, k = s & 1; const int sel = SEL[t]; const int e = k ? (sel >> 8) : (sel & 255);
                    int pos = 0;
#pragma unroll
                    for (int ee = 0; ee < 8; ++ee) { const unsigned long long m = __ballot(e == ee); const int n = __popcll(m);
                        if (n) { unsigned base = 0; if (C.lane == 0) base = atomicAdd(CUR + ee, (unsigned)n); base = __builtin_amdgcn_readfirstlane(base);
                            if (e == ee) pos = ts[ee] * 256 + (int)base + (int)__builtin_amdgcn_mbcnt_hi((unsigned)(m >> 32), __builtin_amdgcn_mbcnt_lo((unsigned)m, 0u)); } }
                    RMAP[pos] = s;
                    { unsigned char* XB8 = ws + WS_XB; const unsigned char* H8 = (const unsigned char*)H;
                      for (int q = 0; q < 64; q += 16) {
                        u32x4 r0[8];
#pragma unroll
                        for (int u = 0; u < 8; ++u) { const int tq = (s0 + q + 2 * u) >> 1; r0[u] = ((const u32x4*)(H8 + (size_t)tq * 1024))[C.lane]; }
#pragma unroll
                        for (int u = 0; u < 8; ++u) {
#pragma unroll
                            for (int k2 = 0; k2 < 2; ++k2) { const int pq = __builtin_amdgcn_readlane(pos, q + 2 * u + k2); ((u32x4*)(XB8 + (size_t)pq * 1024))[C.lane] = r0[u]; } }
                      } }
                }
            }
            if (moe) SEAM(P + 6);
        }
        if (PHM(7) && IN(P + 7)) { KArgP ka = kargs(); (void)ka; FRESH(); unsigned char* const ws = ka->ws; C.ws = ws; constexpr int PHK = 7;
            if (!moe) { pg8::Gemm g{H, (const bf16_t*)(ws + WS_WFF), T, 5632, 1024, 1024}; pg8::StaticOrder S; S.init(T, 5632, C.G, (int)blockIdx.x);
                pg8::EpiSwiglu E{(bf16_t*)(ws + WS_U), FF, 1.0f, true}; GEMM_RUN(pg8::gemm_phase(C.lds, C.tid, g, S, E)); }
            else { pg8::Gemm g{(const bf16_t*)(ws + WS_XB), (const bf16_t*)(ws + WS_WFF), ts[8] * 256, 5632, 512, 512};
                pg8::MoeOrderT<false> S; S.rmap = nullptr; S.so.init(ts[8] * 256, 5632, C.G, (int)blockIdx.x); S.ts1 = ts[1]; S.ts2 = ts[2]; S.ts3 = ts[3]; S.ts4 = ts[4]; S.ts5 = ts[5]; S.ts6 = ts[6]; S.ts7 = ts[7]; S.estride = W13_ESTRIDE8;
                pg8::EpiSwiglu E{(bf16_t*)(ws + WS_UM), FF, 1.0f / W8_SCALE, true}; GEMM_RUN((pg8::gemm_phase<0, true>(C.lds, C.tid, g, S, E))); }
            SEAM(P + 7);
        }
        if (PHM(8) && IN(P + 8)) { KArgP ka = kargs(); (void)ka; FRESH(); unsigned char* const ws = ka->ws; C.ws = ws; constexpr int PHK = 8;
            if (!moe) { pg8::Gemm g{(const bf16_t*)(ws + WS_U), (const bf16_t*)(ws + W2_BASE), T, 1024, FF / 2, FF / 2}; pg8::StaticOrder S; S.init(T, 1024, C.G, (int)blockIdx.x);
                pg8::EpiGate E{(bf16_t*)(ws + WS_PRE), 1.0f / W8_SCALE_W2}; GEMM_RUN((pg8::gemm_phase<0, true>(C.lds, C.tid, g, S, E))); }
            else { pg8::Gemm g{(const bf16_t*)(ws + WS_UM), (const bf16_t*)(ws + W2_BASE), ts[8] * 256, 1024, FF / 2, FF / 2};
                pg8::MoeOrderT<false> S; S.rmap = nullptr; S.so.init(ts[8] * 256, 1024, C.G, (int)blockIdx.x); S.ts1 = ts[1]; S.ts2 = ts[2]; S.ts3 = ts[3]; S.ts4 = ts[4]; S.ts5 = ts[5]; S.ts6 = ts[6]; S.ts7 = ts[7]; S.estride = W2_ESTRIDE8;
                pg8::EpiMoeOut E{(bf16_t*)(ws + WS_Y), (const int*)(ws + WS_RMAP), 1.0f / W8_SCALE_W2}; GEMM_RUN((pg8::gemm_phase<0, true>(C.lds, C.tid, g, S, E))); }
            SEAM(P + 8);
        }
        if (PHM(9) && IN(P + 9)) { KArgP ka = kargs(); (void)ka; FRESH(); unsigned char* const ws = ka->ws; C.ws = ws;
            const float* nsc = (l + 1 < DEPTH) ? MOD + (size_t)(l + 1) * 16 * 6144 + 1024 : nullptr; const float* nsh = (l + 1 < DEPTH) ? MOD + (size_t)(l + 1) * 16 * 6144 : nullptr;
            if (moe) ln_phase<1, false>(C, (l + 1 < DEPTH) ? ws + WS_H8 : nullptr, nullptr, nullptr, XB, (l + 1 < DEPTH) ? (float*)nullptr : ka->out, (bf16_t*)nullptr, ka->ln2_g + l * 1024, ka->ln2_b + l * 1024, nsc, nsh, (const bf16_t*)(ws + WS_Y), (const float*)(ws + WS_GATE), (MOD + (size_t)l * 16 * 6144) + 5120, nullptr, nullptr, nullptr, nullptr, nullptr);
            else ln_phase<0, false>(C, (l + 1 < DEPTH) ? ws + WS_H8 : nullptr, XB, (const bf16_t*)(ws + WS_PRE), XB, (l + 1 < DEPTH) ? (float*)nullptr : ka->out, (bf16_t*)nullptr, ka->ln2_g + l * 1024, ka->ln2_b + l * 1024, nsc, nsh, nullptr, nullptr, (MOD + (size_t)l * 16 * 6144) + 5120, nullptr, nullptr, nullptr, nullptr, nullptr);
            if (l + 1 < DEPTH) for (int rep = 0; rep < (PROBE == 4 ? 2 : 1); ++rep) { __syncthreads(); cvt_mixer_weights(C, l + 1); cvt_ffn_weights(C, l + 1); }
            if (l + 1 < DEPTH) SEAM(P + 9);
        }
    }
    if (PROBE == 30 && blockIdx.x == 0 && C.tid == 0) {
        const unsigned long long c1 = clock64(), t1 = __builtin_amdgcn_s_memrealtime();
        const unsigned long long c0 = ((unsigned long long)MISC[17] << 32) | MISC[16], t0 = ((unsigned long long)MISC[19] << 32) | MISC[18];
        const unsigned long long mhz = (c1 - c0) * 100ull / (t1 - t0);
        while (__builtin_amdgcn_s_memrealtime() - t1 < mhz * 100ull) __builtin_amdgcn_s_sleep(16); }
#undef IN
#undef SEAM
#undef MOD
#undef PART
#undef RSQ
#undef COS
#undef SIN
#undef H
#undef LAT
#undef ZB
#undef QM
#undef KM
#undef VM
#undef OM
#undef PRE
#undef T1
#undef MB
#undef DQ
#undef DK
#undef DV
#undef SA
#undef SB
#undef XB
#undef ctl
#undef gw
#undef NGW
}

extern "C" void kernel_launch(void* const* d_in, const int* in_sizes, int n_in, void* d_out, int out_size, void* d_ws, size_t ws_size, hipStream_t stream) {
    static int grid = 0;
    if (grid == 0) {
        if (n_in != 30 || in_sizes[0] != T * D || out_size != T * D || ws_size < WS_NEED) { fprintf(stderr, "kernel_launch: unexpected shapes (n_in %d, in0 %d, out %d, ws %zu, need %zu)\n", n_in, n_in > 0 ? in_sizes[0] : -1, out_size, ws_size, (size_t)WS_NEED); grid = -1; return; }
        if (hipFuncSetAttribute((const void*)mk_fwd, hipFuncAttributeMaxDynamicSharedMemorySize, LDS_BYTES) != hipSuccess) { fprintf(stderr, "kernel_launch: hipFuncSetAttribute failed\n"); grid = -1; return; }
        int per_cu = 0;
        if (hipOccupancyMaxActiveBlocksPerMultiprocessor(&per_cu, (const void*)mk_fwd, NWAVES * 64, LDS_BYTES) != hipSuccess || per_cu < 1) fprintf(stderr, "kernel_launch: occupancy query reports %d\n", per_cu);
        (void)hipGetLastError();
        grid = 256;
    }
    if (grid < 0) return;
    if (hipMemsetAsync((char*)d_ws + WS_CTL, 0, CTL_ZERO_BYTES, stream) != hipSuccess) { fprintf(stderr, "kernel_launch: memset failed\n"); return; }
    Args a{};
    const float** fp = (const float**)&a.x;
    a.x = (const float*)d_in[0]; a.c = (const float*)d_in[1]; a.pos = (const int*)d_in[2]; a.w_ada = (const float*)d_in[3]; a.b_ada = (const float*)d_in[4]; a.w_in = (const float*)d_in[5];
    a.q_norm_g = (const float*)d_in[6]; a.w_q_up = (const float*)d_in[7]; a.kv_norm_g = (const float*)d_in[8]; a.w_kv_up = (const float*)d_in[9];
    a.lq1 = (const float*)d_in[10]; a.lk1 = (const float*)d_in[11]; a.lq2 = (const float*)d_in[12]; a.lk2 = (const float*)d_in[13]; a.diff_norm_g = (const float*)d_in[14];
    a.w_br_mla = (const float*)d_in[15]; a.w_br_diff = (const float*)d_in[16]; a.w_out = (const float*)d_in[17];
    a.ln1_g = (const float*)d_in[18]; a.ln1_b = (const float*)d_in[19]; a.ln2_g = (const float*)d_in[20]; a.ln2_b = (const float*)d_in[21];
    a.ffn_w1 = (const float*)d_in[22]; a.ffn_w3 = (const float*)d_in[23]; a.ffn_w2 = (const float*)d_in[24]; a.router_w = (const float*)d_in[25]; a.router_b = (const float*)d_in[26];
    a.moe_w1 = (const float*)d_in[27]; a.moe_w3 = (const float*)d_in[28]; a.moe_w2 = (const float*)d_in[29];
    (void)fp;
    a.out = (float*)d_out; a.ws = (unsigned char*)d_ws;
    for (int l = 0; l < 4; ++l) a.lam_init[l] = (float)(0.8 - 0.6 * exp(-0.3 * (double)l));
#if MK_PER_PHASE
    for (int p = 0; p < NPHASE; ++p) {
        const int k = (p - 2) % NPH_L, l = (p - 2) / NPH_L;
        if (p >= 2 && k == 6 && (l & 1) == 0) continue;
        a.ph_lo = p; a.ph_hi = p + 1;
        hipLaunchKernelGGL(mk_fwd, dim3(grid), dim3(NWAVES * 64), LDS_BYTES, stream, a);
    }
#else
    a.ph_lo = 0; a.ph_hi = NPHASE;
    hipLaunchKernelGGL(mk_fwd, dim3(grid), dim3(NWAVES * 64), LDS_BYTES, stream, a);
#endif
    const hipError_t le = hipPeekAtLastError();
    if (le != hipSuccess) fprintf(stderr, "kernel_launch: launch failed: %s\n", hipGetErrorName(le));
}
```

```cpp
#include <hip/hip_runtime.h>
#include <hip/hip_bf16.h>
#include <cstdio>
#include <cstdint>
#include <cmath>

#ifndef MK_PER_PHASE
#define MK_PER_PHASE 0
#endif
#ifndef PH_MASK
#define PH_MASK 0xFFFF
#endif
#define PHM(k) (((PH_MASK) >> (k)) & 1)
#ifndef STG_IN
#define STG_IN 0
#endif
#ifndef STG_BR
#define STG_BR 0
#endif
#ifndef STG_OUT
#define STG_OUT 0
#endif
#ifndef PROBE
#define PROBE 0
#endif

constexpr int D = 1024, BATCH = 16, SEQ = 2048, DEPTH = 4, T = BATCH * SEQ;
constexpr int NZ = 5888;
constexpr int FF = 2816, NEXP = 8;
constexpr float ALPHA = 1.681792830507429f;
constexpr float LN_EPS = 1e-5f, RMS_EPS = 1e-6f;
constexpr float LOG2E = 1.4426950408889634f;
constexpr float CQ_MLA = 0.10206207261596575f * LOG2E;
constexpr float CQ_DIFF = 0.125f * LOG2E;

#define LAS __attribute__((address_space(3)))
#define GAS __attribute__((address_space(1)))
typedef unsigned short bf16_t;
typedef short bf16x8 __attribute__((ext_vector_type(8)));
typedef short s16x4 __attribute__((ext_vector_type(4)));
typedef float f32x4 __attribute__((ext_vector_type(4)));
typedef float f32x2 __attribute__((ext_vector_type(2)));
typedef float f32x16 __attribute__((ext_vector_type(16)));
typedef unsigned u32x4 __attribute__((ext_vector_type(4)));
typedef unsigned u32x2 __attribute__((ext_vector_type(2)));

typedef __bf16 bf16x2_t __attribute__((ext_vector_type(2)));
__device__ __forceinline__ unsigned cvt_pk_bf16(float lo, float hi) { const f32x2 v = {lo, hi}; return __builtin_bit_cast(unsigned, __builtin_convertvector(v, bf16x2_t)); }
__device__ __forceinline__ u32x4 pack8(f32x4 a, f32x4 b) { u32x4 w; w.x = cvt_pk_bf16(a[0], a[1]); w.y = cvt_pk_bf16(a[2], a[3]); w.z = cvt_pk_bf16(b[0], b[1]); w.w = cvt_pk_bf16(b[2], b[3]); return w; }
__device__ __forceinline__ void unpack8(u32x4 w, f32x4& a, f32x4& b) {
    a[0] = __uint_as_float(w.x << 16); a[1] = __uint_as_float(w.x & 0xffff0000u); a[2] = __uint_as_float(w.y << 16); a[3] = __uint_as_float(w.y & 0xffff0000u);
    b[0] = __uint_as_float(w.z << 16); b[1] = __uint_as_float(w.z & 0xffff0000u); b[2] = __uint_as_float(w.w << 16); b[3] = __uint_as_float(w.w & 0xffff0000u); }
__device__ __forceinline__ unsigned pack4_fp8(float a, float b, float c, float d) {
    a = fminf(fmaxf(a, -448.f), 448.f); b = fminf(fmaxf(b, -448.f), 448.f); c = fminf(fmaxf(c, -448.f), 448.f); d = fminf(fmaxf(d, -448.f), 448.f);
    int w = 0; w = __builtin_amdgcn_cvt_pk_fp8_f32(a, b, w, false); w = __builtin_amdgcn_cvt_pk_fp8_f32(c, d, w, true); return (unsigned)w; }
constexpr float W8_SCALE_W2 = 128.0f;
constexpr float W8_SCALE = 32.0f;
__device__ __forceinline__ float bf2f(bf16_t v) { return __uint_as_float(((unsigned)v) << 16); }
template <int X> __device__ __forceinline__ float swz_xor(float v) { return __int_as_float(__builtin_amdgcn_ds_swizzle(__float_as_int(v), (X << 10) | 0x1f)); }
__device__ __forceinline__ float sum_x32(float v) { auto rr = __builtin_amdgcn_permlane32_swap(__float_as_uint(v), __float_as_uint(v), false, false); return __uint_as_float(rr[0]) + __uint_as_float(rr[1]); }
constexpr float LAT8_SCALE = 4.0f;
constexpr float DQ8_SCALE = 8.0f;
constexpr float O8_SCALE = 16.0f, W8_SCALE_BR = 64.0f;
__device__ __forceinline__ float sigmoidf_(float x) { return __builtin_amdgcn_rcpf(1.0f + __builtin_amdgcn_exp2f(-x * LOG2E)); }

namespace pg8 {
constexpr int BM = 256, BK = 64, HALF = 128, HTB = HALF * BK * 2, STAGE_BYTES = 8 * HTB, NXCD = 8, WGM = 8;
__host__ __device__ __forceinline__ int lds_byte(int r, int c) { const int st = (r >> 4) * 2 + (c >> 5), rr = r & 15, cc = c & 31, ob = rr * 64 + cc * 2; return st * 1024 + (ob ^ (((ob >> 9) & 1) << 5)); }
__host__ __device__ __forceinline__ void stage_rc(int b, int& R, int& C) { const int st = b / 1024, sb = b % 1024, swz = sb ^ (((sb >> 9) & 1) << 5); R = (st >> 1) * 16 + swz / 64; C = (st & 1) * 32 + (swz % 64) / 2; }
__host__ __device__ __forceinline__ int perm32(int rho) { const int n = rho >> 4, i = rho & 15; return 8 * (i >> 2) + 4 * n + (i & 3); }

struct Unit { int pm, pn; };
struct Gemm { const bf16_t* A; const bf16_t* Bt; int M, N, K, lda; };

struct StaticOrder {
    int nM, nN, nwg, G, c;
    __host__ __device__ void init(int M, int N, int G_, int c_) { nM = M / BM; nN = N / BM; nwg = nM * nN; G = G_; c = c_; }
    static constexpr bool GATHER = false; const int* rmap = nullptr;
    __host__ __device__ bool next(int i, Unit& u) const {
        const long L = (long)i * G + c; if (L >= nwg) return false;
        int wgid = (int)L; { const int q = nwg / NXCD, r = nwg % NXCD, xcd = wgid % NXCD, off = wgid / NXCD; wgid = (xcd < r ? xcd * (q + 1) : r * (q + 1) + (xcd - r) * q) + off; }
        const int nig = WGM * nN, gid = wgid / nig, fm = gid * WGM, gsz = (nM - fm) < WGM ? (nM - fm) : WGM;
        u.pm = fm + ((wgid % nig) % gsz); u.pn = (wgid % nig) / gsz; return true;
    }
    __device__ __forceinline__ size_t bofs(const Unit&) const { return 0; }
};
template <bool GATHER_> struct MoeOrderT {
    static constexpr bool GATHER = GATHER_;
    StaticOrder so; int ts1, ts2, ts3, ts4, ts5, ts6, ts7; size_t estride; const int* rmap;
    __device__ __forceinline__ bool next(int i, Unit& u) const { return so.next(i, u); }
    __device__ __forceinline__ size_t bofs(const Unit& u) const {
        const int e = (u.pm >= ts1) + (u.pm >= ts2) + (u.pm >= ts3) + (u.pm >= ts4) + (u.pm >= ts5) + (u.pm >= ts6) + (u.pm >= ts7);
        return (size_t)e * estride; }
};

template <class F, bool PERM_, bool WIDE_ = false> struct EpiRow {
    static constexpr bool PERM = PERM_, WIDE = WIDE_; F f;
    __device__ __forceinline__ void operator()(const f32x4 (&acc)[2][2][4][2], const Unit& u, int wr, int wc, int fr, int fq) const {
#pragma unroll
        for (int ai = 0; ai < 2; ++ai) {
            float rs[4];
#pragma unroll
            for (int m = 0; m < 4; ++m) rs[m] = f.rowscale(u.pm * BM + ai * HALF + wr * 64 + m * 16 + fr);
#pragma unroll
            for (int m = 0; m < 4; ++m) { const int row = u.pm * BM + ai * HALF + wr * 64 + m * 16 + fr;
#pragma unroll
                for (int bj = 0; bj < 2; ++bj) f(row, rs[m], u.pn * BM + (WIDE ? wc * 64 + bj * 32 : bj * HALF + wc * 32), fq, acc[ai][bj][m][0], acc[ai][bj][m][1]);
                if constexpr (F::HAS_PAIR && WIDE) f.pair(row, u.pn * BM + wc * 64, fq, acc[ai][0][m][0], acc[ai][0][m][1], acc[ai][1][m][0], acc[ai][1][m][1]);
                asm volatile("" ::: "memory"); __builtin_amdgcn_sched_barrier(0); }
        }
    }
};
struct EpiGate {
    static constexpr bool PERM = true, WIDE = true; bf16_t* G; float inscale;
    __device__ __forceinline__ void operator()(const f32x4 (&acc)[2][2][4][2], const Unit& u, int wr, int wc, int fr, int fq) const {
        const int col0 = u.pn * BM + wc * 64 + 8 * fq;
#pragma unroll
        for (int ai = 0; ai < 2; ++ai)
#pragma unroll
            for (int m = 0; m < 4; ++m) { const size_t o = (size_t)(u.pm * BM + ai * HALF + wr * 64 + m * 16 + fr) * 1024 + col0;
#pragma unroll
                for (int bj = 0; bj < 2; ++bj) *(u32x4*)(G + o + bj * 32) = pack8(acc[ai][bj][m][0] * inscale, acc[ai][bj][m][1] * inscale);
                __builtin_amdgcn_sched_barrier(0); }
    }
};
__device__ __forceinline__ void unpack8_fp8(u32x2 w, f32x4& a, f32x4& b) {
    const f32x2 a0 = __builtin_amdgcn_cvt_pk_f32_fp8((int)w.x, false), a1 = __builtin_amdgcn_cvt_pk_f32_fp8((int)w.x, true);
    const f32x2 b0 = __builtin_amdgcn_cvt_pk_f32_fp8((int)w.y, false), b1 = __builtin_amdgcn_cvt_pk_f32_fp8((int)w.y, true);
    a[0] = a0[0]; a[1] = a0[1]; a[2] = a1[0]; a[3] = a1[1]; b[0] = b0[0]; b[1] = b0[1]; b[2] = b1[0]; b[3] = b1[1]; }
constexpr float Y8_SCALE = 16.0f, MB8_SCALE = 32.0f;
template <int MODE> struct EpiBr {
    static constexpr bool PERM = true, WIDE = true; void* O; const unsigned char* SA8; const unsigned char* SB8; const unsigned char* Y8; float inscale;
    __device__ __forceinline__ void operator()(const f32x4 (&acc)[2][2][4][2], const Unit& u, int wr, int wc, int fr, int fq) const {
        const int col0 = u.pn * BM + wc * 64 + 8 * fq;
#pragma unroll
        for (int ai = 0; ai < 2; ++ai) {
            if (MODE == 1) {
#pragma unroll
                for (int m = 0; m < 4; ++m) { const size_t o = (size_t)(u.pm * BM + ai * HALF + wr * 64 + m * 16 + fr) * 1024 + col0;
#pragma unroll
                    for (int bj = 0; bj < 2; ++bj) { const f32x4 r0 = acc[ai][bj][m][0] * (Y8_SCALE * inscale), r1 = acc[ai][bj][m][1] * (Y8_SCALE * inscale);
                        u32x2 w8; w8.x = pack4_fp8(r0[0], r0[1], r0[2], r0[3]); w8.y = pack4_fp8(r1[0], r1[1], r1[2], r1[3]);
                        *(u32x2*)((unsigned char*)O + o + bj * 32) = w8; }
                    __builtin_amdgcn_sched_barrier(0); }
            } else {
                u32x2 av[4][2], bv[4][2], yv[4][2];
#pragma unroll
                for (int m = 0; m < 4; ++m) { const size_t o = (size_t)(u.pm * BM + ai * HALF + wr * 64 + m * 16 + fr) * 1024 + col0;
#pragma unroll
                    for (int bj = 0; bj < 2; ++bj) { av[m][bj] = *(const u32x2*)(SA8 + o + bj * 32); bv[m][bj] = *(const u32x2*)(SB8 + o + bj * 32); yv[m][bj] = *(const u32x2*)(Y8 + o + bj * 32); } }
#pragma unroll
                for (int m = 0; m < 4; ++m) { const size_t o = (size_t)(u.pm * BM + ai * HALF + wr * 64 + m * 16 + fr) * 1024 + col0;
#pragma unroll
                    for (int bj = 0; bj < 2; ++bj) { f32x4 a0, a1, b0, b1, y0, y1; unpack8_fp8(av[m][bj], a0, a1); unpack8_fp8(bv[m][bj], b0, b1); unpack8_fp8(yv[m][bj], y0, y1);
                        const f32x4 r0 = acc[ai][bj][m][0] * b0 * (MB8_SCALE * inscale) + a0 * y0 * (MB8_SCALE / Y8_SCALE), r1 = acc[ai][bj][m][1] * b1 * (MB8_SCALE * inscale) + a1 * y1 * (MB8_SCALE / Y8_SCALE);
                        u32x2 w8; w8.x = pack4_fp8(r0[0], r0[1], r0[2], r0[3]); w8.y = pack4_fp8(r1[0], r1[1], r1[2], r1[3]);
                        *(u32x2*)((unsigned char*)O + o + bj * 32) = w8; } }
                asm volatile("" ::: "memory"); __builtin_amdgcn_sched_barrier(0);
            }
        }
    }
};
struct EpiMoeOut {
    static constexpr bool PERM = true, WIDE = true; bf16_t* Y; const int* RMAP; float inscale;
    __device__ __forceinline__ void operator()(const f32x4 (&acc)[2][2][4][2], const Unit& u, int wr, int wc, int fr, int fq) const {
        const int col0 = u.pn * BM + wc * 64 + 8 * fq; int sl[2][4];
#pragma unroll
        for (int ai = 0; ai < 2; ++ai)
#pragma unroll
            for (int m = 0; m < 4; ++m) sl[ai][m] = RMAP[u.pm * BM + ai * HALF + wr * 64 + m * 16 + fr];
#pragma unroll
        for (int ai = 0; ai < 2; ++ai)
#pragma unroll
            for (int m = 0; m < 4; ++m) { if (sl[ai][m] >= 0) {
#pragma unroll
                for (int bj = 0; bj < 2; ++bj) *(u32x4*)(Y + (size_t)sl[ai][m] * 1024 + col0 + bj * 32) = pack8(acc[ai][bj][m][0] * inscale, acc[ai][bj][m][1] * inscale); }
                __builtin_amdgcn_sched_barrier(0); }
    }
};
struct EpiSwiglu {
    static constexpr bool PERM = true, WIDE = false; bf16_t* U; int ldu; float inscale; bool out8;
    __device__ __forceinline__ void operator()(const f32x4 (&acc)[2][2][4][2], const Unit& u, int wr, int wc, int fr, int fq) const {
#pragma unroll
        for (int ai = 0; ai < 2; ++ai)
#pragma unroll
            for (int m = 0; m < 4; ++m) { const int row = u.pm * BM + ai * HALF + wr * 64 + m * 16 + fr;
                f32x4 o[2];
#pragma unroll
                for (int n = 0; n < 2; ++n) { const f32x4 a = acc[ai][0][m][n] * inscale, b = acc[ai][1][m][n] * inscale;
#pragma unroll
                    for (int i = 0; i < 4; ++i) o[n][i] = a[i] * sigmoidf_(a[i]) * b[i]; }
                if (out8) { u32x2 w8; w8.x = pack4_fp8(o[0][0], o[0][1], o[0][2], o[0][3]); w8.y = pack4_fp8(o[1][0], o[1][1], o[1][2], o[1][3]);
                    *(u32x2*)((unsigned char*)U + (size_t)row * ldu + u.pn * HALF + wc * 32 + 8 * fq) = w8; }
                else *(u32x4*)(U + (size_t)row * ldu + u.pn * HALF + wc * 32 + 8 * fq) = pack8(o[0], o[1]);
                __builtin_amdgcn_sched_barrier(0); }
    }
};

template <int STG_US = 0, bool FP8 = false, class Epi, class Sched, bool ALIGN_EPI = true>
__device__ __forceinline__ void gemm_phase(LAS unsigned char* lds, int tid_in, const Gemm g, const Sched& S, const Epi& E) {
    int tid_ = tid_in; asm volatile("" : "+v"(tid_));
    const int tid = tid_, wid = __builtin_amdgcn_readfirstlane(tid >> 6), lane = tid & 63, wr = wid >> 2, wc = wid & 3, fr = lane & 15, fq = lane >> 4;
    const int K = g.K, nt = K / BK, lda = g.lda;
    unsigned voffA[2], voffB[2];
#pragma unroll
    for (int i = 0; i < 2; ++i) { int R, C; stage_rc(tid * 16 + i * 8192, R, C);
        const int Rb = Epi::WIDE ? (64 * (R >> 5) + perm32(R & 31)) : (Epi::PERM ? ((R & ~31) + perm32(R & 31)) : R);
        voffA[i] = (unsigned)(R * lda + C) * 2u; voffB[i] = (unsigned)(Rb * K + C) * 2u; }
    const size_t kstep = (size_t)(BK * 2);
    constexpr bool GATHER = Sched::GATHER;
    unsigned oc[2], on[2], cb2[2];
    const size_t hstepA = (size_t)HALF * lda * 2, hstepB = Epi::WIDE ? (size_t)32 * K * 2 : (size_t)HALF * K * 2;
    const size_t tstepA = 2 * hstepA, tstepB = (size_t)BM * K * 2;
    const unsigned ldsw = (unsigned)wid * 1024u;
    const int aoff = lds_byte(wr * 64 + fr, fq * 8), boff = lds_byte(wc * 32 + fr, fq * 8);
#define PG8_SA(b, h) (((b) * 2 + (h)) * HTB)
#define PG8_SB(b, h) ((4 + (b) * 2 + (h)) * HTB)
#define PG8_STAGE(bufoff, gbase, voff) do { _Pragma("unroll") for (int _i = 0; _i < 2; ++_i) \
        __builtin_amdgcn_global_load_lds((const unsigned*)((const char*)(gbase) + (voff)[_i]), (LAS unsigned*)(lds + (bufoff) + ldsw + _i * 8192), 16, 0, 0); } while (0)
#define PG8_GOFF(dst, u) do { if constexpr (GATHER) { _Pragma("unroll") for (int h_ = 0; h_ < 2; ++h_) { unsigned pk_ = 0u; _Pragma("unroll") for (int i_ = 0; i_ < 2; ++i_) { int R_, C_; stage_rc(tid * 16 + i_ * 8192, R_, C_); \
        const int sl_ = S.rmap[(u).pm * BM + h_ * HALF + R_]; pk_ |= (unsigned)((sl_ < 0 ? 0 : sl_) >> 1) << (16 * i_); } dst[h_] = pk_; } } } while (0)
#define PG8_STAGE_A(bufoff, gptr, h, NXT) do { if constexpr (GATHER) { const unsigned pk_ = ((NXT) && last_) ? on[h] : oc[h]; \
        unsigned go_[2]; go_[0] = (pk_ & 0xffffu) * (unsigned)(lda * 2) + cb2[0]; go_[1] = (pk_ >> 16) * (unsigned)(lda * 2) + cb2[1]; PG8_STAGE(bufoff, gptr, go_); } \
        else PG8_STAGE(bufoff, (gptr) + (h) * hstepA, voffA); } while (0)
#define PG8_LDA(dst, b, h) do { if constexpr (FP8) { _Pragma("unroll") for (int m = 0; m < 4; ++m) { const i32x4_ lo_ = *(const LAS i32x4_*)(lds + PG8_SA(b, h) + aoff + m * 2048), hi_ = *(const LAS i32x4_*)(lds + PG8_SA(b, h) + aoff + m * 2048 + 1024); \
        dst##8[m] = __builtin_shufflevector(lo_, hi_, 0, 1, 2, 3, 4, 5, 6, 7); } } \
    else { _Pragma("unroll") for (int m = 0; m < 4; ++m) _Pragma("unroll") for (int k = 0; k < 2; ++k) dst[m][k] = *(const LAS bf16x8*)(lds + PG8_SA(b, h) + aoff + m * 2048 + k * 1024); } } while (0)
#define PG8_LDB(dst, b, h) do { if constexpr (FP8) { _Pragma("unroll") for (int n = 0; n < 2; ++n) { const i32x4_ lo_ = *(const LAS i32x4_*)(lds + PG8_SB(b, h) + boff + n * 2048), hi_ = *(const LAS i32x4_*)(lds + PG8_SB(b, h) + boff + n * 2048 + 1024); \
        dst##8[n] = __builtin_shufflevector(lo_, hi_, 0, 1, 2, 3, 4, 5, 6, 7); } } \
    else { _Pragma("unroll") for (int n = 0; n < 2; ++n) _Pragma("unroll") for (int k = 0; k < 2; ++k) dst[n][k] = *(const LAS bf16x8*)(lds + PG8_SB(b, h) + boff + n * 2048 + k * 1024); } } while (0)
#define PG8_MMA(ai, bj, At, Bt) do { __builtin_amdgcn_s_setprio(1); if constexpr (FP8) { _Pragma("unroll") for (int m = 0; m < 4; ++m) _Pragma("unroll") for (int n = 0; n < 2; ++n) \
        asm volatile("v_mfma_f32_16x16x128_f8f6f4 %0, %1, %2, %0" : "+v"(acc[ai][bj][m][n]) : "v"(Bt##8[n]), "v"(At##8[m])); } \
      else { _Pragma("unroll") for (int m = 0; m < 4; ++m) _Pragma("unroll") for (int n = 0; n < 2; ++n) _Pragma("unroll") for (int k = 0; k < 2; ++k) \
        acc[ai][bj][m][n] = __builtin_amdgcn_mfma_f32_16x16x32_bf16(Bt[n][k], At[m][k], acc[ai][bj][m][n], 0, 0, 0); } __builtin_amdgcn_s_setprio(0); } while (0)
#define PG8_WAIT_V(n) asm volatile("s_waitcnt vmcnt(" #n ")" ::: "memory")
#define PG8_WAIT_L(n) asm volatile("s_waitcnt lgkmcnt(" #n ")" ::: "memory")
#define PG8_BAR __builtin_amdgcn_s_barrier()
#define PG8_SCHED __builtin_amdgcn_sched_barrier(0)
    Unit cur, nxt; int ui = 0;
    if (!S.next(0, cur)) return;
    if (STG_US > 0 && blockIdx.x >= 128) { const unsigned long long t0_ = __builtin_amdgcn_s_memrealtime(); while (__builtin_amdgcn_s_memrealtime() - t0_ < (unsigned long long)(STG_US * 100)) __builtin_amdgcn_s_sleep(8); }
    f32x4 acc[2][2][4][2];
#pragma unroll
    for (int a = 0; a < 2; ++a)
#pragma unroll
        for (int b = 0; b < 2; ++b)
#pragma unroll
            for (int m = 0; m < 4; ++m)
#pragma unroll
                for (int n = 0; n < 2; ++n) acc[a][b][m][n] = (f32x4){0.f, 0.f, 0.f, 0.f};
    typedef int i32x4_ __attribute__((ext_vector_type(4))); typedef int i32x8_ __attribute__((ext_vector_type(8)));
    int scl8 = 0x7f7f7f7f; asm volatile("" : "+v"(scl8));
    bf16x8 At[4][2], B0[2][2], B1[2][2]; i32x8_ At8[4], B08[2], B18[2];
    const char* cA = (const char*)g.A + (GATHER ? (size_t)0 : (size_t)cur.pm * tstepA); const char* cB = (const char*)g.Bt + S.bofs(cur) + (size_t)cur.pn * tstepB;
    if constexpr (GATHER) { _Pragma("unroll") for (int i_ = 0; i_ < 2; ++i_) { int R_, C_; stage_rc(tid * 16 + i_ * 8192, R_, C_); cb2[i_] = (unsigned)C_ * 2u; } }
    PG8_GOFF(oc, cur); bool last_ = false;
    PG8_STAGE(PG8_SB(0, 0), cB, voffB); PG8_STAGE(PG8_SB(0, 1), cB + hstepB, voffB); PG8_STAGE_A(PG8_SA(0, 0), cA, 0, false); PG8_STAGE_A(PG8_SA(0, 1), cA, 1, false);
    if (wr == 1) PG8_BAR;
    PG8_WAIT_V(2); PG8_BAR;
    PG8_STAGE(PG8_SB(1, 0), cB + kstep, voffB); PG8_STAGE_A(PG8_SA(1, 0), cA + kstep, 0, false); PG8_STAGE(PG8_SB(1, 1), cB + hstepB + kstep, voffB);
    PG8_WAIT_V(6); PG8_BAR;
    for (;;) {
        const bool has_next = S.next(ui + 1, nxt);
        if (has_next) PG8_GOFF(on, nxt); else { if constexpr (GATHER) { on[0] = oc[0]; on[1] = oc[1]; } }
        const char* nA = (has_next && !GATHER) ? (const char*)g.A + (size_t)nxt.pm * tstepA : cA; const char* nB = has_next ? (const char*)g.Bt + S.bofs(nxt) + (size_t)nxt.pn * tstepB : cB;
        const int nte = (PROBE == 20) ? 2 * nt : nt;
#define PG8_KT(x) (((x) >= nt) ? (x) - nt : (x))
#pragma unroll 1
        for (int t = 0; t < nte; t += 2) {
            const bool last = (t == nte - 2); last_ = last;
            asm volatile("" : "+v"(voffA[0]), "+v"(voffA[1]), "+v"(voffB[0]), "+v"(voffB[1]));
            const char* a1 = cA + (size_t)PG8_KT(t + 1) * kstep;
            const char* a2 = last ? nA : cA + (size_t)PG8_KT(t + 2) * kstep; const char* b2 = last ? nB : cB + (size_t)PG8_KT(t + 2) * kstep;
            const char* a3 = a2 + kstep; const char* b3 = b2 + kstep;
            PG8_LDB(B0, 0, 0); PG8_LDB(B1, 0, 1); PG8_SCHED; PG8_LDA(At, 0, 0); PG8_STAGE_A(PG8_SA(1, 1), a1, 1, false);
            PG8_WAIT_V(8); PG8_WAIT_L(0); PG8_BAR; PG8_MMA(0, 0, At, B0); PG8_MMA(0, 1, At, B1); PG8_BAR; PG8_SCHED;
            PG8_LDA(At, 0, 1); PG8_STAGE(PG8_SB(0, 0), b2, voffB); PG8_STAGE(PG8_SB(0, 1), b2 + hstepB, voffB); PG8_STAGE_A(PG8_SA(0, 0), a2, 0, true);
            PG8_WAIT_V(8); PG8_WAIT_L(0); PG8_BAR; PG8_MMA(1, 0, At, B0); PG8_MMA(1, 1, At, B1); PG8_BAR; PG8_SCHED;
            PG8_LDB(B0, 1, 0); PG8_LDB(B1, 1, 1); PG8_SCHED; PG8_LDA(At, 1, 0); PG8_STAGE_A(PG8_SA(0, 1), a2, 1, true);
            PG8_WAIT_V(8); PG8_WAIT_L(0); PG8_BAR; PG8_MMA(0, 0, At, B0); PG8_MMA(0, 1, At, B1); PG8_BAR; PG8_SCHED;
            PG8_LDA(At, 1, 1); PG8_STAGE(PG8_SB(1, 0), b3, voffB); PG8_STAGE(PG8_SB(1, 1), b3 + hstepB, voffB); PG8_STAGE_A(PG8_SA(1, 0), a3, 0, true);
            PG8_WAIT_V(8); PG8_WAIT_L(0); PG8_BAR; PG8_MMA(1, 0, At, B0); PG8_MMA(1, 1, At, B1); PG8_BAR; PG8_SCHED;
        }
        if constexpr (FP8) asm volatile("s_nop 15\n\ts_nop 15" ::: "memory");
        if constexpr (ALIGN_EPI) { if (wr == 0) PG8_BAR; }
        if (PROBE == 20) {
#pragma unroll
            for (int a = 0; a < 2; ++a)
#pragma unroll
                for (int b = 0; b < 2; ++b)
#pragma unroll
                    for (int m = 0; m < 4; ++m)
#pragma unroll
                        for (int n = 0; n < 2; ++n) acc[a][b][m][n] = acc[a][b][m][n] * 0.5f; }
        _Pragma("unroll 1") for (int rep_ = 0; rep_ < (PROBE == 21 ? 2 : 1); ++rep_) { E(acc, cur, wr, wc, fr, fq); if (PROBE == 21) asm volatile("" ::: "memory"); }
        if (!has_next) break;
#pragma unroll
        for (int a = 0; a < 2; ++a)
#pragma unroll
            for (int b = 0; b < 2; ++b)
#pragma unroll
                for (int m = 0; m < 4; ++m)
#pragma unroll
                    for (int n = 0; n < 2; ++n) acc[a][b][m][n] = (f32x4){0.f, 0.f, 0.f, 0.f};
        cur = nxt; cA = nA; cB = nB; ++ui;
        if constexpr (GATHER) { oc[0] = on[0]; oc[1] = on[1]; }
        if constexpr (ALIGN_EPI) { if (wr == 1) PG8_BAR; }
    }
    PG8_WAIT_V(0);
    if constexpr (!ALIGN_EPI) { if (wr == 0) PG8_BAR; }
    PG8_BAR;
#undef PG8_KT
#undef PG8_GOFF
#undef PG8_STAGE_A
#undef PG8_SA
#undef PG8_SB
#undef PG8_STAGE
#undef PG8_LDA
#undef PG8_LDB
#undef PG8_MMA
#undef PG8_WAIT_V
#undef PG8_WAIT_L
#undef PG8_BAR
#undef PG8_SCHED
}
}

namespace att {
constexpr int NW = 8, QBLK = 32, KVBLK = 64;
constexpr float THR = 11.5f;
constexpr size_t SHM_V = 16384, SHM_K = 16384;
constexpr size_t OFF_RAW = 101120, OFF_R32 = OFF_RAW + 2048 * 4;
constexpr size_t OFF_V = 0, OFF_K = 3 * SHM_V, OFF_WS = OFF_K + 2 * SHM_K, OFF_POS = OFF_WS + NW * 64 * 4, OFF_NCL = OFF_POS + SEQ * 4, OFF_ZER = OFF_NCL + SEQ * 4, OFF_EXT = OFF_ZER + 256, ATT_LDS = OFF_EXT + 512;
static_assert(ATT_LDS == 101120, "attention LDS layout");
#define KSWZ(row, colB) ((row) * 256 + ((colB) ^ (((row) & 15) << 4)))
#define SBAR() __builtin_amdgcn_sched_barrier(0)
__device__ __forceinline__ int crow(int r, int hi) { return (r & 3) + 8 * (r >> 2) + 4 * hi; }
__device__ __forceinline__ unsigned cvtpk(float lo, float hi) { return cvt_pk_bf16(lo, hi); }
__device__ __forceinline__ unsigned char cvt_fp8_1(float v) { v = __builtin_amdgcn_fmed3f(v, -448.0f, 448.0f); return (unsigned char)(__builtin_amdgcn_cvt_pk_fp8_f32(v, v, 0, false) & 0xff); }

__device__ __forceinline__ void partialSM(f32x16& p0, f32x16& p1, float& m_reg, float& mn, float& alpha) {
  float pmax = p0[0];
#pragma unroll
  for (int r = 1; r < 16; ++r) pmax = fmaxf(pmax, p0[r]);
#pragma unroll
  for (int r = 0; r < 16; ++r) pmax = fmaxf(pmax, p1[r]);
  { auto rr = __builtin_amdgcn_permlane32_swap(__float_as_uint(pmax), __float_as_uint(pmax), false, false);
    pmax = fmaxf(__uint_as_float(rr[0]), __uint_as_float(rr[1])); }
  if (__builtin_expect(__all(pmax - m_reg <= THR), 1)) { mn = m_reg; alpha = 1.f; }
  else { mn = fmaxf(m_reg, pmax); alpha = __builtin_amdgcn_exp2f(m_reg - mn); m_reg = mn; }
#pragma unroll
  for (int r = 0; r < 16; ++r) p0[r] = p0[r] - mn;
#pragma unroll
  for (int r = 0; r < 16; ++r) p1[r] = p1[r] - mn;
#pragma unroll
  for (int r = 0; r < 16; ++r) p0[r] = __builtin_amdgcn_exp2f(p0[r]);
}
__device__ __forceinline__ bool partialSM_adj(f32x16& p0, f32x16& p1, float& m_reg, float& mn, float& alpha, float radj, float skip_th) {
  float pmax = p0[0];
#pragma unroll
  for (int r = 1; r < 16; ++r) pmax = fmaxf(pmax, p0[r]);
#pragma unroll
  for (int r = 0; r < 16; ++r) pmax = fmaxf(pmax, p1[r]);
  { auto rr = __builtin_amdgcn_permlane32_swap(__float_as_uint(pmax), __float_as_uint(pmax), false, false);
    pmax = fmaxf(__uint_as_float(rr[0]), __uint_as_float(rr[1])); }
  pmax += radj;
  if (__all(pmax < m_reg - skip_th)) { mn = m_reg; alpha = 1.f; return true; }
  if (__builtin_expect(__all(pmax - m_reg <= THR), 1)) { mn = m_reg; alpha = 1.f; }
  else { mn = fmaxf(m_reg, pmax); alpha = __builtin_amdgcn_exp2f(m_reg - mn); m_reg = mn; }
  const float off = mn - radj;
#pragma unroll
  for (int r = 0; r < 16; ++r) p0[r] = p0[r] - off;
#pragma unroll
  for (int r = 0; r < 16; ++r) p1[r] = p1[r] - off;
#pragma unroll
  for (int r = 0; r < 16; ++r) p0[r] = __builtin_amdgcn_exp2f(p0[r]);
  return false;
}
__device__ __forceinline__ void partialSM_rel(f32x16& p0, f32x16& p1, float& m_reg, f32x16& negm, float& alpha, bool first) {
  float pmax = p0[0];
#pragma unroll
  for (int r = 1; r < 16; ++r) pmax = fmaxf(pmax, p0[r]);
#pragma unroll
  for (int r = 0; r < 16; ++r) pmax = fmaxf(pmax, p1[r]);
  { auto rr = __builtin_amdgcn_permlane32_swap(__float_as_uint(pmax), __float_as_uint(pmax), false, false);
    pmax = fmaxf(__uint_as_float(rr[0]), __uint_as_float(rr[1])); }
  if (__builtin_expect(!first && __all(pmax <= THR), 1)) { alpha = 1.f; }
  else { const float dl = first ? pmax : fmaxf(pmax, 0.f); m_reg += dl; alpha = first ? 0.f : __builtin_amdgcn_exp2f(-dl);
#pragma unroll
    for (int r = 0; r < 16; ++r) { p0[r] -= dl; p1[r] -= dl; }
#pragma unroll
    for (int r = 0; r < 16; ++r) negm[r] = -m_reg;
    asm volatile("" : "+v"(negm)); }
#pragma unroll
  for (int r = 0; r < 16; ++r) p0[r] = __builtin_amdgcn_exp2f(p0[r]);
}
__device__ __forceinline__ void finishSM(f32x16& p0, f32x16& p1, float alpha, float& l_reg, bf16x8& pa0, bf16x8& pa1, bf16x8& pa2, bf16x8& pa3) {
#pragma unroll
  for (int r = 0; r < 16; ++r) p1[r] = __builtin_amdgcn_exp2f(p1[r]);
  float ps = 0;
#pragma unroll
  for (int r = 0; r < 16; ++r) ps += p0[r];
#pragma unroll
  for (int r = 0; r < 16; ++r) ps += p1[r];
  { auto rr = __builtin_amdgcn_permlane32_swap(__float_as_uint(ps), __float_as_uint(ps), false, false);
    ps = __uint_as_float(rr[0]) + __uint_as_float(rr[1]); }
  l_reg = l_reg * alpha + ps;
#define PK4(P, BASE, OUT) do { unsigned a0 = cvtpk(P[BASE + 0], P[BASE + 1]), a1 = cvtpk(P[BASE + 2], P[BASE + 3]);   \
    unsigned b0 = cvtpk(P[BASE + 4], P[BASE + 5]), b1 = cvtpk(P[BASE + 6], P[BASE + 7]);                              \
    auto r0 = __builtin_amdgcn_permlane32_swap(a0, b0, false, false); auto r1 = __builtin_amdgcn_permlane32_swap(a1, b1, false, false); \
    u32x4 w = {r0[0], r1[0], r0[1], r1[1]}; OUT = *reinterpret_cast<bf16x8*>(&w); } while (0)
  PK4(p0, 0, pa0); PK4(p0, 8, pa1); PK4(p1, 0, pa2); PK4(p1, 8, pa3);
#undef PK4
}
template <int NQK> __device__ __forceinline__ void qkt(f32x16& p0, f32x16& p1, const char* Ks, const bf16x8* qr, int r32, int hi, int colb0) {
#pragma unroll
  for (int d0 = 0; d0 < NQK; ++d0) { const int cb = colb0 + (d0 * 16 + hi * 8) * 2;
    bf16x8 b0 = *reinterpret_cast<const bf16x8*>(Ks + KSWZ(r32, cb));
    bf16x8 b1 = *reinterpret_cast<const bf16x8*>(Ks + KSWZ(32 + r32, cb));
    p0 = __builtin_amdgcn_mfma_f32_32x32x16_bf16(b0, qr[d0], p0, 0, 0, 0);
    p1 = __builtin_amdgcn_mfma_f32_32x32x16_bf16(b1, qr[d0], p1, 0, 0, 0); }
}
template <int NCB> __device__ __forceinline__ int v_st(int k, int c) { const int kk = (k & ~0xC) | ((k & 4) << 1) | ((k & 8) >> 1); return ((kk >> 3) * NCB + (c >> 5)) * 512 + ((kk & 7) * 32 + (c & 31)) * 2; }
__device__ __forceinline__ int v_rd_base(int lane) { return ((lane & 3) << 3) | (((lane >> 2) & 3) << 6) | (((lane >> 4) & 1) << 5) | (((lane >> 5) & 1) << 8); }
template <int NCB> constexpr int v_rd_off(int d0, int ks, int half) { return d0 * 512 + (2 * ks + half) * NCB * 512; }
template <int OFF> __device__ __forceinline__ s16x4 tr_read(int vb) { s16x4 r; asm volatile("ds_read_b64_tr_b16 %0, %1 offset:%2" : "=&v"(r) : "v"(vb), "i"(OFF) : "memory"); return r; }
template <int NCB, int D0> __device__ __forceinline__ void pv_one(f32x16& od, int vb, bf16x8 pa0, bf16x8 pa1, bf16x8 pa2, bf16x8 pa3) {
  const s16x4 l0 = tr_read<v_rd_off<NCB>(D0, 0, 0)>(vb), h0 = tr_read<v_rd_off<NCB>(D0, 0, 1)>(vb), l1 = tr_read<v_rd_off<NCB>(D0, 1, 0)>(vb), h1 = tr_read<v_rd_off<NCB>(D0, 1, 1)>(vb);
  const s16x4 l2 = tr_read<v_rd_off<NCB>(D0, 2, 0)>(vb), h2 = tr_read<v_rd_off<NCB>(D0, 2, 1)>(vb), l3 = tr_read<v_rd_off<NCB>(D0, 3, 0)>(vb), h3 = tr_read<v_rd_off<NCB>(D0, 3, 1)>(vb);
  asm volatile("s_waitcnt lgkmcnt(0)" ::: "memory"); SBAR();
#define PK(L, H) (bf16x8){L[0], L[1], L[2], L[3], H[0], H[1], H[2], H[3]}
  od = __builtin_amdgcn_mfma_f32_32x32x16_bf16(pa0, PK(l0, h0), od, 0, 0, 0);
  od = __builtin_amdgcn_mfma_f32_32x32x16_bf16(pa1, PK(l1, h1), od, 0, 0, 0);
  od = __builtin_amdgcn_mfma_f32_32x32x16_bf16(pa2, PK(l2, h2), od, 0, 0, 0);
  od = __builtin_amdgcn_mfma_f32_32x32x16_bf16(pa3, PK(l3, h3), od, 0, 0, 0);
#undef PK
}
template <int NCB> __device__ __forceinline__ void pv_all(f32x16* o, int vb, bf16x8 pa0, bf16x8 pa1, bf16x8 pa2, bf16x8 pa3) {
  pv_one<NCB, 0>(o[0], vb, pa0, pa1, pa2, pa3); pv_one<NCB, 1>(o[1], vb, pa0, pa1, pa2, pa3);
  if constexpr (NCB == 4) { pv_one<NCB, 2>(o[2], vb, pa0, pa1, pa2, pa3); pv_one<NCB, 3>(o[3], vb, pa0, pa1, pa2, pa3); }
}
__device__ __forceinline__ void alibi(f32x16& p0, f32x16& p1, const float* cl, int k0, int hi, float rl) {
  const float* pk = cl + k0 + 4 * hi;
#pragma unroll
  for (int g = 0; g < 4; ++g) { const f32x4 a = *(const f32x4*)(pk + 8 * g), b = *(const f32x4*)(pk + 32 + 8 * g);
#pragma unroll
    for (int i = 0; i < 4; ++i) { p0[4 * g + i] -= fabsf(rl - a[i]); p1[4 * g + i] -= fabsf(rl - b[i]); } }
}
__device__ __forceinline__ void load_c(f32x16& p0, f32x16& p1, const float* cp, int hi) {
  const float* pk = cp + 4 * hi;
#pragma unroll
  for (int g = 0; g < 4; ++g) { const f32x4 a = *(const f32x4*)(pk + 8 * g), b = *(const f32x4*)(pk + 32 + 8 * g);
#pragma unroll
    for (int i = 0; i < 4; ++i) { p0[4 * g + i] = a[i]; p1[4 * g + i] = b[i]; } }
}

__device__ __forceinline__ float wmin64(float v) { v = fminf(v, swz_xor<1>(v)); v = fminf(v, swz_xor<2>(v)); v = fminf(v, swz_xor<4>(v)); v = fminf(v, swz_xor<8>(v)); v = fminf(v, swz_xor<16>(v));
  auto rr = __builtin_amdgcn_permlane32_swap(__float_as_uint(v), __float_as_uint(v), false, false); return fminf(__uint_as_float(rr[0]), __uint_as_float(rr[1])); }
__device__ __forceinline__ float wmax64(float v) { v = fmaxf(v, swz_xor<1>(v)); v = fmaxf(v, swz_xor<2>(v)); v = fmaxf(v, swz_xor<4>(v)); v = fmaxf(v, swz_xor<8>(v)); v = fmaxf(v, swz_xor<16>(v));
  auto rr = __builtin_amdgcn_permlane32_swap(__float_as_uint(v), __float_as_uint(v), false, false); return fmaxf(__uint_as_float(rr[0]), __uint_as_float(rr[1])); }
constexpr float SKIP_TH = 20.f;
struct DiffArgs { const int* pos; float sl; float lam; float oscale; const float* ng; float kmax2; int khoff; };

__device__ __forceinline__ void diff_pos_setup(const int* __restrict__ pos, char* lds, int tid) {
  float* rawp = (float*)(lds + OFF_RAW); float* r32t = (float*)(lds + OFF_R32);
  const int p0 = pos[0];
  for (int i = tid; i < SEQ; i += NW * 64) { const float v = (float)(pos[i] - p0); rawp[i] = v;
    float mn = v, mx = v;
    mn = fminf(mn, swz_xor<1>(mn)); mn = fminf(mn, swz_xor<2>(mn)); mn = fminf(mn, swz_xor<4>(mn)); mn = fminf(mn, swz_xor<8>(mn)); mn = fminf(mn, swz_xor<16>(mn));
    mx = fmaxf(mx, swz_xor<1>(mx)); mx = fmaxf(mx, swz_xor<2>(mx)); mx = fmaxf(mx, swz_xor<4>(mx)); mx = fmaxf(mx, swz_xor<8>(mx)); mx = fmaxf(mx, swz_xor<16>(mx));
    if ((tid & 31) == 0) { r32t[i >> 5] = mn; r32t[64 + (i >> 5)] = mx; } }
  __syncthreads();
}
template <bool DIFF>
__device__ __forceinline__ void attn_unit(const bf16_t* __restrict__ Qb, const bf16_t* __restrict__ Kh, const bf16_t* __restrict__ Vh, unsigned char* __restrict__ Ob, int q0, const DiffArgs da, char* lds, LAS unsigned char* ldsl, int tid_in) {
  constexpr int LDQ = DIFF ? 1024 : 768, LDK = DIFF ? 1024 : 768, LDV = DIFF ? 1024 : 512, LDO = DIFF ? 1024 : 512;
  constexpr int NQK = DIFF ? 4 : 6, NDV = DIFF ? 4 : 2, KCH = DIFF ? 16 : 12, NVP = DIFF ? 2 : 1;
  int tid_ = tid_in; asm volatile("" : "+v"(tid_));
  const int tid = tid_, wid = __builtin_amdgcn_readfirstlane(tid >> 6), lane = tid & 63, r32 = lane & 31, hi = lane >> 5;
  const int mp = DIFF ? (wid >> 2) : 0, wrow = DIFF ? (wid & 3) * QBLK : wid * QBLK;
  char* V_lds = lds + OFF_V; char* K_lds = lds + OFF_K;
  float* ws = (float*)(lds + OFF_WS) + wid * 64; float* li_l = ws; float* al_l = ws + 32;
  float* posl = (float*)(lds + OFF_POS);
  float* ncl = (float*)(lds + OFF_NCL); float* zer = (float*)(lds + OFF_ZER);
  float m_reg = DIFF ? -1e30f : 0.f, l_reg = 0; bool first = true; f32x16 o[NDV]; bf16x8 qr[NQK];
#pragma unroll
  for (int d = 0; d < NDV; ++d) o[d] = f32x16{};
  unsigned koff[2]; bool kact[2]; unsigned voff[NVP];
#pragma unroll
  for (int i = 0; i < 2; ++i) { const int piece = wid + 8 * i, row = 4 * piece + (lane >> 4), pos = lane & 15, chunk = pos ^ (row & 15); kact[i] = chunk < KCH; koff[i] = (unsigned)(row * LDK + ((!DIFF && chunk >= 8) ? chunk * 8 : da.khoff + chunk * 8)); }
#pragma unroll
  for (int i = 0; i < NVP; ++i) { const int q = (wid + 8 * i) * 64 + lane, st = q >> 5, kkhi = st / NDV, cblk = st % NDV, kk = kkhi * 8 + ((q & 31) >> 2), cc = q & 3;
    const int key = (kk & ~0xC) | ((kk & 4) << 1) | ((kk & 8) >> 1); voff[i] = (unsigned)(key * LDV + cblk * 32 + cc * 8); }
  const int vb0 = (int)(uintptr_t)V_lds + v_rd_base(lane);
  const int kcol0 = mp * 128;
  LAS unsigned char* Kl = ldsl + OFF_K + wid * 1024; LAS unsigned char* Vl = ldsl + OFF_V + wid * 1024;
#define DMA_K(buf, k0) do { _Pragma("unroll") for (int i_ = 0; i_ < 2; ++i_) if (kact[i_]) \
    __builtin_amdgcn_global_load_lds((const unsigned*)(Kh + (size_t)(k0) * LDK + koff[i_]), (LAS unsigned*)(Kl + (buf) * SHM_K + i_ * 8192), 16, 0, 0); } while (0)
#define DMA_V(bufoff, k0) do { _Pragma("unroll") for (int i_ = 0; i_ < NVP; ++i_) \
    __builtin_amdgcn_global_load_lds((const unsigned*)(Vh + (size_t)(k0) * LDV + voff[i_]), (LAS unsigned*)(Vl + (bufoff) + i_ * 8192), 16, 0, 0); } while (0)
#define TILE_BAR() do { asm volatile("s_waitcnt vmcnt(0) lgkmcnt(0)" ::: "memory"); __builtin_amdgcn_s_barrier(); asm volatile("" ::: "memory"); } while (0)
  if constexpr (DIFF) {
    const unsigned char* Qw8 = (const unsigned char*)Qb + (long)(wrow + r32) * 1024 + mp * 64 + hi * 8;
#pragma unroll
    for (int d0 = 0; d0 < NQK; ++d0) { const u32x2 w8 = *reinterpret_cast<const u32x2*>(Qw8 + d0 * 16);
      const f32x2 a0 = __builtin_amdgcn_cvt_pk_f32_fp8((int)w8.x, false), a1 = __builtin_amdgcn_cvt_pk_f32_fp8((int)w8.x, true), b0 = __builtin_amdgcn_cvt_pk_f32_fp8((int)w8.y, false), b1 = __builtin_amdgcn_cvt_pk_f32_fp8((int)w8.y, true);
      constexpr float iq = 1.0f / DQ8_SCALE;
      u32x4 w; w[0] = cvtpk(a0[0] * iq, a0[1] * iq); w[1] = cvtpk(a1[0] * iq, a1[1] * iq); w[2] = cvtpk(b0[0] * iq, b0[1] * iq); w[3] = cvtpk(b1[0] * iq, b1[1] * iq);
      qr[d0] = *reinterpret_cast<bf16x8*>(&w); }
  } else {
    const bf16_t* Qw = Qb + (long)(wrow + r32) * LDQ + mp * 64 + hi * 8;
#pragma unroll
    for (int d0 = 0; d0 < NQK; ++d0) qr[d0] = *reinterpret_cast<const bf16x8*>(Qw + d0 * 16);
  }
  if constexpr (DIFF) {
    __syncthreads();
    DMA_K(0, ((q0 >> 6) + 0) * KVBLK); DMA_V(0, ((q0 >> 6) + 0) * KVBLK); DMA_K(1, ((q0 >> 6) + 1) * KVBLK); DMA_V((int)SHM_V, ((q0 >> 6) + 1) * KVBLK);
  }
  float pq = 0.f;
  float* ext = (float*)(lds + OFF_EXT);
  float wqmin = 0.f, wqmax = 0.f;
  if constexpr (DIFF) {
    const float* rawp = (const float*)(lds + OFF_RAW); const float* r32t = (const float*)(lds + OFF_R32);
    const float bp = rawp[q0];
    for (int i = tid; i < SEQ; i += NW * 64) { const float c = da.sl * (rawp[i] - bp); posl[i] = c; ncl[i] = -c; }
    if (tid < 64) zer[tid] = 0.f;
    pq = da.sl * (rawp[q0 + wrow + r32] - bp);
    if (wid == 0) { const int t = lane & 31; const float v = (lane < 32) ? fminf(r32t[2 * t], r32t[2 * t + 1]) : fmaxf(r32t[64 + 2 * t], r32t[64 + 2 * t + 1]); ext[lane] = da.sl * (v - bp); }
    { const int g = (q0 + wrow) >> 5; wqmin = da.sl * (r32t[g] - bp); wqmax = da.sl * (r32t[64 + g] - bp); }
    { float qs = 0.f;
#pragma unroll
      for (int d0 = 0; d0 < NQK; ++d0)
#pragma unroll
        for (int e = 0; e < 8; ++e) { const float f = bf2f((bf16_t)qr[d0][e]); qs += f * f; }
      qs = sum_x32(qs); qs = wmax64(qs); if (lane == 0) ext[64 + wid] = qs; }
  }
#define RESC(a) do { if (__any((a) < 1.f)) { if (hi == 0) al_l[r32] = (a); asm volatile("s_waitcnt lgkmcnt(0)" ::: "memory"); \
    _Pragma("unroll") for (int d = 0; d < NDV; ++d) _Pragma("unroll") for (int r = 0; r < 16; ++r) o[d][r] *= al_l[crow(r, hi)]; } } while (0)
  f32x16 negm;
#pragma unroll
  for (int r = 0; r < 16; ++r) negm[r] = 0.f;
#define QK(P0, P1, RADJ, MODE, KBUF, k0) do { \
    if constexpr (DIFF) { const int t_ = (k0) >> 6; const float tmn_ = ext[t_], tmx_ = ext[32 + t_]; \
      const int mode_ = __builtin_amdgcn_readfirstlane((tmx_ <= wqmin) ? 1 : ((tmn_ >= wqmax) ? 2 : 0)); \
      const float* cp_ = mode_ == 0 ? zer : (mode_ == 1 ? posl + (k0) : ncl + (k0)); \
      load_c(P0, P1, cp_, hi); RADJ = mode_ == 1 ? -pq : (mode_ == 2 ? pq : 0.f); MODE = mode_; \
      qkt<NQK>(P0, P1, KBUF, qr, r32, hi, kcol0); \
    } else { P0 = negm; P1 = negm; qkt<NQK>(P0, P1, KBUF, qr, r32, hi, kcol0); } } while (0)
#define PSM(P0, P1, MN, AL, RADJ, MODE, K0, SK) do { if constexpr (DIFF) { if (MODE == 0) alibi(P0, P1, posl, (K0), hi, pq); SK = partialSM_adj(P0, P1, m_reg, MN, AL, RADJ, SKIP_TH); } else { partialSM_rel(P0, P1, m_reg, negm, AL, first); first = false; } } while (0)
  f32x16 pA0, pA1, pB0, pB1; float mnA = 0.f, mnB = 0.f, alA, alB, raA = 0.f, raB = 0.f; int mdA = 0, mdB = 0; bf16x8 pa0, pa1, pa2, pa3; constexpr int NTALL = SEQ / KVBLK;
  int td0 = 0, lo = 0, hiT = NTALL; float Bq = 0.f, qpmin = 0.f, qpmax = 0.f;
  if constexpr (DIFF) {
    __syncthreads();
    td0 = q0 >> 6; qpmin = fminf(ext[td0], ext[td0 + 1]); qpmax = fmaxf(ext[32 + td0], ext[32 + td0 + 1]);
    float q2 = ext[64];
#pragma unroll
    for (int w = 1; w < 8; ++w) q2 = fmaxf(q2, ext[64 + w]);
    Bq = sqrtf(q2 * da.kmax2); td0 = q0 >> 6;
  }
  for (int rg = 0; rg < (DIFF ? 2 : 1); ++rg) {
  int t0 = 0, NT = NTALL;
  if constexpr (DIFF) {
    if (rg == 0) { t0 = td0; NT = 2; }
    else {
      const float mm = wmin64(m_reg); if (lane == 0) ext[72 + wid] = mm; __syncthreads();
      float mmin = ext[72];
#pragma unroll
      for (int w = 1; w < 8; ++w) mmin = fminf(mmin, ext[72 + w]);
      const float thr = Bq - mmin + SKIP_TH;
      { const int t = lane & 31; const float dmin = fmaxf(0.f, fmaxf(ext[t] - qpmax, qpmin - ext[32 + t]));
        const unsigned keep = (unsigned)__ballot(dmin <= thr) | (3u << td0);
        lo = __builtin_ctz(keep); hiT = 32 - __builtin_clz(keep); }
      lo = __builtin_amdgcn_readfirstlane(lo & ~1); hiT = __builtin_amdgcn_readfirstlane((hiT + 1) & ~1);
      t0 = lo; NT = hiT - lo - 2;
    }
    if (NT <= 0) continue;
  }
#define TK(j) ((DIFF && rg == 1 && t0 + (j) >= td0 ? t0 + (j) + 2 : t0 + (j)) * KVBLK)
  int vprev = 0, vcur = (int)SHM_V, vnext = 2 * (int)SHM_V;
  if (!DIFF || rg == 1) {
    __syncthreads();
    DMA_K(0, TK(0)); DMA_V(0, TK(0)); DMA_K(1, TK(1)); DMA_V((int)SHM_V, TK(1)); }
  TILE_BAR();
  bool skA = false, skB = false;
  QK(pA0, pA1, raA, mdA, K_lds, TK(0)); PSM(pA0, pA1, mnA, alA, raA, mdA, TK(0), skA);
  TILE_BAR();
#define ROT() do { const int t_ = vprev; vprev = vcur; vcur = vnext; vnext = t_; } while (0)
  for (int j = 1; j + 1 < NT; j += 2) {
    DMA_K(0, TK(j + 1)); DMA_V(vnext, TK(j + 1));
    SBAR(); QK(pB0, pB1, raB, mdB, K_lds + SHM_K, TK(j));
    if (!skA) { finishSM(pA0, pA1, alA, l_reg, pa0, pa1, pa2, pa3); SBAR();
                pv_all<NDV>(o, vb0 + vprev, pa0, pa1, pa2, pa3); }
    PSM(pB0, pB1, mnB, alB, raB, mdB, TK(j), skB);
    RESC(alB); TILE_BAR(); ROT();
    if (j + 2 < NT) { DMA_K(1, TK(j + 2)); DMA_V(vnext, TK(j + 2)); }
    SBAR(); QK(pA0, pA1, raA, mdA, K_lds, TK(j + 1));
    if (!skB) { finishSM(pB0, pB1, alB, l_reg, pa0, pa1, pa2, pa3); SBAR();
                pv_all<NDV>(o, vb0 + vprev, pa0, pa1, pa2, pa3); }
    PSM(pA0, pA1, mnA, alA, raA, mdA, TK(j + 1), skA);
    RESC(alA); TILE_BAR(); ROT();
  }
  SBAR(); QK(pB0, pB1, raB, mdB, K_lds + SHM_K, TK(NT - 1));
  if (!skA) { finishSM(pA0, pA1, alA, l_reg, pa0, pa1, pa2, pa3); SBAR();
              pv_all<NDV>(o, vb0 + vprev, pa0, pa1, pa2, pa3); }
  PSM(pB0, pB1, mnB, alB, raB, mdB, TK(NT - 1), skB);
  RESC(alB);
  if (!skB) { finishSM(pB0, pB1, alB, l_reg, pa0, pa1, pa2, pa3); SBAR();
              pv_all<NDV>(o, vb0 + vcur, pa0, pa1, pa2, pa3); }
#undef TK
#undef ROT
  }
  if (hi == 0) li_l[r32] = l_reg; asm volatile("s_waitcnt lgkmcnt(0)" ::: "memory");
  float rli[16];
#pragma unroll
  for (int r = 0; r < 16; ++r) rli[r] = __builtin_amdgcn_rcpf(li_l[crow(r, hi)]);
  if constexpr (!DIFF) {
    __syncthreads();
    LAS float* blk = (LAS float*)(ldsl + wid * 9216);
#pragma unroll
    for (int r = 0; r < 16; ++r) { const int orow = crow(r, hi);
#pragma unroll
      for (int d0 = 0; d0 < NDV; ++d0) blk[orow * 72 + d0 * 36 + r32] = o[d0][r] * (rli[r] * O8_SCALE); }
    asm volatile("s_waitcnt lgkmcnt(0)" ::: "memory");
    const int row = lane >> 1, half = lane & 1; const LAS float* rp = blk + row * 72 + half * 36;
    unsigned char* Op = Ob + (long)(wrow + row) * LDO + half * 32;
#pragma unroll
    for (int j4 = 0; j4 < 2; ++j4) { u32x4 w;
#pragma unroll
      for (int k = 0; k < 4; ++k) { const f32x4 y = *(const LAS f32x4*)(rp + 4 * (4 * j4 + k)); w[k] = pack4_fp8(y[0], y[1], y[2], y[3]); }
      *(u32x4*)(Op + 16 * j4) = w; }
  } else {
    __syncthreads();
    LAS float* blk = (LAS float*)(ldsl + (wid & 3) * 17408);
#define BIDX(orow, d0) ((orow) * 136 + ((d0) >> 1) * 68 + ((d0) & 1) * 32 + r32)
    if (mp == 1) {
#pragma unroll
      for (int r = 0; r < 16; ++r) { const int orow = crow(r, hi);
#pragma unroll
        for (int d0 = 0; d0 < 4; ++d0) blk[BIDX(orow, d0)] = o[d0][r] * rli[r]; }
    }
    __syncthreads();
    if (mp == 0) {
#pragma unroll
      for (int r = 0; r < 16; ++r) { const int orow = crow(r, hi);
#pragma unroll
        for (int d0 = 0; d0 < 4; ++d0) { LAS float* p = blk + BIDX(orow, d0); *p = o[d0][r] * rli[r] - da.lam * *p; } }
      asm volatile("s_waitcnt lgkmcnt(0)" ::: "memory");
      const int row = lane >> 1, half = lane & 1; const LAS float* rp = blk + row * 136 + half * 68;
      f32x4 v[16]; float s = 0.f;
#pragma unroll
      for (int j = 0; j < 16; ++j) { v[j] = *(const LAS f32x4*)(rp + 4 * j); s += (v[j][0] * v[j][0] + v[j][1] * v[j][1]) + (v[j][2] * v[j][2] + v[j][3] * v[j][3]); }
      s += swz_xor<1>(s);
      const float sc = da.oscale * O8_SCALE * __builtin_amdgcn_rsqf(s * (1.0f / 128.0f) + RMS_EPS);
      unsigned char* Op = Ob + (long)(wrow + row) * LDO + half * 64;
#pragma unroll
      for (int j4 = 0; j4 < 4; ++j4) { u32x4 w;
#pragma unroll
        for (int k = 0; k < 4; ++k) { const int j = 4 * j4 + k; const f32x4 g = *(const f32x4*)(da.ng + half * 64 + 4 * j); const f32x4 y = v[j] * sc * g; w[k] = pack4_fp8(y[0], y[1], y[2], y[3]); }
        *(u32x4*)(Op + 16 * j4) = w; }
    }
#undef BIDX
  }
#undef DMA_K
#undef DMA_V
#undef TILE_BAR
#undef RESC
#undef QK
#undef PSM
}
#undef KSWZ
#undef SBAR
}

constexpr size_t MiB = 1u << 20;
constexpr size_t WS_CTL = 0, CTL_ZERO_BYTES = 1 * MiB;
constexpr size_t WS_MOD = 1 * MiB;
constexpr size_t WS_RSQ = 3 * MiB;
constexpr size_t WS_COS = 6 * MiB;
constexpr size_t WS_SIN = 8 * MiB;
constexpr size_t WS_SEL = 10 * MiB;
constexpr size_t WS_GATE = 10 * MiB + 256 * 1024;
constexpr size_t WS_RMAP = 11 * MiB;
constexpr size_t WS_WMIX = 12 * MiB;
constexpr size_t W_IN = WS_WMIX, W_QUP = W_IN + (size_t)NZ * 1024 * 2, W_KVUP = W_QUP + 768 * 384 * 2, W_BRM = W_KVUP + 1024 * 256 * 2, W_BRD = W_BRM + 1024 * 512 * 2, W_OUT = W_BRD + 1024 * 1024 * 2;
constexpr size_t WS_WFF = 30 * MiB;
constexpr size_t W2_ESTRIDE8 = (size_t)1024 * 2816;
constexpr size_t W13_ESTRIDE8 = (size_t)5632 * 1024;
constexpr size_t W13_ESTRIDE = (size_t)5632 * 1024 * 2, W2_ESTRIDE = (size_t)1024 * 2816 * 2, W2_BASE = WS_WFF + 8 * W13_ESTRIDE;
constexpr size_t WS_ACT = 162 * MiB;
constexpr size_t WS_H = WS_ACT;
constexpr size_t WS_LAT = WS_H + 64 * MiB;
constexpr size_t WS_ZB = WS_LAT + 48 * MiB;
constexpr size_t WS_QM = WS_ZB + 320 * MiB;
constexpr size_t WS_KM = WS_QM + 48 * MiB;
constexpr size_t WS_VM = WS_KM + 48 * MiB;
constexpr size_t WS_OM = WS_VM + 32 * MiB;
constexpr size_t WS_END = WS_OM + 32 * MiB;
constexpr size_t WS_PRE = WS_QM;
constexpr size_t WS_PART = WS_QM;
constexpr size_t WS_T1 = WS_ZB + 64 * MiB;
constexpr size_t WS_MB = WS_ZB + 128 * MiB;
constexpr size_t WS_DO8 = WS_ZB + 224 * MiB;
constexpr size_t WS_U = WS_LAT;
constexpr size_t WS_XB = WS_LAT;
constexpr size_t WS_Y = WS_LAT;
constexpr size_t WS_UM = WS_LAT + 132 * MiB;
static_assert(WS_UM + (size_t)67584 * 2816 * 2 <= WS_END + 64 * MiB, "ws map");
constexpr size_t WS_WIN8 = WS_END + 96 * MiB;
constexpr size_t WS_H8 = WS_OM;
constexpr size_t WS_XRES = WS_END + 16 * MiB;
constexpr size_t WS_NEED = WS_END + 104 * MiB;
constexpr int CW_BAR = 4096;
constexpr int CW_CNT = 8192;
constexpr int CW_CUR = 8192 + 256;
constexpr int CW_WGH = 32768;
constexpr int CW_KMAX = 16384;

constexpr int RING_BYTES = 131072, LDSCTL_OFF = RING_BYTES, MISC_OFF = LDSCTL_OFF + 320, LDS_BYTES = 147456;
constexpr int NWAVES = 8;

#define XB_TMO      128
#define XB_XCNT(j)  (256  + 64 * (j))
#define XB_XSUB(j)  (1280 + 64 * (j))
#define XB_XGEN(j)  (2304 + 64 * (j))
#define XB_TOP      3328
#define XB_TOPGEN   3392
#define XCD_BAR_WORDS 3456
#define XB_SPIN_CAP (1u << 18)
__device__ __forceinline__ unsigned xb_ld(unsigned* p)              { return __hip_atomic_load(p, __ATOMIC_RELAXED, __HIP_MEMORY_SCOPE_AGENT); }
__device__ __forceinline__ unsigned xb_add(unsigned* p, unsigned v) { return __hip_atomic_fetch_add(p, v, __ATOMIC_RELAXED, __HIP_MEMORY_SCOPE_AGENT); }
__device__ __forceinline__ unsigned xb_xcc_id() { return (unsigned)__builtin_amdgcn_s_getreg((3 << 11) | 20) & 0xFu; }
#define XB_SPIN(cond, bar) do { unsigned _sp = 0; while (cond) { __builtin_amdgcn_s_sleep(1); \
    if ((++_sp & 255u) == 0u) { if (xb_ld(&(bar)[XB_TMO])) break; if (_sp > XB_SPIN_CAP) { atomicAdd(&(bar)[XB_TMO], 1u); break; } } } } while (0)
struct XcdBarrier { unsigned* bar; unsigned x; volatile LAS unsigned* st; };
__device__ __forceinline__ XcdBarrier xcd_barrier_post(unsigned* bar, volatile LAS unsigned* st, bool leader) {
    XcdBarrier b; b.bar = bar; b.x = xb_xcc_id(); b.st = st;
    if (leader) (void)xb_add(&bar[XB_XCNT(b.x)], 1u);
    return b;
}
__device__ __forceinline__ void xcd_barrier_complete(unsigned* bar, unsigned x, unsigned& nloc, unsigned& nx) {
    const unsigned G = gridDim.x * gridDim.y * gridDim.z;
    unsigned sum, cnt, mine, sp = 0u;
    for (;;) {
        sum = 0u; cnt = 0u; mine = 0u;
#pragma unroll
        for (unsigned j = 0; j < 16; ++j) { const unsigned c = xb_ld(&bar[XB_XCNT(j)]); sum += c; cnt += (c > 0u) ? 1u : 0u; mine = (j == x) ? c : mine; }
        if (sum == G) break;
        __builtin_amdgcn_s_sleep(1);
        if ((++sp & 255u) == 0u) { if (xb_ld(&bar[XB_TMO])) break; if (sp > XB_SPIN_CAP) { atomicAdd(&bar[XB_TMO], 1u); break; } }
    }
    nloc = mine > 0u ? mine : 1u; nx = cnt > 0u ? cnt : 1u;
}
__device__ __forceinline__ void xcd_barrier(const XcdBarrier& b, bool leader) {
    asm volatile("s_waitcnt vmcnt(0)" ::: "memory");
    __syncthreads();
    if (leader) {
        unsigned* bar = b.bar;
        __builtin_amdgcn_s_waitcnt(0);
        unsigned nloc = b.st[0], nx = b.st[1];
        if (nloc == 0u) { xcd_barrier_complete(bar, b.x, nloc, nx); b.st[0] = nloc; b.st[1] = nx; }
        const unsigned old = xb_add(&bar[XB_XSUB(b.x)], 1u);
        const unsigned gen = old / nloc;
        if (old + 1u == (gen + 1u) * nloc) {
            __builtin_amdgcn_fence(__ATOMIC_RELEASE, "agent");
            asm volatile("s_waitcnt vmcnt(0)" ::: "memory");
            const unsigned og = xb_add(&bar[XB_TOP], 1u);
            const unsigned tg = og / nx;
            if (og + 1u == (tg + 1u) * nx) xb_add(&bar[XB_TOPGEN], 1u);
            else XB_SPIN(xb_ld(&bar[XB_TOPGEN]) == tg, bar);
            __builtin_amdgcn_fence(__ATOMIC_ACQUIRE, "agent");
            xb_add(&bar[XB_XGEN(b.x)], 1u);
            asm volatile("s_waitcnt vmcnt(0)" ::: "memory");
        } else {
            XB_SPIN(xb_ld(&bar[XB_XGEN(b.x)]) == gen, bar);
            __builtin_amdgcn_fence(__ATOMIC_ACQUIRE, "agent");
            asm volatile("s_waitcnt vmcnt(0)" ::: "memory");
        }
    }
    __syncthreads();
}

__device__ __forceinline__ float wave_sum(float v) {
    v += swz_xor<1>(v); v += swz_xor<2>(v); v += swz_xor<4>(v); v += swz_xor<8>(v); v += swz_xor<16>(v);
    return sum_x32(v);
}
__device__ __forceinline__ unsigned f2bf(float f) { unsigned u = __builtin_bit_cast(unsigned, f); return (u + 0x7fffu + ((u >> 16) & 1u)) >> 16; }
__device__ __forceinline__ unsigned pk2(float lo, float hi) { return f2bf(lo) | (f2bf(hi) << 16); }

template <class MapF>
__device__ __forceinline__ void transpose_item(const float* W, int N, bf16_t* WT, int ldk, const float* gain, LAS float* scr, int kb, int nb, int lane, MapF map) {
    const int k0 = 64 * kb, n0 = 32 * nb;
    float tv[32];
#pragma unroll
    for (int i = 0; i < 32; ++i) { const int kk = 2 * i + (lane >> 5); tv[i] = W[(size_t)(k0 + kk) * N + n0 + (lane & 31)]; }
#pragma unroll
    for (int i = 0; i < 32; ++i) { const int kk = 2 * i + (lane >> 5); float v = tv[i]; if (gain) v *= gain[k0 + kk]; scr[kk * 33 + (lane & 31)] = v; }
    asm volatile("s_waitcnt lgkmcnt(0)" ::: "memory");
    const int c = lane & 7;
#pragma unroll
    for (int j = 0; j < 4; ++j) { const int n = (lane >> 3) + 8 * j; const LAS float* s = scr + (8 * c) * 33 + n;
        u32x4 o; o.x = pk2(s[0 * 33], s[1 * 33]); o.y = pk2(s[2 * 33], s[3 * 33]); o.z = pk2(s[4 * 33], s[5 * 33]); o.w = pk2(s[6 * 33], s[7 * 33]);
        const int dr = map(n0 + n);
        *(GAS u32x4*)(WT + (size_t)dr * ldk + k0 + 8 * c) = o; }
    asm volatile("s_waitcnt lgkmcnt(0)" ::: "memory");
}
template <class MapF>
__device__ __forceinline__ void transpose_item_fp8(const float* W, int N, unsigned char* WT8, int ldkb, float scale, LAS float* scr, int kb, int nb, int lane, MapF map, const float* gain = nullptr, bool zero = false) {
    const int k0 = 64 * kb, n0 = 32 * nb;
    float tv[32];
#pragma unroll
    for (int i = 0; i < 32; ++i) { const int kk = 2 * i + (lane >> 5); tv[i] = zero ? 0.f : W[(size_t)(k0 + kk) * N + n0 + (lane & 31)]; }
#pragma unroll
    for (int i = 0; i < 32; ++i) { const int kk = 2 * i + (lane >> 5); float v = tv[i] * scale; if (gain && !zero) v *= gain[k0 + kk]; scr[kk * 33 + (lane & 31)] = v; }
    asm volatile("s_waitcnt lgkmcnt(0)" ::: "memory");
    const int c = lane & 7;
#pragma unroll
    for (int j = 0; j < 4; ++j) { const int n = (lane >> 3) + 8 * j; const LAS float* sp = scr + (8 * c) * 33 + n;
        u32x2 o; o.x = pack4_fp8(sp[0 * 33], sp[1 * 33], sp[2 * 33], sp[3 * 33]); o.y = pack4_fp8(sp[4 * 33], sp[5 * 33], sp[6 * 33], sp[7 * 33]);
        const int dr = map(n0 + n);
        *(GAS u32x2*)(WT8 + (size_t)dr * ldkb + k0 + 8 * c) = o; }
    asm volatile("s_waitcnt lgkmcnt(0)" ::: "memory");
}
__host__ __device__ __forceinline__ int rope_virt(int rho) { const int n = rho >> 4, fq = (rho & 15) >> 2, i = rho & 3; return 8 * fq + 4 * n + i; }
struct MapIn  { __device__ __forceinline__ int operator()(int n) const { if (n < 384) return n; if (n < 640) return n + 128; if (n < 672) return 384 + rope_virt(n - 640); return n + 96; } };
struct MapIn8 { __device__ __forceinline__ int operator()(int n) const { return n + 96 - 2816; } };
struct MapQup { __device__ __forceinline__ int operator()(int n) const { const int h = n / 96, w = n - h * 96; return w < 64 ? n : h * 96 + 64 + rope_virt(w - 64); } };
struct MapId  { __device__ __forceinline__ int operator()(int n) const { return n; } };
struct MapW13 { int half; __device__ __forceinline__ int operator()(int n) const { return 256 * (n >> 7) + 128 * half + (n & 127); } };

struct Args {
    const float* x; const float* c; const int* pos; const float* w_ada; const float* b_ada; const float* w_in; const float* q_norm_g; const float* w_q_up; const float* kv_norm_g; const float* w_kv_up;
    const float* lq1; const float* lk1; const float* lq2; const float* lk2; const float* diff_norm_g; const float* w_br_mla; const float* w_br_diff; const float* w_out;
    const float* ln1_g; const float* ln1_b; const float* ln2_g; const float* ln2_b; const float* ffn_w1; const float* ffn_w3; const float* ffn_w2; const float* router_w; const float* router_b;
    const float* moe_w1; const float* moe_w3; const float* moe_w2;
    float* out; unsigned char* ws; int ph_lo, ph_hi; float lam_init[4];
};

typedef const __attribute__((address_space(4))) Args* KArgP;
__device__ __forceinline__ KArgP kargs() { KArgP p = (KArgP)__builtin_amdgcn_kernarg_segment_ptr(); asm volatile("" : "+s"(p)); return p; }
struct Ctx { LAS unsigned char* lds; int tid, lane, wave, vcu, G; unsigned char* ws; };

__device__ __forceinline__ void tr8_load(float (&tv)[32], const float* W, int N, int kb, int nb, int lane) {
    const int k0 = 64 * kb, n0 = 32 * nb;
#pragma unroll
    for (int i = 0; i < 32; ++i) { const int kk = 2 * i + (lane >> 5); tv[i] = W[(size_t)(k0 + kk) * N + n0 + (lane & 31)]; }
}
template <class MapF>
__device__ __forceinline__ void tr8_finish(const float (&tv)[32], unsigned char* WT8, int ldkb, float scale, LAS float* scr, int kb, int nb, int lane, MapF map) {
    const int k0 = 64 * kb, n0 = 32 * nb;
#pragma unroll
    for (int i = 0; i < 32; ++i) { const int kk = 2 * i + (lane >> 5); scr[kk * 33 + (lane & 31)] = tv[i] * scale; }
    asm volatile("s_waitcnt lgkmcnt(0)" ::: "memory");
    const int c = lane & 7;
#pragma unroll
    for (int j = 0; j < 4; ++j) { const int n = (lane >> 3) + 8 * j; const LAS float* sp = scr + (8 * c) * 33 + n;
        u32x2 o; o.x = pack4_fp8(sp[0 * 33], sp[1 * 33], sp[2 * 33], sp[3 * 33]); o.y = pack4_fp8(sp[4 * 33], sp[5 * 33], sp[6 * 33], sp[7 * 33]);
        const int dr = map(n0 + n);
        *(GAS u32x2*)(WT8 + (size_t)dr * ldkb + k0 + 8 * c) = o; }
    asm volatile("s_waitcnt lgkmcnt(0)" ::: "memory");
}
__device__ __forceinline__ void cvt_mixer_weights(const Ctx& C, int l) {
    KArgP a = kargs();
    LAS float* scr = (LAS float*)(C.lds + C.wave * 8448);
    const int gw = C.vcu * NWAVES + C.wave, NGW = C.G * NWAVES;
    constexpr int I_IN = 16 * 181, I_QUP = 8 * 24, I_KVUP = 4 * 32, I_BRM = 8 * 32, I_BRD = 16 * 32, I_OUT = 16 * 32;
    constexpr int NIT = I_IN + I_QUP + I_KVUP + I_BRM + I_BRD + I_OUT;
    unsigned char* ws = C.ws;
    for (int it = gw; it < NIT; it += NGW) {
        int r = it;
        if (r < I_IN) { transpose_item_fp8(a->w_in + (size_t)l * 1024 * 5792, 5792, ws + WS_WIN8, 1024, W8_SCALE, scr, r / 181, r % 181, C.lane, MapIn{}); continue; } r -= I_IN;
        if (r < I_QUP) { transpose_item_fp8(a->w_q_up + (size_t)l * 384 * 768, 768, ws + W_QUP, 512, W8_SCALE, scr, r / 24, r % 24, C.lane, MapQup{}, a->q_norm_g + l * 384, (r / 24) >= 6); continue; } r -= I_QUP;
        if (r < I_KVUP) { transpose_item_fp8(a->w_kv_up + (size_t)l * 256 * 1024, 1024, ws + W_KVUP, 256, W8_SCALE, scr, r / 32, r % 32, C.lane, MapId{}, a->kv_norm_g + l * 256); continue; } r -= I_KVUP;
        if (r < I_BRM) { transpose_item_fp8(a->w_br_mla + (size_t)l * 512 * 1024, 1024, ws + W_BRM, 512, W8_SCALE_BR, scr, r / 32, r % 32, C.lane, MapId{}); continue; } r -= I_BRM;
        if (r < I_BRD) { transpose_item_fp8(a->w_br_diff + (size_t)l * 1024 * 1024, 1024, ws + W_BRD, 1024, W8_SCALE_BR, scr, r / 32, r % 32, C.lane, MapId{}); continue; } r -= I_BRD;
        transpose_item_fp8(a->w_out + (size_t)l * 1024 * 1024, 1024, ws + W_OUT, 1024, W8_SCALE_BR, scr, r / 32, r % 32, C.lane, MapId{});
    }
}
__device__ __forceinline__ void cvt_ffn_weights(const Ctx& C, int l) {
    KArgP a = kargs();
    LAS float* scr = (LAS float*)(C.lds + C.wave * 8448);
    const int gw = C.vcu * NWAVES + C.wave, NGW = C.G * NWAVES;
    constexpr int I_W1 = 16 * 88, I_W2 = 44 * 32, I_E = 2 * I_W1 + I_W2;
    unsigned char* ws = C.ws;
    const bool moe = (l & 1) != 0; const int li = l >> 1;
    const int nE = moe ? NEXP : 1;
    const float* w1 = moe ? a->moe_w1 + (size_t)li * NEXP * 1024 * FF : a->ffn_w1 + (size_t)li * 1024 * FF;
    const float* w3 = moe ? a->moe_w3 + (size_t)li * NEXP * 1024 * FF : a->ffn_w3 + (size_t)li * 1024 * FF;
    const float* w2 = moe ? a->moe_w2 + (size_t)li * NEXP * 1024 * FF : a->ffn_w2 + (size_t)li * 1024 * FF;
    if (moe) {
#define MOE_ITEM(it_, src_, N_, kb_, nb_, kind_, e_) const int e_ = (it_) / I_E; int r_##it_ = (it_) - e_ * I_E; const int kind_ = (r_##it_ >= 2 * I_W1) ? 2 : (r_##it_ >= I_W1 ? 1 : 0); \
        r_##it_ -= kind_ * I_W1; const float* src_ = (kind_ == 0 ? w1 : (kind_ == 1 ? w3 : w2)) + (size_t)e_ * 1024 * FF; const int N_ = kind_ == 2 ? 1024 : FF; \
        const int kb_ = kind_ == 2 ? r_##it_ / 32 : r_##it_ / 88, nb_ = kind_ == 2 ? r_##it_ % 32 : r_##it_ % 88;
        int it = gw; float tv[32];
        if (it < nE * I_E) { MOE_ITEM(it, src0, N0, kb0, nb0, kind0, e0) tr8_load(tv, src0, N0, kb0, nb0, C.lane); }
        while (it < nE * I_E) {
            const int nit = it + NGW; float tn[32];
            if (nit < nE * I_E) { MOE_ITEM(nit, src1, N1, kb1, nb1, kind1, e1) tr8_load(tn, src1, N1, kb1, nb1, C.lane); }
            { MOE_ITEM(it, src0, N0, kb0, nb0, kind0, e0) (void)src0; (void)N0;
              if (kind0 == 2) tr8_finish(tv, ws + W2_BASE + (size_t)e0 * W2_ESTRIDE8, FF, W8_SCALE_W2, scr, kb0, nb0, C.lane, MapId{});
              else tr8_finish(tv, ws + WS_WFF + (size_t)e0 * W13_ESTRIDE8, 1024, W8_SCALE, scr, kb0, nb0, C.lane, MapW13{kind0}); }
#pragma unroll
            for (int i = 0; i < 32; ++i) tv[i] = tn[i];
            it = nit; }
#undef MOE_ITEM
        return;
    }
    for (int it = gw; it < nE * I_E; it += NGW) {
        const int e = it / I_E; int r = it - e * I_E;
        bf16_t* d13 = (bf16_t*)(ws + WS_WFF + (size_t)e * W13_ESTRIDE);
        const size_t eo = (size_t)e * 1024 * FF;
        if (moe) {
            unsigned char* d8 = ws + WS_WFF + (size_t)e * W13_ESTRIDE8;
            if (r < I_W1) { transpose_item_fp8(w1 + eo, FF, d8, 1024, W8_SCALE, scr, r / 88, r % 88, C.lane, MapW13{0}); continue; } r -= I_W1;
            if (r < I_W1) { transpose_item_fp8(w3 + eo, FF, d8, 1024, W8_SCALE, scr, r / 88, r % 88, C.lane, MapW13{1}); continue; } r -= I_W1;
        } else {
        if (r < I_W1) { transpose_item(w1 + eo, FF, d13, 1024, nullptr, scr, r / 88, r % 88, C.lane, MapW13{0}); continue; } r -= I_W1;
        if (r < I_W1) { transpose_item(w3 + eo, FF, d13, 1024, nullptr, scr, r / 88, r % 88, C.lane, MapW13{1}); continue; } r -= I_W1;
        }
        transpose_item_fp8(w2 + eo, 1024, ws + W2_BASE + (size_t)e * W2_ESTRIDE8, FF, W8_SCALE_W2, scr, r / 32, r % 32, C.lane, MapId{});
    }
}

struct FIn {
    static constexpr bool HAS_PAIR = true;
    bf16_t* LAT; bf16_t* ZB; bf16_t* KM; float* RSQ; const float* COS; const float* SIN; int cboff; float insc; unsigned* KMX;
    __device__ __forceinline__ void pair(int row, int cb, int fq, f32x4 a0, f32x4 a1, f32x4 b0, f32x4 b1) const {
        cb += cboff; if (cb < 1792 || cb >= 2816) return;
        float ss = ((a0[0] * a0[0] + a0[1] * a0[1]) + (a0[2] * a0[2] + a0[3] * a0[3])) + ((a1[0] * a1[0] + a1[1] * a1[1]) + (a1[2] * a1[2] + a1[3] * a1[3]))
                 + ((b0[0] * b0[0] + b0[1] * b0[1]) + (b0[2] * b0[2] + b0[3] * b0[3])) + ((b1[0] * b1[0] + b1[1] * b1[1]) + (b1[2] * b1[2] + b1[3] * b1[3]));
        ss += swz_xor<16>(ss); ss = sum_x32(ss);
        ss = fmaxf(ss, swz_xor<1>(ss)); ss = fmaxf(ss, swz_xor<2>(ss)); ss = fmaxf(ss, swz_xor<4>(ss)); ss = fmaxf(ss, swz_xor<8>(ss));
        if (fq == 0 && (row & 15) == 0) atomicMax(KMX + (row >> 11) * 16 + ((cb - 1792) >> 6), __float_as_uint(ss * (insc * insc)));
    }
    __device__ __forceinline__ float rowscale(int) const { return 1.f; }
    __device__ __forceinline__ void operator()(int row, float rs, int cb, int fq, f32x4 v0, f32x4 v1) const {
        cb += cboff; v0 = v0 * insc; v1 = v1 * insc;
        if (cb >= 384 && cb < 512) { u32x2 z8; z8.x = 0u; z8.y = 0u; *(u32x2*)((unsigned char*)LAT + (size_t)row * 768 + cb + 8 * fq) = z8; }
        if (cb < 384 || (cb >= 512 && cb < 768)) {
            { const f32x4 s0 = v0 * LAT8_SCALE, s1 = v1 * LAT8_SCALE; u32x2 w8; w8.x = pack4_fp8(s0[0], s0[1], s0[2], s0[3]); w8.y = pack4_fp8(s1[0], s1[1], s1[2], s1[3]);
              *(u32x2*)((unsigned char*)LAT + (size_t)row * 768 + cb + 8 * fq) = w8; }
            float ss = (v0[0] * v0[0] + v0[1] * v0[1]) + (v0[2] * v0[2] + v0[3] * v0[3]) + (v1[0] * v1[0] + v1[1] * v1[1]) + (v1[2] * v1[2] + v1[3] * v1[3]);
            ss += swz_xor<16>(ss); ss = sum_x32(ss);
            const int slot = cb < 384 ? (cb >> 5) : 12 + ((cb - 512) >> 5);
            if (fq == 0) RSQ[(size_t)row * 24 + slot] = ss;
        } else if (cb < 416) {
            const f32x4 cs = *(const f32x4*)(COS + (size_t)row * 16 + 4 * fq), sn = *(const f32x4*)(SIN + (size_t)row * 16 + 4 * fq);
            const f32x4 o1 = v0 * cs - v1 * sn, o2 = v0 * sn + v1 * cs;
            const u32x4 w = pack8(o1, o2);
            *(u32x4*)(KM + (size_t)row * 768 + 64 + 8 * fq) = w;
        } else if (cb >= 768) {
            const int g = (cb - 768) >> 10, c = (cb - 768) & 1023;
            if (g == 0) {
                v0 = v0 * (CQ_DIFF * DQ8_SCALE); v1 = v1 * (CQ_DIFF * DQ8_SCALE);
                u32x2 w8; w8.x = pack4_fp8(v0[0], v0[1], v0[2], v0[3]); w8.y = pack4_fp8(v1[0], v1[1], v1[2], v1[3]);
                *(u32x2*)((unsigned char*)ZB + (size_t)row * 1024 + c + 8 * fq) = w8; return; }
            if (g >= 3) {
#pragma unroll
                for (int i = 0; i < 4; ++i) { v0[i] = sigmoidf_(v0[i]); v1[i] = sigmoidf_(v1[i]); }
                u32x2 w8; w8.x = pack4_fp8(v0[0], v0[1], v0[2], v0[3]); w8.y = pack4_fp8(v1[0], v1[1], v1[2], v1[3]);
                *(u32x2*)((unsigned char*)(ZB + (size_t)g * T * 1024) + (size_t)row * 1024 + c + 8 * fq) = w8;
            } else *(u32x4*)(ZB + (size_t)g * T * 1024 + (size_t)row * 1024 + c + 8 * fq) = pack8(v0, v1);
        }
    }
};
struct FQup {   static constexpr bool HAS_PAIR = false;
    bf16_t* QM; const float* RSQ; const float* COS; const float* SIN;
    __device__ __forceinline__ float rowscale(int row) const {
        const f32x4 a = *(const f32x4*)(RSQ + (size_t)row * 24), b = *(const f32x4*)(RSQ + (size_t)row * 24 + 4), c = *(const f32x4*)(RSQ + (size_t)row * 24 + 8);
        const float ss = ((a[0] + a[1]) + (a[2] + a[3])) + ((b[0] + b[1]) + (b[2] + b[3])) + ((c[0] + c[1]) + (c[2] + c[3]));
        return (CQ_MLA / (LAT8_SCALE * W8_SCALE)) * __builtin_amdgcn_rsqf(ss * (1.0f / 384.0f) + RMS_EPS); }
    __device__ __forceinline__ void operator()(int row, float r, int cb, int fq, f32x4 v0, f32x4 v1) const {
        v0 = v0 * r; v1 = v1 * r;
        if ((cb % 96) == 64) {
            const f32x4 cs = *(const f32x4*)(COS + (size_t)row * 16 + 4 * fq), sn = *(const f32x4*)(SIN + (size_t)row * 16 + 4 * fq);
            const f32x4 o1 = v0 * cs - v1 * sn, o2 = v0 * sn + v1 * cs; v0 = o1; v1 = o2;
        }
        *(u32x4*)(QM + (size_t)row * 768 + cb + 8 * fq) = pack8(v0, v1);
    }
};
struct FKVup {  static constexpr bool HAS_PAIR = false;
    bf16_t* KM; bf16_t* VM; const float* RSQ;
    __device__ __forceinline__ float rowscale(int row) const {
        const f32x4 a = *(const f32x4*)(RSQ + (size_t)row * 24 + 12), b = *(const f32x4*)(RSQ + (size_t)row * 24 + 16);
        const float ss = ((a[0] + a[1]) + (a[2] + a[3])) + ((b[0] + b[1]) + (b[2] + b[3]));
        return (1.0f / (LAT8_SCALE * W8_SCALE)) * __builtin_amdgcn_rsqf(ss * (1.0f / 256.0f) + RMS_EPS); }
    __device__ __forceinline__ void operator()(int row, float r, int cb, int fq, f32x4 v0, f32x4 v1) const {
        v0 = v0 * r; v1 = v1 * r;
        const int h = cb >> 7, w = cb & 127;
        if (w < 64) *(u32x4*)(KM + (size_t)row * 768 + h * 96 + w + 8 * fq) = pack8(v0, v1);
        else *(u32x4*)(VM + (size_t)row * 512 + h * 64 + (w - 64) + 8 * fq) = pack8(v0, v1);
    }
};
struct FBr1 {   static constexpr bool HAS_PAIR = false;
    bf16_t* T1; const bf16_t* SA;
    __device__ __forceinline__ float rowscale(int) const { return 1.f; }
    __device__ __forceinline__ void operator()(int row, float rs, int cb, int fq, f32x4 v0, f32x4 v1) const {
        const size_t o = (size_t)row * 1024 + cb + 8 * fq; f32x4 s0, s1; unpack8(*(const u32x4*)(SA + o), s0, s1);
        *(u32x4*)(T1 + o) = pack8(v0 * s0, v1 * s1);
    }
};
struct FBr2 {   static constexpr bool HAS_PAIR = false;
    bf16_t* MB; const bf16_t* T1; const bf16_t* SB;
    __device__ __forceinline__ float rowscale(int) const { return 1.f; }
    __device__ __forceinline__ void operator()(int row, float rs, int cb, int fq, f32x4 v0, f32x4 v1) const {
        const size_t o = (size_t)row * 1024 + cb + 8 * fq; f32x4 s0, s1, t0, t1; unpack8(*(const u32x4*)(SB + o), s0, s1); unpack8(*(const u32x4*)(T1 + o), t0, t1);
        *(u32x4*)(MB + o) = pack8(t0 + v0 * s0, t1 + v1 * s1);
    }
};
struct FRes {   static constexpr bool HAS_PAIR = false;
    float* PRE; const float* X; const float* gate;
    __device__ __forceinline__ float rowscale(int) const { return 1.f; }
    __device__ __forceinline__ void operator()(int row, float rs, int cb, int fq, f32x4 v0, f32x4 v1) const {
        const int b = row >> 11; const float* gp = gate + (size_t)b * 6144 + cb + 4 * fq;
        const size_t o = (size_t)row * 1024 + cb + 4 * fq;
        const f32x4 g0 = *(const f32x4*)gp, g1 = *(const f32x4*)(gp + 16), x0 = *(const f32x4*)(X + o), x1 = *(const f32x4*)(X + o + 16);
        *(f32x4*)(PRE + o) = x0 * ALPHA + g0 * v0; *(f32x4*)(PRE + o + 16) = x1 * ALPHA + g1 * v1;
    }
};
struct FMoeOut {
    bf16_t* Y; const int* RMAP;
    __device__ __forceinline__ float rowscale(int) const { return 1.f; }
    __device__ __forceinline__ void operator()(int row, float rs, int cb, int fq, f32x4 v0, f32x4 v1) const {
        const int s = RMAP[row];
        if (s >= 0) *(u32x4*)(Y + (size_t)s * 1024 + cb + 8 * fq) = pack8(v0, v1);
    }
};

template <int MODE, bool ROUTE>
__device__ __forceinline__ void ln_phase(const Ctx& C, unsigned char* H8, const bf16_t* XIN, const bf16_t* G, bf16_t* XB, float* OUT32, bf16_t* H, const float* lng, const float* lnb, const float* sc, const float* sh,
                                         const bf16_t* Y, const float* GATE, const float* g2, const float* rw, const float* rb, int* SEL, float* GOUT, unsigned* CNT, unsigned* WGH = nullptr) {
    int lane_ = C.lane; asm volatile("" : "+v"(lane_)); const int lane = lane_; const int wg = blockIdx.x; const int b = (wg * 128) >> 11;
    f32x4 vg[4], vb[4], vsc[4], vsh[4], vg2[4];
#pragma unroll
    for (int j = 0; j < 4; ++j) { const int c = 4 * lane + 256 * j; vg[j] = *(const f32x4*)(lng + c); vb[j] = *(const f32x4*)(lnb + c);
        if (sc) { vsc[j] = *(const f32x4*)(sc + (size_t)b * 6144 + c) + 1.0f; vsh[j] = *(const f32x4*)(sh + (size_t)b * 6144 + c); }
        vg2[j] = *(const f32x4*)(g2 + (size_t)b * 6144 + c); }
    LAS float* rwl = (LAS float*)C.lds;
    LAS unsigned* hist = (LAS unsigned*)(C.lds + 32768);
    if (ROUTE) { for (int i = C.tid; i < 8192; i += NWAVES * 64) rwl[(i & 7) * 1024 + (i >> 3)] = rw[i]; if (C.tid < 8) hist[C.tid] = 0u; __syncthreads(); }
    for (int rr = 0; rr < 8; ++rr) {
        u32x2 vv[2][4], rya[2][4], ryb[2][4]; float rga[2], rgb[2];
#pragma unroll
        for (int h2 = 0; h2 < 2; ++h2) { const int row = wg * 128 + C.wave * 16 + rr + 8 * h2;
            if (MODE == 0) {
#pragma unroll
                for (int j = 0; j < 4; ++j) { const int c = 4 * lane + 256 * j; vv[h2][j] = *(const u32x2*)(XIN + (size_t)row * 1024 + c); rya[h2][j] = *(const u32x2*)(G + (size_t)row * 1024 + c); }
            } else {
                rga[h2] = GATE[2 * row]; rgb[h2] = GATE[2 * row + 1];
#pragma unroll
                for (int j = 0; j < 4; ++j) { const int c = 4 * lane + 256 * j; vv[h2][j] = *(const u32x2*)(XB + (size_t)row * 1024 + c);
                    rya[h2][j] = *(const u32x2*)(Y + (size_t)(2 * row) * 1024 + c); ryb[h2][j] = *(const u32x2*)(Y + (size_t)(2 * row + 1) * 1024 + c); }
            } }
#pragma unroll
      for (int h2 = 0; h2 < 2; ++h2) { const int row = wg * 128 + C.wave * 16 + rr + 8 * h2;
        f32x4 v[4];
        if (MODE == 0) {
#pragma unroll
            for (int j = 0; j < 4; ++j) { const u32x2 ya = rya[h2][j], xw = vv[h2][j]; f32x4 fa, xv; fa[0] = __uint_as_float(ya.x << 16); fa[1] = __uint_as_float(ya.x & 0xffff0000u); fa[2] = __uint_as_float(ya.y << 16); fa[3] = __uint_as_float(ya.y & 0xffff0000u);
                xv[0] = __uint_as_float(xw.x << 16); xv[1] = __uint_as_float(xw.x & 0xffff0000u); xv[2] = __uint_as_float(xw.y << 16); xv[3] = __uint_as_float(xw.y & 0xffff0000u);
                v[j] = xv * ALPHA + vg2[j] * fa; }
        } else {
            const float ga = rga[h2], gb = rgb[h2];
#pragma unroll
            for (int j = 0; j < 4; ++j) { const u32x2 xw = vv[h2][j]; const u32x2 ya = rya[h2][j], yb = ryb[h2][j];
                f32x4 fa, fb, xv; xv[0] = __uint_as_float(xw.x << 16); xv[1] = __uint_as_float(xw.x & 0xffff0000u); xv[2] = __uint_as_float(xw.y << 16); xv[3] = __uint_as_float(xw.y & 0xffff0000u); fa[0] = __uint_as_float(ya.x << 16); fa[1] = __uint_as_float(ya.x & 0xffff0000u); fa[2] = __uint_as_float(ya.y << 16); fa[3] = __uint_as_float(ya.y & 0xffff0000u);
                fb[0] = __uint_as_float(yb.x << 16); fb[1] = __uint_as_float(yb.x & 0xffff0000u); fb[2] = __uint_as_float(yb.y << 16); fb[3] = __uint_as_float(yb.y & 0xffff0000u);
                v[j] = xv * ALPHA + vg2[j] * (fa * ga + fb * gb); }
        }
        float s = 0.f;
#pragma unroll
        for (int j = 0; j < 4; ++j) s += (v[j][0] + v[j][1]) + (v[j][2] + v[j][3]);
        const float mean = wave_sum(s) * (1.f / 1024.f); float s2 = 0.f;
#pragma unroll
        for (int j = 0; j < 4; ++j) { v[j] = v[j] - mean; s2 += (v[j][0] * v[j][0] + v[j][1] * v[j][1]) + (v[j][2] * v[j][2] + v[j][3] * v[j][3]); }
        const float rstd = 1.f / sqrtf(wave_sum(s2) * (1.f / 1024.f) + LN_EPS);
        float lg[8];
        if (ROUTE) {
#pragma unroll
            for (int e = 0; e < 8; ++e) lg[e] = 0.f; }
#pragma unroll
        for (int j = 0; j < 4; ++j) { const int c = 4 * lane + 256 * j; const f32x4 y = v[j] * rstd * vg[j] + vb[j];
            if (OUT32) *(f32x4*)(OUT32 + (size_t)row * 1024 + c) = y;
            else { u32x2 w; w.x = cvt_pk_bf16(y[0], y[1]); w.y = cvt_pk_bf16(y[2], y[3]); *(u32x2*)(XB + (size_t)row * 1024 + c) = w; }
            if (sc) { const f32x4 hh = y * vsc[j] + vsh[j];
                if (H) { u32x2 w; w.x = cvt_pk_bf16(hh[0], hh[1]); w.y = cvt_pk_bf16(hh[2], hh[3]); *(u32x2*)(H + (size_t)row * 1024 + c) = w; }
                if (H8) *(unsigned*)(H8 + (size_t)row * 1024 + c) = pack4_fp8(hh[0], hh[1], hh[2], hh[3]);
                if (ROUTE) {
#pragma unroll
                    for (int e = 0; e < 8; ++e) { const f32x4 w4 = *(const LAS f32x4*)(rwl + e * 1024 + c); lg[e] += (hh[0] * w4[0] + hh[1] * w4[1]) + (hh[2] * w4[2] + hh[3] * w4[3]); } } } }
        if (ROUTE) {
#pragma unroll
            for (int e = 0; e < 8; ++e) lg[e] = wave_sum(lg[e]) + rb[e];
            int i0 = 0; float m0 = lg[0];
#pragma unroll
            for (int e = 1; e < 8; ++e) if (lg[e] > m0) { m0 = lg[e]; i0 = e; }
            int i1 = -1; float m1 = -INFINITY;
#pragma unroll
            for (int e = 0; e < 8; ++e) if (e != i0 && lg[e] > m1) { m1 = lg[e]; i1 = e; }
            const float g0 = 1.0f / (1.0f + expf(m1 - m0));
            if (lane == 0) { SEL[row] = i0 | (i1 << 8); GOUT[2 * row] = g0; GOUT[2 * row + 1] = 1.0f - g0; atomicAdd((unsigned*)&hist[i0], 1u); atomicAdd((unsigned*)&hist[i1], 1u); }
        }
      }
    }
    if (ROUTE) { __syncthreads(); if (C.tid < 8) WGH[blockIdx.x * 8 + C.tid] = (unsigned)hist[C.tid]; }
}

constexpr int NPH_L = 10, NPHASE = 2 + DEPTH * NPH_L;
#ifndef LB2
#define LB2 2
#endif
#ifdef NVGPR
__attribute__((amdgpu_num_vgpr(NVGPR)))
#endif
__global__ void __launch_bounds__(NWAVES * 64, LB2) mk_fwd(Args args) {
    extern __shared__ __attribute__((aligned(16))) unsigned char lds[];
    const int wave0 = __builtin_amdgcn_readfirstlane((int)threadIdx.x >> 6);
    Ctx C; C.lds = (LAS unsigned char*)lds; C.wave = wave0; C.lane = (int)__builtin_amdgcn_mbcnt_hi(~0u, __builtin_amdgcn_mbcnt_lo(~0u, 0u)); C.tid = wave0 * 64 + C.lane;
    C.G = gridDim.x; { const int bx = blockIdx.x; C.vcu = (C.G % 8 == 0) ? (bx % 8) * (C.G / 8) + bx / 8 : bx; }
    KArgP ka0 = kargs();
    unsigned* const ctl0 = (unsigned*)(ka0->ws + WS_CTL);
    volatile LAS unsigned* MISC = (volatile LAS unsigned*)(C.lds + MISC_OFF);
    for (int u = C.tid; u < (LDS_BYTES - LDSCTL_OFF) / 4; u += NWAVES * 64) ((LAS unsigned*)(C.lds + LDSCTL_OFF))[u] = 0u;
    __syncthreads();
    if (PROBE == 30 && blockIdx.x == 0 && C.tid == 0) { const unsigned long long c0 = clock64(), t0 = __builtin_amdgcn_s_memrealtime();
        MISC[16] = (unsigned)c0; MISC[17] = (unsigned)(c0 >> 32); MISC[18] = (unsigned)t0; MISC[19] = (unsigned)(t0 >> 32); }
    XcdBarrier bar; bar.bar = ctl0 + CW_BAR; bar.x = 0; bar.st = nullptr;
    if (!MK_PER_PHASE) bar = xcd_barrier_post(ctl0 + CW_BAR, MISC + 8, C.tid == 0);
    const int lo = ka0->ph_lo, hi = ka0->ph_hi;
#define GEMM_RUN(call) do { call; if (PROBE == 1 || PROBE == 10 + PHK) { asm volatile("s_waitcnt vmcnt(0)" ::: "memory"); __syncthreads(); call; } } while (0)
#define FRESH() do { int l_; asm volatile("v_mbcnt_lo_u32_b32 %0, -1, 0\n\tv_mbcnt_hi_u32_b32 %0, -1, %0" : "=v"(l_)); C.lane = l_; C.wave = wave0; C.tid = wave0 * 64 + l_; } while (0)
#define IN(k) (lo <= (k) && (k) < hi)
#define SEAM(k) do { if (IN((k) + 1)) { FRESH(); XcdBarrier b2_ = bar; asm volatile("" : "+s"(b2_.bar)); xcd_barrier(b2_, C.tid == 0); if (PROBE == 6) xcd_barrier(b2_, C.tid == 0); } } while (0)
#define MOD ((float*)(ws + WS_MOD))
#define PART ((float*)(ws + WS_PART))
#define RSQ ((float*)(ws + WS_RSQ))
#define COS ((float*)(ws + WS_COS))
#define SIN ((float*)(ws + WS_SIN))
#define H ((bf16_t*)(ws + WS_H))
#define LAT ((bf16_t*)(ws + WS_LAT))
#define ZB ((bf16_t*)(ws + WS_ZB))
#define QM ((bf16_t*)(ws + WS_QM))
#define KM ((bf16_t*)(ws + WS_KM))
#define VM ((bf16_t*)(ws + WS_VM))
#define OM ((bf16_t*)(ws + WS_OM))
#define PRE ((float*)(ws + WS_PRE))
#define T1 ((bf16_t*)(ws + WS_T1))
#define MB ((bf16_t*)(ws + WS_MB))
#define DQ (ZB)
#define DK (ZB + (size_t)T * 1024)
#define DV (ZB + (size_t)2 * T * 1024)
#define SA (ZB + (size_t)3 * T * 1024)
#define SB (ZB + (size_t)4 * T * 1024)
#define XB ((bf16_t*)(ws + WS_XRES))
#define ctl ((unsigned*)(ws + WS_CTL))
#define gw (C.vcu * NWAVES + C.wave)
#define NGW (C.G * NWAVES)

    if (PHM(10) && IN(0)) { KArgP ka = kargs(); (void)ka; FRESH(); unsigned char* const ws = ka->ws; C.ws = ws;
        for (int rep = 0; rep < (PROBE == 4 ? 2 : 1); ++rep) { cvt_mixer_weights(C, 0); cvt_ffn_weights(C, 0); }
        LAS float* cond = (LAS float*)(C.lds + C.wave * 8448);
        for (int it = gw; it < 4 * 24 * 16; it += NGW) {
            const int kc = it & 15, jb = (it >> 4) % 24, l = it / (16 * 24);
            for (int i = C.lane; i < 1024; i += 64) { const int k = i >> 4, b = i & 15; const float cv = ka->c[b * 1024 + kc * 64 + k]; cond[k * 16 + b] = cv / (1.0f + expf(-cv)); }
            asm volatile("s_waitcnt lgkmcnt(0)" ::: "memory");
            f32x4 acc[16];
#pragma unroll
            for (int b = 0; b < 16; ++b) acc[b] = (f32x4){0.f, 0.f, 0.f, 0.f};
            const float* wp = ka->w_ada + ((size_t)l * 1024 + kc * 64) * 6144 + jb * 256 + 4 * C.lane;
#pragma unroll 4
            for (int k = 0; k < 64; ++k) { const f32x4 w = *(const f32x4*)(wp + (size_t)k * 6144);
                const f32x4 c0 = *(const LAS f32x4*)(cond + k * 16), c1 = *(const LAS f32x4*)(cond + k * 16 + 4), c2 = *(const LAS f32x4*)(cond + k * 16 + 8), c3 = *(const LAS f32x4*)(cond + k * 16 + 12);
#pragma unroll
                for (int b = 0; b < 4; ++b) { acc[b] += w * c0[b]; acc[4 + b] += w * c1[b]; acc[8 + b] += w * c2[b]; acc[12 + b] += w * c3[b]; } }
#pragma unroll
            for (int b = 0; b < 16; ++b) *(f32x4*)(PART + (((size_t)kc * 4 + l) * 16 + b) * 6144 + jb * 256 + 4 * C.lane) = acc[b];
            asm volatile("s_waitcnt lgkmcnt(0)" ::: "memory");
        }
        for (int i = blockIdx.x * (NWAVES * 64) + C.tid; i < T * 16; i += C.G * NWAVES * 64) {
            const int t = i >> 4, j = i & 15; const float inv = powf(10000.0f, -(float)j * (1.0f / 16.0f)); const float ang = (float)ka->pos[t] * inv;
            COS[i] = cosf(ang); SIN[i] = sinf(ang); }
        SEAM(0);
    }
    if (PHM(11) && IN(1)) { KArgP ka = kargs(); (void)ka; FRESH(); unsigned char* const ws = ka->ws; C.ws = ws;
        for (int i = blockIdx.x * (NWAVES * 64) + C.tid; i < 4 * 16 * 6144; i += C.G * NWAVES * 64) {
            const int j = i % 6144, l = i / (16 * 6144); float s = ka->b_ada[l * 6144 + j];
#pragma unroll
            for (int kc = 0; kc < 16; ++kc) s += PART[(size_t)kc * 4 * 16 * 6144 + i];
            MOD[i] = s; }
        { const int wg = blockIdx.x, b = (wg * 128) >> 11; f32x4 vsc[4], vsh[4];
#pragma unroll
          for (int j = 0; j < 4; ++j) { const int c = 4 * C.lane + 256 * j; f32x4 a = *(const f32x4*)(ka->b_ada + c), s = *(const f32x4*)(ka->b_ada + 1024 + c);
#pragma unroll 4
              for (int kc = 0; kc < 16; ++kc) { const float* p = PART + (((size_t)kc * 4 + 0) * 16 + b) * 6144; a += *(const f32x4*)(p + c); s += *(const f32x4*)(p + 1024 + c); }
              vsh[j] = a; vsc[j] = s + 1.0f; }
          for (int rr = 0; rr < 16; ++rr) { const int row = wg * 128 + C.wave * 16 + rr;
#pragma unroll
              for (int j = 0; j < 4; ++j) { const int c = 4 * C.lane + 256 * j; const f32x4 xv = *(const f32x4*)(ka->x + (size_t)row * 1024 + c); const f32x4 hh = xv * vsc[j] + vsh[j];
                  *(unsigned*)(ws + WS_H8 + (size_t)row * 1024 + c) = pack4_fp8(hh[0], hh[1], hh[2], hh[3]);
                  { u32x2 w; w.x = cvt_pk_bf16(xv[0], xv[1]); w.y = cvt_pk_bf16(xv[2], xv[3]); *(u32x2*)(XB + (size_t)row * 1024 + c) = w; } } } }
        SEAM(1);
    }

    for (int l = 0; l < DEPTH; ++l) {
        const int P = 2 + l * NPH_L;
        const bool moe = (l & 1) != 0; const int li = l >> 1;
        if (PHM(0) && IN(P + 0)) { KArgP ka = kargs(); (void)ka; FRESH(); unsigned char* const ws = ka->ws; C.ws = ws; constexpr int PHK = 0;
            pg8::Gemm g{(const bf16_t*)(ws + WS_H8), (const bf16_t*)(ws + WS_WIN8), T, NZ, 512, 512}; pg8::StaticOrder S; S.init(T, NZ, C.G, (int)blockIdx.x);
            pg8::EpiRow<FIn, true, true> E{FIn{LAT, ZB, KM, RSQ, COS, SIN, 0, 1.0f / W8_SCALE, ctl + CW_KMAX + l * 256}};
            GEMM_RUN((pg8::gemm_phase<STG_IN, true>(C.lds, C.tid, g, S, E)));
            SEAM(P + 0);
        }
        if (PHM(1) && IN(P + 1)) { KArgP ka = kargs(); (void)ka; FRESH(); unsigned char* const ws = ka->ws; C.ws = ws; constexpr int PHK = 1;
            { pg8::Gemm g{LAT, (const bf16_t*)(ws + W_QUP), T, 768, 256, 384}; pg8::StaticOrder S; S.init(T, 768, C.G, (int)blockIdx.x);
              pg8::EpiRow<FQup, true, true> E{FQup{QM, RSQ, COS, SIN}}; GEMM_RUN((pg8::gemm_phase<0, true>(C.lds, C.tid, g, S, E))); }
            { pg8::Gemm g{(const bf16_t*)((const unsigned char*)LAT + 512), (const bf16_t*)(ws + W_KVUP), T, 1024, 128, 384}; pg8::StaticOrder S; S.init(T, 1024, C.G, (int)blockIdx.x);
              pg8::EpiRow<FKVup, true, true> E{FKVup{KM, VM, RSQ}}; GEMM_RUN((pg8::gemm_phase<0, true>(C.lds, C.tid, g, S, E))); }
            SEAM(P + 1);
        }
        if (PHM(2) && IN(P + 2)) { KArgP ka = kargs(); (void)ka; FRESH(); unsigned char* const ws = ka->ws; C.ws = ws;
            float lam;
            { float s1 = 0.f, s2 = 0.f;
              for (int i = 0; i < 64; ++i) { s1 += ka->lq1[l * 64 + i] * ka->lk1[l * 64 + i]; s2 += ka->lq2[l * 64 + i] * ka->lk2[l * 64 + i]; }
              lam = expf(s1) - expf(s2) + ka->lam_init[l]; }
            const int xcd = C.vcu >> 5, jj = C.vcu & 31; const bool g256 = (C.G == 256);
            for (int rep = 0; rep < (PROBE == 2 ? 2 : 1); ++rep)
            for (int i = 0; ; ++i) {
                int u; if (g256) { if (i >= 4) break; u = xcd * 128 + i * 32 + jj; } else { u = i * C.G + C.vcu; if (u >= 1024) break; }
                const int bh = u >> 3, qb = u & 7, b = bh >> 3, h = bh & 7; const size_t r0 = (size_t)b * SEQ;
                att::DiffArgs da{nullptr, 0.f, 0.f, 0.f, nullptr, 0.f, h * 96};
                att::attn_unit<false>(QM + (r0 + qb * 256) * 768 + h * 96, KM + r0 * 768, VM + r0 * 512 + h * 64, (unsigned char*)OM + (r0 + qb * 256) * 512 + h * 64, qb * 256, da, (char*)lds, C.lds, C.tid);
            }
            int bprev = -1;
            for (int rep = 0; rep < (PROBE == 3 ? 2 : 1); ++rep)
            for (int i = 0; ; ++i) {
                int b, h, qb;
                if (g256) { if (i >= 8) break; h = i; b = xcd * 2 + (jj >> 4); qb = ((jj & 15) + 2 * i) & 15; }
                const size_t r0 = (size_t)b * SEQ;
                if (b != bprev) { __syncthreads(); att::diff_pos_setup(ka->pos + r0, (char*)lds, C.tid); bprev = b; }
                const unsigned* km = ctl + CW_KMAX + l * 256 + (b * 8 + h) * 2;
                att::DiffArgs da{ka->pos + r0, exp2f(-(float)(h + 1)) * LOG2E, lam, 1.0f - ka->lam_init[l], ka->diff_norm_g + l * 1024 + h * 128, 1.01f * fmaxf(__uint_as_float(km[0]), __uint_as_float(km[1])), 0};
                att::attn_unit<true>((const bf16_t*)((const unsigned char*)DQ + (r0 + qb * 128) * 1024 + h * 128), DK + r0 * 1024 + h * 128, DV + r0 * 1024 + h * 128,
                                     (ws + WS_DO8) + (r0 + qb * 128) * 1024 + h * 128, qb * 128, da, (char*)lds, C.lds, C.tid);
            }
            SEAM(P + 2);
        }
        if (PHM(3) && IN(P + 3)) { KArgP ka = kargs(); (void)ka; FRESH(); unsigned char* const ws = ka->ws; C.ws = ws; constexpr int PHK = 3;
            { pg8::Gemm g{OM, (const bf16_t*)(ws + W_BRM), T, 1024, 256, 256}; pg8::StaticOrder S; S.init(T, 1024, C.G, (int)blockIdx.x);
              pg8::EpiBr<1> E{T1, nullptr, nullptr, nullptr, 1.0f / (O8_SCALE * W8_SCALE_BR)}; GEMM_RUN((pg8::gemm_phase<STG_BR, true>(C.lds, C.tid, g, S, E))); }
            asm volatile("s_waitcnt vmcnt(0)" ::: "memory"); __syncthreads();
            { pg8::Gemm g{(const bf16_t*)(ws + WS_DO8), (const bf16_t*)(ws + W_BRD), T, 1024, 512, 512}; pg8::StaticOrder S; S.init(T, 1024, C.G, (int)blockIdx.x);
              pg8::EpiBr<2> E{MB, (const unsigned char*)SA, (const unsigned char*)SB, (const unsigned char*)T1, 1.0f / (O8_SCALE * W8_SCALE_BR)}; GEMM_RUN((pg8::gemm_phase<0, true>(C.lds, C.tid, g, S, E))); }
            SEAM(P + 3);
        }
        if (PHM(4) && IN(P + 4)) { KArgP ka = kargs(); (void)ka; FRESH(); unsigned char* const ws = ka->ws; C.ws = ws; constexpr int PHK = 4;
            pg8::Gemm g{MB, (const bf16_t*)(ws + W_OUT), T, 1024, 512, 512}; pg8::StaticOrder S; S.init(T, 1024, C.G, (int)blockIdx.x);
            pg8::EpiGate E{(bf16_t*)(ws + WS_PRE), 1.0f / (pg8::MB8_SCALE * W8_SCALE_BR)}; GEMM_RUN((pg8::gemm_phase<STG_OUT, true>(C.lds, C.tid, g, S, E)));
            SEAM(P + 4);
        }
        if (PHM(5) && IN(P + 5)) { KArgP ka = kargs(); (void)ka; FRESH(); unsigned char* const ws = ka->ws; C.ws = ws;
            if (moe) ln_phase<0, true>(C, ws + WS_H, XB, (const bf16_t*)(ws + WS_PRE), XB, (float*)nullptr, (bf16_t*)nullptr, ka->ln1_g + l * 1024, ka->ln1_b + l * 1024, (MOD + (size_t)l * 16 * 6144) + 4096, (MOD + (size_t)l * 16 * 6144) + 3072, nullptr, nullptr, (MOD + (size_t)l * 16 * 6144) + 2048,
                                       ka->router_w + (size_t)li * 8192, ka->router_b + li * 8, (int*)(ws + WS_SEL), (float*)(ws + WS_GATE), ctl + CW_CNT + 64 * li, ctl + CW_WGH + 2048 * li);
            else ln_phase<0, false>(C, nullptr, XB, (const bf16_t*)(ws + WS_PRE), XB, (float*)nullptr, H, ka->ln1_g + l * 1024, ka->ln1_b + l * 1024, (MOD + (size_t)l * 16 * 6144) + 4096, (MOD + (size_t)l * 16 * 6144) + 3072, nullptr, nullptr, (MOD + (size_t)l * 16 * 6144) + 2048, nullptr, nullptr, nullptr, nullptr, nullptr);
            SEAM(P + 5);
        }
        int ts[9];
#pragma unroll
        for (int e = 0; e < 9; ++e) ts[e] = 0;
        if (moe && (IN(P + 6) || IN(P + 7) || IN(P + 8))) { KArgP ka = kargs(); FRESH(); unsigned char* const ws = ka->ws;
            const unsigned* WGH = ctl + CW_WGH + 2048 * li; LAS unsigned* kl = (LAS unsigned*)C.lds;
            { const int e = C.wave, wg = blockIdx.x; float tot = 0.f, pre = 0.f;
#pragma unroll
              for (int j = 0; j < 4; ++j) { const int w = C.lane + 64 * j; const float v = (float)__hip_atomic_load(WGH + w * 8 + e, __ATOMIC_RELAXED, __HIP_MEMORY_SCOPE_AGENT); tot += v; pre += (w < wg) ? v : 0.f; }
              tot = wave_sum(tot); pre = wave_sum(pre); if (C.lane == 0) { kl[e] = (unsigned)pre; kl[48 + e] = (unsigned)tot; } }
            __syncthreads();
            int accp = 0;
#pragma unroll
            for (int e = 0; e < 8; ++e) { ts[e] = accp; const int cnt = (int)kl[48 + e]; accp += (cnt + 255) >> 8; }
            ts[8] = accp;
        }
        if (PHM(6) && IN(P + 6)) { KArgP ka = kargs(); (void)ka; FRESH(); unsigned char* const ws = ka->ws; C.ws = ws;
            if (moe) {
                const int* SEL = (const int*)(ws + WS_SEL); int* RMAP = (int*)(ws + WS_RMAP);
                LAS unsigned* kl = (LAS unsigned*)C.lds;
                if (blockIdx.x == 0) {
                    _Pragma("unroll") for (int e = 0; e < 8; ++e) { const int c = (int)kl[48 + e], beg = ts[e] * 256 + c, end = ts[e + 1] * 256; for (int p = beg + C.tid; p < end; p += NWAVES * 64) RMAP[p] = -1; } }
                const int wg = blockIdx.x;
                int e_my = 0, rank = 0, tsv = 0;
                if (C.wave < 4) { const int s = wg * 256 + C.wave * 64 + C.lane, t = s >> 1, k = s & 1; const int sel = SEL[t]; e_my = k ? (sel >> 8) : (sel & 255);
#pragma unroll
                    for (int ee = 0; ee < 8; ++ee) { const unsigned long long m = __ballot(e_my == ee);
                        if (C.lane == 0) kl[8 + C.wave * 8 + ee] = (unsigned)__popcll(m);
                        if (e_my == ee) { rank = (int)__builtin_amdgcn_mbcnt_hi((unsigned)(m >> 32), __builtin_amdgcn_mbcnt_lo((unsigned)m, 0u)); tsv = ts[ee]; } } }
                __syncthreads();
                if (C.wave < 4) { unsigned off = kl[e_my];
#pragma unroll
                    for (int w2 = 0; w2 < 3; ++w2) off += (w2 < C.wave) ? kl[8 + w2 * 8 + e_my] : 0u;
                    const int pos = tsv * 256 + (int)off + rank;
                    RMAP[pos] = wg * 256 + C.wave * 64 + C.lane; kl[64 + C.wave * 64 + C.lane] = (unsigned)pos; }
                __syncthreads();
                { unsigned char* XB8 = ws + WS_XB; const unsigned char* H8 = (const unsigned char*)H;
                  const int pos = (int)kl[64 + C.wave * 32 + (C.lane & 31)];
                  for (int q = 0; q < 32; q += 16) {
                    u32x4 r0[8];
#pragma unroll
                    for (int u = 0; u < 8; ++u) { const int tq = wg * 128 + C.wave * 16 + (q >> 1) + u; r0[u] = ((const u32x4*)(H8 + (size_t)tq * 1024))[C.lane]; }
#pragma unroll
                    for (int u = 0; u < 8; ++u) {
#pragma unroll
                        for (int k2 = 0; k2 < 2; ++k2) { const int pq = __builtin_amdgcn_readlane(pos, q + 2 * u + k2); ((u32x4*)(XB8 + (size_t)pq * 1024))[C.lane] = r0[u]; } }
                  } }
            }
            if (moe) SEAM(P + 6);
        }
        if (PHM(7) && IN(P + 7)) { KArgP ka = kargs(); (void)ka; FRESH(); unsigned char* const ws = ka->ws; C.ws = ws; constexpr int PHK = 7;
            if (!moe) { pg8::Gemm g{H, (const bf16_t*)(ws + WS_WFF), T, 5632, 1024, 1024}; pg8::StaticOrder S; S.init(T, 5632, C.G, (int)blockIdx.x);
                pg8::EpiSwiglu E{(bf16_t*)(ws + WS_U), FF, 1.0f, true}; GEMM_RUN(pg8::gemm_phase(C.lds, C.tid, g, S, E)); }
            else { pg8::Gemm g{(const bf16_t*)(ws + WS_XB), (const bf16_t*)(ws + WS_WFF), ts[8] * 256, 5632, 512, 512};
                pg8::MoeOrderT<false> S; S.rmap = nullptr; S.so.init(ts[8] * 256, 5632, C.G, (int)blockIdx.x); S.ts1 = ts[1]; S.ts2 = ts[2]; S.ts3 = ts[3]; S.ts4 = ts[4]; S.ts5 = ts[5]; S.ts6 = ts[6]; S.ts7 = ts[7]; S.estride = W13_ESTRIDE8;
                pg8::EpiSwiglu E{(bf16_t*)(ws + WS_UM), FF, 1.0f / W8_SCALE, true}; GEMM_RUN((pg8::gemm_phase<0, true>(C.lds, C.tid, g, S, E))); }
            SEAM(P + 7);
        }
        if (PHM(8) && IN(P + 8)) { KArgP ka = kargs(); (void)ka; FRESH(); unsigned char* const ws = ka->ws; C.ws = ws; constexpr int PHK = 8;
            if (!moe) { pg8::Gemm g{(const bf16_t*)(ws + WS_U), (const bf16_t*)(ws + W2_BASE), T, 1024, FF / 2, FF / 2}; pg8::StaticOrder S; S.init(T, 1024, C.G, (int)blockIdx.x);
                pg8::EpiGate E{(bf16_t*)(ws + WS_PRE), 1.0f / W8_SCALE_W2}; GEMM_RUN((pg8::gemm_phase<0, true>(C.lds, C.tid, g, S, E))); }
            else { pg8::Gemm g{(const bf16_t*)(ws + WS_UM), (const bf16_t*)(ws + W2_BASE), ts[8] * 256, 1024, FF / 2, FF / 2};
                pg8::MoeOrderT<false> S; S.rmap = nullptr; S.so.init(ts[8] * 256, 1024, C.G, (int)blockIdx.x); S.ts1 = ts[1]; S.ts2 = ts[2]; S.ts3 = ts[3]; S.ts4 = ts[4]; S.ts5 = ts[5]; S.ts6 = ts[6]; S.ts7 = ts[7]; S.estride = W2_ESTRIDE8;
                pg8::EpiMoeOut E{(bf16_t*)(ws + WS_Y), (const int*)(ws + WS_RMAP), 1.0f / W8_SCALE_W2}; GEMM_RUN((pg8::gemm_phase<0, true>(C.lds, C.tid, g, S, E))); }
            SEAM(P + 8);
        }
        if (PHM(9) && IN(P + 9)) { KArgP ka = kargs(); (void)ka; FRESH(); unsigned char* const ws = ka->ws; C.ws = ws;
            const float* nsc = (l + 1 < DEPTH) ? MOD + (size_t)(l + 1) * 16 * 6144 + 1024 : nullptr; const float* nsh = (l + 1 < DEPTH) ? MOD + (size_t)(l + 1) * 16 * 6144 : nullptr;
            if (moe) ln_phase<1, false>(C, (l + 1 < DEPTH) ? ws + WS_H8 : nullptr, nullptr, nullptr, XB, (l + 1 < DEPTH) ? (float*)nullptr : ka->out, (bf16_t*)nullptr, ka->ln2_g + l * 1024, ka->ln2_b + l * 1024, nsc, nsh, (const bf16_t*)(ws + WS_Y), (const float*)(ws + WS_GATE), (MOD + (size_t)l * 16 * 6144) + 5120, nullptr, nullptr, nullptr, nullptr, nullptr);
            else ln_phase<0, false>(C, (l + 1 < DEPTH) ? ws + WS_H8 : nullptr, XB, (const bf16_t*)(ws + WS_PRE), XB, (l + 1 < DEPTH) ? (float*)nullptr : ka->out, (bf16_t*)nullptr, ka->ln2_g + l * 1024, ka->ln2_b + l * 1024, nsc, nsh, nullptr, nullptr, (MOD + (size_t)l * 16 * 6144) + 5120, nullptr, nullptr, nullptr, nullptr, nullptr);
            if (l + 1 < DEPTH) for (int rep = 0; rep < (PROBE == 4 ? 2 : 1); ++rep) { __syncthreads(); cvt_mixer_weights(C, l + 1); cvt_ffn_weights(C, l + 1); }
            if (l + 1 < DEPTH) SEAM(P + 9);
        }
    }
    if (PROBE == 30 && blockIdx.x == 0 && C.tid == 0) {
        const unsigned long long c1 = clock64(), t1 = __builtin_amdgcn_s_memrealtime();
        const unsigned long long c0 = ((unsigned long long)MISC[17] << 32) | MISC[16], t0 = ((unsigned long long)MISC[19] << 32) | MISC[18];
        const unsigned long long mhz = (c1 - c0) * 100ull / (t1 - t0);
        while (__builtin_amdgcn_s_memrealtime() - t1 < mhz * 100ull) __builtin_amdgcn_s_sleep(16); }
#undef IN
#undef SEAM
#undef MOD
#undef PART
#undef RSQ
#undef COS
#undef SIN
#undef H
#undef LAT
#undef ZB
#undef QM
#undef KM
#undef VM
#undef OM
#undef PRE
#undef T1
#undef MB
#undef DQ
#undef DK
#undef DV
#undef SA
#undef SB
#undef XB
#undef ctl
#undef gw
#undef NGW
}

extern "C" void kernel_launch(void* const* d_in, const int* in_sizes, int n_in, void* d_out, int out_size, void* d_ws, size_t ws_size, hipStream_t stream) {
    static int grid = 0;
    if (grid == 0) {
        if (n_in != 30 || in_sizes[0] != T * D || out_size != T * D || ws_size < WS_NEED) { fprintf(stderr, "kernel_launch: unexpected shapes (n_in %d, in0 %d, out %d, ws %zu, need %zu)\n", n_in, n_in > 0 ? in_sizes[0] : -1, out_size, ws_size, (size_t)WS_NEED); grid = -1; return; }
        if (hipFuncSetAttribute((const void*)mk_fwd, hipFuncAttributeMaxDynamicSharedMemorySize, LDS_BYTES) != hipSuccess) { fprintf(stderr, "kernel_launch: hipFuncSetAttribute failed\n"); grid = -1; return; }
        int per_cu = 0;
        if (hipOccupancyMaxActiveBlocksPerMultiprocessor(&per_cu, (const void*)mk_fwd, NWAVES * 64, LDS_BYTES) != hipSuccess || per_cu < 1) fprintf(stderr, "kernel_launch: occupancy query reports %d\n", per_cu);
        (void)hipGetLastError();
        grid = 256;
    }
    if (grid < 0) return;
    if (hipMemsetAsync((char*)d_ws + WS_CTL, 0, CTL_ZERO_BYTES, stream) != hipSuccess) { fprintf(stderr, "kernel_launch: memset failed\n"); return; }
    Args a{};
    const float** fp = (const float**)&a.x;
    a.x = (const float*)d_in[0]; a.c = (const float*)d_in[1]; a.pos = (const int*)d_in[2]; a.w_ada = (const float*)d_in[3]; a.b_ada = (const float*)d_in[4]; a.w_in = (const float*)d_in[5];
    a.q_norm_g = (const float*)d_in[6]; a.w_q_up = (const float*)d_in[7]; a.kv_norm_g = (const float*)d_in[8]; a.w_kv_up = (const float*)d_in[9];
    a.lq1 = (const float*)d_in[10]; a.lk1 = (const float*)d_in[11]; a.lq2 = (const float*)d_in[12]; a.lk2 = (const float*)d_in[13]; a.diff_norm_g = (const float*)d_in[14];
    a.w_br_mla = (const float*)d_in[15]; a.w_br_diff = (const float*)d_in[16]; a.w_out = (const float*)d_in[17];
    a.ln1_g = (const float*)d_in[18]; a.ln1_b = (const float*)d_in[19]; a.ln2_g = (const float*)d_in[20]; a.ln2_b = (const float*)d_in[21];
    a.ffn_w1 = (const float*)d_in[22]; a.ffn_w3 = (const float*)d_in[23]; a.ffn_w2 = (const float*)d_in[24]; a.router_w = (const float*)d_in[25]; a.router_b = (const float*)d_in[26];
    a.moe_w1 = (const float*)d_in[27]; a.moe_w3 = (const float*)d_in[28]; a.moe_w2 = (const float*)d_in[29];
    (void)fp;
    a.out = (float*)d_out; a.ws = (unsigned char*)d_ws;
    for (int l = 0; l < 4; ++l) a.lam_init[l] = (float)(0.8 - 0.6 * exp(-0.3 * (double)l));
#if MK_PER_PHASE
    for (int p = 0; p < NPHASE; ++p) {
        const int k = (p - 2) % NPH_L, l = (p - 2) / NPH_L;
        if (p >= 2 && k == 6 && (l & 1) == 0) continue;
        a.ph_lo = p; a.ph_hi = p + 1;
        hipLaunchKernelGGL(mk_fwd, dim3(grid), dim3(NWAVES * 64), LDS_BYTES, stream, a);
    }
#else
    a.ph_lo = 0; a.ph_hi = NPHASE;
    hipLaunchKernelGGL(mk_fwd, dim3(grid), dim3(NWAVES * 64), LDS_BYTES, stream, a);
#endif
    const hipError_t le = hipPeekAtLastError();
    if (le != hipSuccess) fprintf(stderr, "kernel_launch: launch failed: %s\n", hipGetErrorName(le));
}
```
